# Optimizing an MI355X kernel written in HIP

```python
import jax, jax.numpy as jnp
from jax import lax
import numpy as np

D_MODEL = 1024
BATCH = 2
SEQ = 8192
DEPTH = 1

MEM_LEN = 256
HEAD_DIM = 64
LRU_WIDTH = D_MODEL // 2
LRU_BLOCKS = 8
LRU_BLOCK_W = LRU_WIDTH // LRU_BLOCKS
CONV_W = 4
LRU_C = 8.0
MOBA_HEADS = 4
MOBA_WIDTH = MOBA_HEADS * HEAD_DIM
MOBA_BLOCK = 256
MOBA_TOPK = 3
Q_CHUNK = 128
MEM_HEADS = 4
MEM_WIDTH = MEM_HEADS * HEAD_DIM
MIX_WIDTH = LRU_WIDTH + MOBA_WIDTH + MEM_WIDTH
IN_WIDTH = 2 * LRU_WIDTH + 3 * MOBA_WIDTH + MEM_WIDTH
D_FF = ((8 * D_MODEL // 3 + 127) // 128) * 128
NORM_EPS = 1e-6

kernel_name = "hymba_rglru_moba_memxattn_macaron"


def rms_norm(x, g):
    xf = x.astype(jnp.float32)
    y = xf * lax.rsqrt(jnp.mean(xf * xf, axis=-1, keepdims=True) + NORM_EPS)
    return (y * g.astype(jnp.float32)).astype(x.dtype)


def swiglu(x, w_in, w_out):
    a, b = jnp.split(x @ w_in, 2, axis=-1)
    return (jax.nn.silu(a) * b) @ w_out


def alibi_slopes(n_heads):
    return 2.0 ** (-8.0 * jnp.arange(1, n_heads + 1, dtype=jnp.float32) / n_heads)


def split_heads(t, n_heads):
    b, s, _ = t.shape
    return t.reshape(b, s, n_heads, HEAD_DIM).transpose(0, 2, 1, 3)


def merge_heads(t):
    b, h, s, d = t.shape
    return t.transpose(0, 2, 1, 3).reshape(b, s, h * d)


def causal_depthwise_conv(x, w, bias):
    c = x.shape[-1]
    y = lax.conv_general_dilated(
        x, w[:, None, :].astype(x.dtype), window_strides=(1,), padding=[(CONV_W - 1, 0)],
        dimension_numbers=("NWC", "WIO", "NWC"), feature_group_count=c)
    return y + bias.astype(x.dtype)


def rg_lru(xb, a_w, a_b, x_w, x_b, lam):
    b, s, c = xb.shape
    xf = xb.astype(jnp.float32)
    xblk = xf.reshape(b, s, LRU_BLOCKS, LRU_BLOCK_W)
    r = jax.nn.sigmoid(jnp.einsum("bsnc,ncd->bsnd", xblk, a_w.astype(jnp.float32)) + a_b.astype(jnp.float32)).reshape(b, s, c)
    i = jax.nn.sigmoid(jnp.einsum("bsnc,ncd->bsnd", xblk, x_w.astype(jnp.float32)) + x_b.astype(jnp.float32)).reshape(b, s, c)
    log_a = -LRU_C * r * jax.nn.softplus(-lam.astype(jnp.float32))
    a = jnp.exp(log_a)
    mult = jnp.sqrt(-jnp.expm1(2.0 * log_a))
    mult = jnp.where(jnp.arange(s)[None, :, None] == 0, 1.0, mult)
    bt = mult * i * xf

    def combine(left, right):
        a1, b1 = left
        a2, b2 = right
        return a1 * a2, a2 * b1 + b2

    _, h = lax.associative_scan(combine, (a, bt), axis=1)
    return h


def moba_attention(q, k, v):
    b, h, s, hd = q.shape
    n_blk = -(-s // MOBA_BLOCK)
    s_pad = n_blk * MOBA_BLOCK
    pad = s_pad - s
    if pad:
        widths = ((0, 0), (0, 0), (0, pad), (0, 0))
        q, k, v = jnp.pad(q, widths), jnp.pad(k, widths), jnp.pad(v, widths)
    kb = k.reshape(b, h, n_blk, MOBA_BLOCK, hd)
    vb = v.reshape(b, h, n_blk, MOBA_BLOCK, hd)
    k_mean = jnp.mean(kb.astype(jnp.float32), axis=3)
    gate = jnp.einsum("bhsd,bhnd->bhsn", q.astype(jnp.float32), k_mean)
    q_blk = jnp.arange(s_pad) // MOBA_BLOCK
    fully_past = jnp.arange(n_blk)[None, :] < q_blk[:, None]
    gate = jnp.where(fully_past, gate, -jnp.inf)
    n_sel = min(MOBA_TOPK, n_blk)
    gate_top, sel = lax.top_k(gate, n_sel)
    sel_ok = gate_top > -jnp.inf
    slopes = alibi_slopes(h)
    scale = hd ** -0.5
    offs = jnp.arange(MOBA_BLOCK)
    gather_blocks = jax.vmap(jax.vmap(lambda blocks, idx: blocks[idx]))

    def chunk(c):
        start = c * Q_CHUNK
        qc = lax.dynamic_slice_in_dim(q, start, Q_CHUNK, axis=2)
        selc = lax.dynamic_slice_in_dim(sel, start, Q_CHUNK, axis=2)
        okc = lax.dynamic_slice_in_dim(sel_ok, start, Q_CHUNK, axis=2)
        own = start // MOBA_BLOCK
        k_own = lax.dynamic_index_in_dim(kb, own, axis=2, keepdims=False)
        v_own = lax.dynamic_index_in_dim(vb, own, axis=2, keepdims=False)
        k_sel = gather_blocks(kb, selc)
        v_sel = gather_blocks(vb, selc)
        t_q = start + jnp.arange(Q_CHUNK)
        s_own = jnp.einsum("bhqd,bhkd->bhqk", qc, k_own).astype(jnp.float32) * scale
        d_own = t_q[:, None] - (own * MOBA_BLOCK + offs)[None, :]
        s_own = jnp.where(d_own >= 0, s_own - slopes[:, None, None] * d_own.astype(jnp.float32), -jnp.inf)
        s_sel = jnp.einsum("bhqd,bhqjkd->bhqjk", qc, k_sel).astype(jnp.float32) * scale
        d_sel = t_q[None, None, :, None, None] - (selc[..., None] * MOBA_BLOCK + offs)
        s_sel = jnp.where(okc[..., None], s_sel - slopes[None, :, None, None, None] * d_sel.astype(jnp.float32), -jnp.inf)
        scores = jnp.concatenate([s_sel.reshape(b, h, Q_CHUNK, n_sel * MOBA_BLOCK), s_own], axis=-1)
        p = jax.nn.softmax(scores, axis=-1)
        p_sel = p[..., :n_sel * MOBA_BLOCK].reshape(b, h, Q_CHUNK, n_sel, MOBA_BLOCK).astype(v.dtype)
        p_own = p[..., n_sel * MOBA_BLOCK:].astype(v.dtype)
        return (jnp.einsum("bhqjk,bhqjkd->bhqd", p_sel, v_sel)
                + jnp.einsum("bhqk,bhkd->bhqd", p_own, v_own))

    out = lax.map(chunk, jnp.arange(s_pad // Q_CHUNK))
    out = out.transpose(1, 2, 0, 3, 4).reshape(b, h, s_pad, hd)
    return out[:, :, :s]


def memory_attention(q, k, v):
    scores = jnp.einsum("bhsd,bhmd->bhsm", q, k).astype(jnp.float32) * (HEAD_DIM ** -0.5)
    p = jax.nn.softmax(scores, axis=-1)
    return jnp.einsum("bhsm,bhmd->bhsd", p.astype(v.dtype), v)


def setup_inputs(seed: int = 0) -> dict:
    key = jax.random.key(seed)
    ks = jax.random.split(key, 24)

    def normal(k, shape, scale):
        return jax.random.normal(k, shape, jnp.float32) * scale

    def gain(k, n):
        return 1.0 + 0.02 * jax.random.normal(k, (DEPTH, n), jnp.float32)

    u = jax.random.uniform(ks[12], (DEPTH, LRU_WIDTH), jnp.float32, minval=0.9, maxval=0.999)
    a0 = u ** (1.0 / LRU_C)
    lam = jnp.log(a0) - jnp.log1p(-a0)
    return {
        "x": normal(ks[0], (BATCH, SEQ, D_MODEL), 1.0),
        "mem": normal(ks[1], (BATCH, MEM_LEN, D_MODEL), 1.0),
        "ffn1_norm": gain(ks[2], D_MODEL),
        "ffn1_w_in": normal(ks[3], (DEPTH, D_MODEL, 2 * D_FF), D_MODEL ** -0.5),
        "ffn1_w_out": normal(ks[4], (DEPTH, D_FF, D_MODEL), D_FF ** -0.5),
        "mix_norm": gain(ks[5], D_MODEL),
        "mem_norm": gain(ks[6], D_MODEL),
        "w_in": normal(ks[7], (DEPTH, D_MODEL, IN_WIDTH), D_MODEL ** -0.5),
        "lru_conv_w": normal(ks[8], (DEPTH, CONV_W, LRU_WIDTH), CONV_W ** -0.5),
        "lru_conv_b": normal(ks[9], (DEPTH, LRU_WIDTH), 0.01),
        "lru_a_w": normal(ks[10], (DEPTH, LRU_BLOCKS, LRU_BLOCK_W, LRU_BLOCK_W), LRU_BLOCK_W ** -0.5),
        "lru_a_b": normal(ks[11], (DEPTH, LRU_BLOCKS, LRU_BLOCK_W), 0.01),
        "lru_x_w": normal(ks[13], (DEPTH, LRU_BLOCKS, LRU_BLOCK_W, LRU_BLOCK_W), LRU_BLOCK_W ** -0.5),
        "lru_x_b": normal(ks[14], (DEPTH, LRU_BLOCKS, LRU_BLOCK_W), 0.01),
        "lru_lambda": lam,
        "moba_q_norm": gain(ks[15], HEAD_DIM),
        "moba_k_norm": gain(ks[16], HEAD_DIM),
        "mem_w_kv": normal(ks[17], (DEPTH, D_MODEL, 2 * MEM_WIDTH), D_MODEL ** -0.5),
        "mem_q_norm": gain(ks[18], HEAD_DIM),
        "mem_k_norm": gain(ks[19], HEAD_DIM),
        "w_out": normal(ks[20], (DEPTH, MIX_WIDTH, D_MODEL), MIX_WIDTH ** -0.5),
        "ffn2_norm": gain(ks[21], D_MODEL),
        "ffn2_w_in": normal(ks[22], (DEPTH, D_MODEL, 2 * D_FF), D_MODEL ** -0.5),
        "ffn2_w_out": normal(ks[23], (DEPTH, D_FF, D_MODEL), D_FF ** -0.5),
    }


def reference(x, mem, ffn1_norm, ffn1_w_in, ffn1_w_out, mix_norm, mem_norm, w_in,
              lru_conv_w, lru_conv_b, lru_a_w, lru_a_b, lru_x_w, lru_x_b, lru_lambda,
              moba_q_norm, moba_k_norm, mem_w_kv, mem_q_norm, mem_k_norm, w_out,
              ffn2_norm, ffn2_w_in, ffn2_w_out):
    split_at = np.cumsum([LRU_WIDTH, LRU_WIDTH, MOBA_WIDTH, MOBA_WIDTH, MOBA_WIDTH])
    for l in range(DEPTH):
        x = x + 0.5 * swiglu(rms_norm(x, ffn1_norm[l]), ffn1_w_in[l], ffn1_w_out[l])

        u = rms_norm(x, mix_norm[l]) @ w_in[l]
        lru_x, lru_g, mq, mk, mv, cq = jnp.split(u, split_at, axis=-1)

        xb = causal_depthwise_conv(lru_x, lru_conv_w[l], lru_conv_b[l])
        h_lru = rg_lru(xb, lru_a_w[l], lru_a_b[l], lru_x_w[l], lru_x_b[l], lru_lambda[l])
        y_lru = (h_lru * jax.nn.gelu(lru_g.astype(jnp.float32))).astype(x.dtype)

        q = rms_norm(split_heads(mq, MOBA_HEADS), moba_q_norm[l])
        k = rms_norm(split_heads(mk, MOBA_HEADS), moba_k_norm[l])
        v = split_heads(mv, MOBA_HEADS)
        y_moba = merge_heads(moba_attention(q, k, v))

        mkv = rms_norm(mem, mem_norm[l]) @ mem_w_kv[l]
        mem_k, mem_v = jnp.split(mkv, 2, axis=-1)
        qc = rms_norm(split_heads(cq, MEM_HEADS), mem_q_norm[l])
        kc = rms_norm(split_heads(mem_k, MEM_HEADS), mem_k_norm[l])
        y_mem = merge_heads(memory_attention(qc, kc, split_heads(mem_v, MEM_HEADS)))

        mixed = jnp.concatenate([y_lru, y_moba.astype(x.dtype), y_mem.astype(x.dtype)], axis=-1)
        x = x + mixed @ w_out[l]

        x = x + 0.5 * swiglu(rms_norm(x, ffn2_norm[l]), ffn2_w_in[l], ffn2_w_out[l])
    return x
```

```cpp
#include <hip/hip_runtime.h>
#include <cstdio>
#include <cstdint>
namespace pg8 {
#define PG8_LAS __attribute__((address_space(3)))
typedef unsigned short bf16_t;
typedef short bf16x8 __attribute__((ext_vector_type(8)));
typedef float f32x4 __attribute__((ext_vector_type(4)));
typedef unsigned u32x4 __attribute__((ext_vector_type(4)));
constexpr int BM = 256, BK = 64, HALF = 128, HTB = HALF * BK * 2  , STAGE_BYTES = 8 * HTB, NXCD = 8, WGM = 8;

__host__ __device__ __forceinline__ int lds_byte(int r, int c) { const int st = (r >> 4) * 2 + (c >> 5), rr = r & 15, cc = c & 31, ob = rr * 64 + cc * 2; return st * 1024 + (ob ^ (((ob >> 9) & 1) << 5)); }
__host__ __device__ __forceinline__ void stage_rc(int b, int& R, int& C) { const int st = b / 1024, sb = b % 1024, swz = sb ^ (((sb >> 9) & 1) << 5); R = (st >> 1) * 16 + swz / 64; C = (st & 1) * 32 + (swz % 64) / 2; }
__host__ __device__ __forceinline__ int perm32(int rho) { const int n = rho >> 4, i = rho & 15; return 8 * (i >> 2) + 4 * n + (i & 3); }

struct Unit { int pm, pn; };
struct Gemm { const bf16_t* A; const bf16_t* Bt; int M, N, K; };

struct StaticOrder {
    int nM, nN, nwg, G, c;
    __host__ __device__ void init(int M, int N, int G_, int c_) { nM = M / BM; nN = N / BM; nwg = nM * nN; G = G_; c = c_; }
    __host__ __device__ bool next(int i, Unit& u) const {
        const long L = (long)i * G + c; if (L >= nwg) return false;
        int wgid = (int)L; { const int q = nwg / NXCD, r = nwg % NXCD, xcd = wgid % NXCD, off = wgid / NXCD; wgid = (xcd < r ? xcd * (q + 1) : r * (q + 1) + (xcd - r) * q) + off; }
        const int nig = WGM * nN, gid = wgid / nig, fm = gid * WGM, gsz = (nM - fm) < WGM ? (nM - fm) : WGM;
        u.pm = fm + ((wgid % nig) % gsz); u.pn = (wgid % nig) / gsz; return true;
    }
    __device__ __forceinline__ void a_ready(const Unit&) const {}
    __device__ __forceinline__ void done(const Unit&) const {}
};

__device__ __forceinline__ unsigned cvt_pk_bf16(float lo, float hi) { unsigned r; asm volatile("v_cvt_pk_bf16_f32 %0, %1, %2" : "=v"(r) : "v"(lo), "v"(hi)); return r; }
typedef float f32x2 __attribute__((ext_vector_type(2)));

template <class Epi, class Sched, bool ALIGN_EPI = false, bool SP2 = false>
__device__ __forceinline__ void gemm_phase(PG8_LAS unsigned char* lds, const Gemm g, const Sched& S, const Epi& E) {
    const int tid = threadIdx.x, wid = __builtin_amdgcn_readfirstlane(tid >> 6), lane = tid & 63, wr = wid >> 2, wc = wid & 3, fr = lane & 15, fq = lane >> 4;
    const int K = g.K, nt = K / BK;
    unsigned voffA[2], voffB[2];
#pragma unroll
    for (int i = 0; i < 2; ++i) { int R, C; stage_rc(tid * 16 + i * 8192, R, C); const int Rb = Epi::PERM ? ((R & ~31) + perm32(R & 31)) : R;
        voffA[i] = (unsigned)(R * K + C) * 2u; voffB[i] = (unsigned)(Rb * K + C) * 2u; }
    const size_t kstep = (size_t)(BK * 2);
    const size_t hstep = (size_t)HALF * K * 2;
    const size_t tstep = 2 * hstep;
    const unsigned ldsw = (unsigned)wid * 1024u;
    const int aoff = lds_byte(wr * 64 + fr, fq * 8), boff = lds_byte(wc * 32 + fr, fq * 8);
#define PG8_SA(b, h) (((b) * 2 + (h)) * HTB)
#define PG8_SB(b, h) ((4 + (b) * 2 + (h)) * HTB)
#define PG8_STAGE(bufoff, gbase, voff) do { _Pragma("unroll") for (int _i = 0; _i < 2; ++_i) \
        __builtin_amdgcn_global_load_lds((const unsigned*)((const char*)(gbase) + (voff)[_i]), (PG8_LAS unsigned*)(lds + (bufoff) + ldsw + _i * 8192), 16, 0, 0); } while (0)
#define PG8_LDA(dst, b, h) do { _Pragma("unroll") for (int m = 0; m < 4; ++m) _Pragma("unroll") for (int k = 0; k < 2; ++k) dst[m][k] = *(const PG8_LAS bf16x8*)(lds + PG8_SA(b, h) + aoff + m * 2048 + k * 1024); } while (0)
#define PG8_LDB(dst, b, h) do { _Pragma("unroll") for (int n = 0; n < 2; ++n) _Pragma("unroll") for (int k = 0; k < 2; ++k) dst[n][k] = *(const PG8_LAS bf16x8*)(lds + PG8_SB(b, h) + boff + n * 2048 + k * 1024); } while (0)
#define PG8_MMA(ai, bj, At, Bt) do { __builtin_amdgcn_s_setprio(1); _Pragma("unroll") for (int m = 0; m < 4; ++m) _Pragma("unroll") for (int n = 0; n < 2; ++n) _Pragma("unroll") for (int k = 0; k < 2; ++k) \
        acc[ai][bj][m][n] = __builtin_amdgcn_mfma_f32_16x16x32_bf16(Bt[n][k], At[m][k], acc[ai][bj][m][n], 0, 0, 0); __builtin_amdgcn_s_setprio(0); } while (0)
#define PG8_WAIT_V(n) asm volatile("s_waitcnt vmcnt(" #n ")" ::: "memory")
#define PG8_WAIT_L(n) asm volatile("s_waitcnt lgkmcnt(" #n ")" ::: "memory")
#define PG8_BAR __builtin_amdgcn_s_barrier()
#define PG8_SCHED __builtin_amdgcn_sched_barrier(0)
    Unit cur, nxt; int ui = 0;
    if (!S.next(0, cur)) return;
    f32x4 acc[2][2][4][2];
#pragma unroll
    for (int a = 0; a < 2; ++a)
#pragma unroll
        for (int b = 0; b < 2; ++b)
#pragma unroll
            for (int m = 0; m < 4; ++m)
#pragma unroll
                for (int n = 0; n < 2; ++n) acc[a][b][m][n] = (f32x4){0.f, 0.f, 0.f, 0.f};
    bf16x8 At[4][2], B0[2][2], B1[2][2];
    const char* cA = (const char*)g.A + (size_t)cur.pm * tstep; const char* cB = (const char*)g.Bt + (size_t)cur.pn * tstep;
    S.a_ready(cur);
    if constexpr (SP2) {
        PG8_STAGE(PG8_SB(0, 0), cB, voffB); PG8_STAGE(PG8_SB(0, 1), cB + hstep, voffB); PG8_STAGE(PG8_SA(0, 0), cA, voffA); PG8_STAGE(PG8_SA(0, 1), cA + hstep, voffA);
        if (wr == 1) PG8_BAR;
        PG8_WAIT_V(2); PG8_BAR;
        PG8_STAGE(PG8_SB(1, 0), cB + kstep, voffB); PG8_STAGE(PG8_SA(1, 0), cA + kstep, voffA); PG8_STAGE(PG8_SB(1, 1), cB + hstep + kstep, voffB);
        PG8_WAIT_V(6); PG8_BAR;
    } else {
        PG8_STAGE(PG8_SB(0, 0), cB, voffB); PG8_STAGE(PG8_SA(0, 0), cA, voffA); PG8_STAGE(PG8_SB(0, 1), cB + hstep, voffB); PG8_STAGE(PG8_SA(0, 1), cA + hstep, voffA);
        if (wr == 1) PG8_BAR;
        PG8_WAIT_V(4); PG8_BAR;
        PG8_STAGE(PG8_SB(1, 0), cB + kstep, voffB); PG8_STAGE(PG8_SA(1, 0), cA + kstep, voffA); PG8_STAGE(PG8_SB(1, 1), cB + hstep + kstep, voffB);
        PG8_WAIT_V(6); PG8_BAR;
    }
    for (;;) {
        const bool has_next = S.next(ui + 1, nxt);
        const char* nA = has_next ? (const char*)g.A + (size_t)nxt.pm * tstep : cA; const char* nB = has_next ? (const char*)g.Bt + (size_t)nxt.pn * tstep : cB;
        for (int t = 0; t < nt; t += 2) {
            const bool last = (t == nt - 2);
            const char* a1 = cA + (size_t)(t + 1) * kstep;
            const char* a2 = last ? nA : cA + (size_t)(t + 2) * kstep; const char* b2 = last ? nB : cB + (size_t)(t + 2) * kstep;
            const char* a3 = a2 + kstep; const char* b3 = b2 + kstep;
            if (last && has_next) S.a_ready(nxt);
            if constexpr (SP2) {
            PG8_LDB(B0, 0, 0); PG8_LDB(B1, 0, 1); PG8_SCHED; PG8_LDA(At, 0, 0); PG8_STAGE(PG8_SA(1, 1), a1 + hstep, voffA);
            PG8_WAIT_V(8); PG8_WAIT_L(0); PG8_BAR; PG8_MMA(0, 0, At, B0); PG8_MMA(0, 1, At, B1); PG8_BAR; PG8_SCHED;
            PG8_LDA(At, 0, 1); PG8_STAGE(PG8_SB(0, 0), b2, voffB); PG8_STAGE(PG8_SB(0, 1), b2 + hstep, voffB); PG8_STAGE(PG8_SA(0, 0), a2, voffA);
            PG8_WAIT_V(8); PG8_WAIT_L(0); PG8_BAR; PG8_MMA(1, 0, At, B0); PG8_MMA(1, 1, At, B1); PG8_BAR; PG8_SCHED;
            PG8_LDB(B0, 1, 0); PG8_LDB(B1, 1, 1); PG8_SCHED; PG8_LDA(At, 1, 0); PG8_STAGE(PG8_SA(0, 1), a2 + hstep, voffA);
            PG8_WAIT_V(8); PG8_WAIT_L(0); PG8_BAR; PG8_MMA(0, 0, At, B0); PG8_MMA(0, 1, At, B1); PG8_BAR; PG8_SCHED;
            PG8_LDA(At, 1, 1); PG8_STAGE(PG8_SB(1, 0), b3, voffB); PG8_STAGE(PG8_SB(1, 1), b3 + hstep, voffB); PG8_STAGE(PG8_SA(1, 0), a3, voffA);
            PG8_WAIT_V(8); PG8_WAIT_L(0); PG8_BAR; PG8_MMA(1, 0, At, B0); PG8_MMA(1, 1, At, B1); PG8_BAR; PG8_SCHED;
            } else {
            PG8_LDB(B0, 0, 0); PG8_SCHED; PG8_LDA(At, 0, 0); PG8_STAGE(PG8_SA(1, 1), a1 + hstep, voffA);
            PG8_WAIT_L(8); PG8_BAR; PG8_WAIT_L(0); PG8_MMA(0, 0, At, B0); PG8_BAR; PG8_SCHED;
            PG8_LDB(B1, 0, 1); PG8_STAGE(PG8_SB(0, 0), b2, voffB);
            PG8_BAR; PG8_WAIT_L(0); PG8_MMA(0, 1, At, B1); PG8_BAR;
            PG8_LDA(At, 0, 1); PG8_STAGE(PG8_SA(0, 0), a2, voffA);
            PG8_BAR; PG8_WAIT_L(0); PG8_MMA(1, 0, At, B0); PG8_BAR; PG8_SCHED;
            PG8_STAGE(PG8_SB(0, 1), b2 + hstep, voffB);
            PG8_WAIT_V(6); PG8_BAR; PG8_MMA(1, 1, At, B1); PG8_BAR;
            PG8_LDB(B0, 1, 0); PG8_SCHED; PG8_LDA(At, 1, 0); PG8_STAGE(PG8_SA(0, 1), a2 + hstep, voffA);
            PG8_WAIT_L(8); PG8_BAR; PG8_WAIT_L(0); PG8_MMA(0, 0, At, B0); PG8_BAR; PG8_SCHED;
            PG8_LDB(B1, 1, 1); PG8_STAGE(PG8_SB(1, 0), b3, voffB);
            PG8_BAR; PG8_WAIT_L(0); PG8_MMA(0, 1, At, B1); PG8_BAR;
            PG8_LDA(At, 1, 1); PG8_STAGE(PG8_SA(1, 0), a3, voffA);
            PG8_BAR; PG8_WAIT_L(0); PG8_MMA(1, 0, At, B0); PG8_BAR; PG8_SCHED;
            PG8_STAGE(PG8_SB(1, 1), b3 + hstep, voffB);
            PG8_WAIT_V(6); PG8_BAR; PG8_MMA(1, 1, At, B1); PG8_BAR;
            }
        }
        if constexpr (ALIGN_EPI) { if (wr == 0) PG8_BAR; }
        if constexpr (!Epi::AFTER_DRAIN) { E(acc, cur, wr, wc, fr, fq); S.done(cur); }
        if (!has_next) break;
#pragma unroll
        for (int a = 0; a < 2; ++a)
#pragma unroll
            for (int b = 0; b < 2; ++b)
#pragma unroll
                for (int m = 0; m < 4; ++m)
#pragma unroll
                    for (int n = 0; n < 2; ++n) acc[a][b][m][n] = (f32x4){0.f, 0.f, 0.f, 0.f};
        cur = nxt; cA = nA; cB = nB; ++ui;
        if constexpr (ALIGN_EPI) { if (wr == 1) PG8_BAR; }
    }
    PG8_WAIT_V(0);
    if constexpr (!ALIGN_EPI) { if (wr == 0) PG8_BAR; }
    PG8_BAR;
    if constexpr (Epi::AFTER_DRAIN) { E.fused(acc, cur, wr, wc, fr, fq, lds, wid, lane); S.done(cur); }
#undef PG8_SA
#undef PG8_SB
#undef PG8_STAGE
#undef PG8_LDA
#undef PG8_LDB
#undef PG8_MMA
#undef PG8_WAIT_V
#undef PG8_WAIT_L
#undef PG8_BAR
#undef PG8_SCHED
}
}
namespace pg8 {
constexpr float NORM_EPS_F = 1e-6f;
__device__ __forceinline__ float row_rs(const float* ssq4, int row) {
    const f32x4 s = *(const f32x4*)(ssq4 + (size_t)row * 4);
    return __builtin_amdgcn_rsqf(((s[0] + s[1]) + (s[2] + s[3])) * (1.0f / 1024.0f) + NORM_EPS_F);
}
__device__ __forceinline__ float silu_mul(float a, float b) { return a * __builtin_amdgcn_rcpf(1.0f + __expf(-a)) * b; }
struct EpiSwiGLU {
    static constexpr bool PERM = true, AFTER_DRAIN = false;
    bf16_t* H; int ldh; const float* ssq;
    __device__ __forceinline__ void operator()(const f32x4 (&acc)[2][2][4][2], const Unit& u, int wr, int wc, int fr, int fq) const {
        const int row0 = u.pm * BM + wr * 64 + fr, col0 = u.pn * HALF + wc * 32 + 8 * fq;
#pragma unroll
        for (int ai = 0; ai < 2; ++ai)
#pragma unroll
            for (int m = 0; m < 4; ++m) { const int row = row0 + ai * HALF + m * 16; const float rs = row_rs(ssq, row);
                const f32x4 a0 = acc[ai][0][m][0] * rs, a1 = acc[ai][0][m][1] * rs, b0 = acc[ai][1][m][0] * rs, b1 = acc[ai][1][m][1] * rs;
                u32x4 w; w.x = cvt_pk_bf16(silu_mul(a0[0], b0[0]), silu_mul(a0[1], b0[1])); w.y = cvt_pk_bf16(silu_mul(a0[2], b0[2]), silu_mul(a0[3], b0[3]));
                w.z = cvt_pk_bf16(silu_mul(a1[0], b1[0]), silu_mul(a1[1], b1[1])); w.w = cvt_pk_bf16(silu_mul(a1[2], b1[2]), silu_mul(a1[3], b1[3]));
                *(u32x4*)(H + (size_t)row * ldh + col0) = w; }
    }
};
struct EpiResid {
    static constexpr bool PERM = false, AFTER_DRAIN = true;
    const float* base; float* out; bf16_t* ob; float* ssq_out; float alpha;
    __device__ __forceinline__ void fused(f32x4 (&acc)[2][2][4][2], const Unit& u, int wr, int wc, int fr, int fq, PG8_LAS unsigned char* lds, int wid, int lane) const {
        typedef unsigned u32x2v __attribute__((ext_vector_type(2)));
        PG8_LAS float* P = (PG8_LAS float*)lds;
        const int col0 = u.pn * BM + wc * 32 + 4 * fq;
#pragma unroll
        for (int ai = 0; ai < 2; ++ai)
#pragma unroll
            for (int m = 0; m < 4; ++m) { const int r = ai * HALF + wr * 64 + m * 16 + fr; const size_t off = (size_t)(u.pm * BM + r) * 1024 + col0; float q = 0.f;
#pragma unroll
                for (int bj = 0; bj < 2; ++bj)
#pragma unroll
                    for (int n = 0; n < 2; ++n) { const f32x4 bs = *(const f32x4*)(base + off + bj * HALF + n * 16); const f32x4 o = bs + acc[ai][bj][m][n] * alpha;
                        *(f32x4*)(out + off + bj * HALF + n * 16) = o; q += (o[0] * o[0] + o[1] * o[1]) + (o[2] * o[2] + o[3] * o[3]);
                        if (ob) { u32x2v w; w.x = cvt_pk_bf16(o[0], o[1]); w.y = cvt_pk_bf16(o[2], o[3]); *(u32x2v*)(ob + off + bj * HALF + n * 16) = w; } }
                q += __shfl_xor(q, 16); q += __shfl_xor(q, 32);
                if (fq == 0) P[r * 4 + wc] = q;
                if (m & 1) asm volatile("" ::: "memory"); }
        asm volatile("s_waitcnt lgkmcnt(0)" ::: "memory"); __builtin_amdgcn_s_barrier(); asm volatile("" ::: "memory");
        if (ssq_out) { const int t = wid * 64 + lane; if (t < 256) { const PG8_LAS f32x4* P4 = (const PG8_LAS f32x4*)lds; const f32x4 p = P4[t]; ssq_out[(size_t)(u.pm * BM + t) * 4 + u.pn] = (p[0] + p[1]) + (p[2] + p[3]); } }
    }
};
struct EpiWin {
    static constexpr bool PERM = true, AFTER_DRAIN = false;
    bf16_t* U; const float* ssq; const float* gains;
    __device__ __forceinline__ void operator()(const f32x4 (&acc)[2][2][4][2], const Unit& u, int wr, int wc, int fr, int fq) const {
        const int row0 = u.pm * BM + wr * 64 + fr, colL = u.pn * BM + wc * 64 + 8 * fq;
        const bool nrm = (u.pn == 4) || (u.pn == 5) || (u.pn == 7);
        const float* g = gains + ((u.pn == 4) ? 0 : (u.pn == 5) ? 64 : 128);
        f32x4 gv[2][2];
#pragma unroll
        for (int bj = 0; bj < 2; ++bj)
#pragma unroll
            for (int n = 0; n < 2; ++n) gv[bj][n] = nrm ? *(const f32x4*)(g + 32 * bj + 8 * fq + 4 * n) : (f32x4){1.f, 1.f, 1.f, 1.f};
#pragma unroll
        for (int ai = 0; ai < 2; ++ai)
#pragma unroll
            for (int m = 0; m < 4; ++m) { const int row = row0 + ai * HALF + m * 16; const float rs = row_rs(ssq, row);
                f32x4 v[2][2]; float ss = 0.f;
#pragma unroll
                for (int bj = 0; bj < 2; ++bj)
#pragma unroll
                    for (int n = 0; n < 2; ++n) { v[bj][n] = acc[ai][bj][m][n] * rs; ss += (v[bj][n][0] * v[bj][n][0] + v[bj][n][1] * v[bj][n][1]) + (v[bj][n][2] * v[bj][n][2] + v[bj][n][3] * v[bj][n][3]); }
                ss += __shfl_xor(ss, 16); ss += __shfl_xor(ss, 32);
                const float rn = nrm ? __builtin_amdgcn_rsqf(ss * (1.0f / 64.0f) + NORM_EPS_F) : 1.0f;
#pragma unroll
                for (int bj = 0; bj < 2; ++bj) { const f32x4 x0 = v[bj][0] * rn * gv[bj][0], x1 = v[bj][1] * rn * gv[bj][1];
                    u32x4 w; w.x = cvt_pk_bf16(x0[0], x0[1]); w.y = cvt_pk_bf16(x0[2], x0[3]); w.z = cvt_pk_bf16(x1[0], x1[1]); w.w = cvt_pk_bf16(x1[2], x1[3]);
                    *(u32x4*)(U + (size_t)row * 2048 + colL + 32 * bj) = w; } }
    }
};
}
#ifndef PG8_SP2
#define PG8_SP2 true
#endif
#ifndef PG8_ALIGN
#define PG8_ALIGN true
#endif
#ifndef MK_N_LAUNCHES
#define MK_N_LAUNCHES 1
#endif
constexpr int NWAVES = 8;
constexpr int NPHASE = 9;
constexpr int N_LAUNCHES = MK_N_LAUNCHES;

constexpr int BATCH = 2, SEQ = 8192, D = 1024, FF = 2816, M = BATCH * SEQ;
constexpr int MEMLEN = 256, HD = 64, LRUW = 512, INW = 2048, NBLK = SEQ / 256;
constexpr float EPS = 1e-6f;

constexpr size_t MiB = 1u << 20;
constexpr size_t WS_CTL = 0, CTL_ZERO_BYTES = 64 * 1024;
constexpr size_t WS_SSQ0 = 1 * MiB, WS_SSQ1 = WS_SSQ0 + 256 * 1024, WS_SSQ2 = WS_SSQ1 + 256 * 1024;
constexpr size_t WS_KMEAN = 2 * MiB;
constexpr size_t WS_AGGA = WS_KMEAN + 64 * 1024;
constexpr size_t WS_AGGH = WS_AGGA + 128 * 1024;
constexpr size_t WS_GAINS = WS_AGGH + 128 * 1024;
constexpr size_t WS_MEMB = 3 * MiB;
constexpr size_t WS_MEMK = 4 * MiB, WS_MEMV = WS_MEMK + 256 * 1024;
constexpr size_t WS_W1I = 8 * MiB, WS_W1O = 19 * MiB, WS_WIN = 25 * MiB, WS_WOUT = 29 * MiB, WS_WMKV = 31 * MiB, WS_W2I = 32 * MiB, WS_W2O = 43 * MiB;
constexpr size_t WS_XB = 50 * MiB;
constexpr size_t WS_MIX = 82 * MiB;
constexpr size_t WS_H = 114 * MiB;
constexpr size_t WS_U = WS_H;
constexpr size_t WS_END = 256 * MiB;
static_assert(WS_H + (size_t)M * FF * 2 <= WS_END, "d_ws map");
constexpr int CW_BAR = 1024;

constexpr int RING_OFF = 0, RING_BYTES = 131072;
constexpr int LDSCTL_OFF = RING_BYTES, MISC_OFF = LDSCTL_OFF + 320;
constexpr int LDS_BYTES = 147456;

#define GAS __attribute__((address_space(1)))
#define LAS __attribute__((address_space(3)))
typedef unsigned short bf16;
typedef unsigned v4u __attribute__((ext_vector_type(4)));
typedef float f32x4 __attribute__((ext_vector_type(4)));
typedef short bf16x8 __attribute__((ext_vector_type(8)));
typedef GAS unsigned gu32;
typedef GAS unsigned long long gu64;
#define RLX_AGENT __ATOMIC_RELAXED, __HIP_MEMORY_SCOPE_AGENT
#define LDS_WAIT() asm volatile("s_waitcnt lgkmcnt(0)" ::: "memory")
#define VM_WAIT() asm volatile("s_waitcnt vmcnt(0)" ::: "memory")
__device__ __forceinline__ unsigned long long rt() { return __builtin_amdgcn_s_memrealtime(); }
__device__ __forceinline__ unsigned f2bf(float f) { unsigned u = __builtin_bit_cast(unsigned, f); return (u + 0x7fffu + ((u >> 16) & 1u)) >> 16; }
__device__ __forceinline__ unsigned pk2(float lo, float hi) { return f2bf(lo) | (f2bf(hi) << 16); }

#define XB_TMO      128
#define XB_XCNT(j)  (256  + 64 * (j))
#define XB_XSUB(j)  (1280 + 64 * (j))
#define XB_XGEN(j)  (2304 + 64 * (j))
#define XB_TOP      3328
#define XB_TOPGEN   3392
#define XCD_BAR_WORDS 3456
#define XB_SPIN_CAP (1u << 18)

__device__ __forceinline__ unsigned xb_ld(unsigned* p)              { return __hip_atomic_load(p, __ATOMIC_RELAXED, __HIP_MEMORY_SCOPE_AGENT); }
__device__ __forceinline__ unsigned xb_add(unsigned* p, unsigned v) { return __hip_atomic_fetch_add(p, v, __ATOMIC_RELAXED, __HIP_MEMORY_SCOPE_AGENT); }
__device__ __forceinline__ unsigned xb_xcc_id() { return (unsigned)__builtin_amdgcn_s_getreg((3 << 11) | 20) & 0xFu; }
#define XB_SPIN(cond, bar) do { unsigned _sp = 0; while (cond) { __builtin_amdgcn_s_sleep(1); \
    if ((++_sp & 255u) == 0u) { if (xb_ld(&(bar)[XB_TMO])) break; if (_sp > XB_SPIN_CAP) { atomicAdd(&(bar)[XB_TMO], 1u); break; } } } } while (0)

struct XcdBarrier {
    unsigned* bar; unsigned x;
    volatile LAS unsigned* st;
};

__device__ __forceinline__ XcdBarrier xcd_barrier_post(unsigned* bar, volatile LAS unsigned* st) {
    XcdBarrier b; b.bar = bar; b.x = xb_xcc_id(); b.st = st;
    if (threadIdx.x == 0) (void)xb_add(&bar[XB_XCNT(b.x)], 1u);
    return b;
}
__device__ __forceinline__ void xcd_barrier_complete(unsigned* bar, unsigned x, unsigned& nloc, unsigned& nx) {
    const unsigned G = gridDim.x * gridDim.y * gridDim.z;
    unsigned sum, cnt, mine, sp = 0u;
    for (;;) {
        sum = 0u; cnt = 0u; mine = 0u;
#pragma unroll
        for (unsigned j = 0; j < 16; ++j) { const unsigned c = xb_ld(&bar[XB_XCNT(j)]); sum += c; cnt += (c > 0u) ? 1u : 0u; mine = (j == x) ? c : mine; }
        if (sum == G) break;
        __builtin_amdgcn_s_sleep(1);
        if ((++sp & 255u) == 0u) { if (xb_ld(&bar[XB_TMO])) break; if (sp > XB_SPIN_CAP) { atomicAdd(&bar[XB_TMO], 1u); break; } }
    }
    nloc = mine > 0u ? mine : 1u; nx = cnt > 0u ? cnt : 1u;
}

__device__ __forceinline__ void xcd_barrier(const XcdBarrier& b) {
    asm volatile("s_waitcnt vmcnt(0)" ::: "memory");
    __syncthreads();
    if (threadIdx.x == 0) {
        unsigned* bar = b.bar;
        __builtin_amdgcn_s_waitcnt(0);
        unsigned nloc = b.st[0], nx = b.st[1];
        if (nloc == 0u) { xcd_barrier_complete(bar, b.x, nloc, nx); b.st[0] = nloc; b.st[1] = nx; }
        const unsigned old = xb_add(&bar[XB_XSUB(b.x)], 1u);
        const unsigned gen = old / nloc;
        if (old + 1u == (gen + 1u) * nloc) {
            __builtin_amdgcn_fence(__ATOMIC_RELEASE, "agent");
            asm volatile("s_waitcnt vmcnt(0)" ::: "memory");
            const unsigned og = xb_add(&bar[XB_TOP], 1u);
            const unsigned tg = og / nx;
            if (og + 1u == (tg + 1u) * nx) xb_add(&bar[XB_TOPGEN], 1u);
            else XB_SPIN(xb_ld(&bar[XB_TOPGEN]) == tg, bar);
            __builtin_amdgcn_fence(__ATOMIC_ACQUIRE, "agent");
            xb_add(&bar[XB_XGEN(b.x)], 1u);
            asm volatile("s_waitcnt vmcnt(0)" ::: "memory");
        } else {
            XB_SPIN(xb_ld(&bar[XB_XGEN(b.x)]) == gen, bar);
            __builtin_amdgcn_fence(__ATOMIC_ACQUIRE, "agent");
            asm volatile("s_waitcnt vmcnt(0)" ::: "memory");
        }
    }
    __syncthreads();
}
__device__ __forceinline__ float bf2f(unsigned short h) { return __uint_as_float((unsigned)h << 16); }
__device__ __forceinline__ float bflo(unsigned w) { return __uint_as_float(w << 16); }
__device__ __forceinline__ float bfhi(unsigned w) { return __uint_as_float(w & 0xffff0000u); }
__device__ __forceinline__ float wave_sum(float v) {
#pragma unroll
    for (int o = 1; o < 64; o <<= 1) v += __shfl_xor(v, o);
    return v;
}
__device__ __forceinline__ float wave_max(float v) {
#pragma unroll
    for (int o = 1; o < 64; o <<= 1) v = fmaxf(v, __shfl_xor(v, o));
    return v;
}
__device__ __forceinline__ float sigmoidf_(float x) { return 1.0f / (1.0f + __expf(-x)); }
__device__ __forceinline__ float gelu_tanh(float x) { const float z = 0.7978845608028654f * (x + 0.044715f * x * x * x); const float e = __expf(2.0f * z); return 0.5f * x * (1.0f + (1.0f - 2.0f / (e + 1.0f))); }

__device__ __forceinline__ void p0_transpose_item(const float* W, int K, int N, const float* gain, bf16* WT, int dest_row0, LAS float* scr, int k0, int n0, int lane) {
#pragma unroll 8
    for (int i = 0; i < 32; ++i) { const int kk = 2 * i + (lane >> 5); const float g = gain ? gain[k0 + kk] : 1.0f; scr[kk * 33 + (lane & 31)] = W[(size_t)(k0 + kk) * N + n0 + (lane & 31)] * g; }
    LDS_WAIT(); asm volatile("" ::: "memory");
    const int c = lane & 7;
#pragma unroll
    for (int j = 0; j < 4; ++j) { const int n = (lane >> 3) + 8 * j; const LAS float* s = scr + (8 * c) * 33 + n;
        v4u o; o.x = pk2(s[0 * 33], s[1 * 33]); o.y = pk2(s[2 * 33], s[3 * 33]); o.z = pk2(s[4 * 33], s[5 * 33]); o.w = pk2(s[6 * 33], s[7 * 33]);
        *(GAS v4u*)(WT + (size_t)(dest_row0 + n) * K + k0 + 8 * c) = o; }
    LDS_WAIT(); asm volatile("" ::: "memory");
}
__device__ __forceinline__ int map_swiglu(int n0) { return n0 < FF ? 256 * (n0 / 128) + (n0 % 128) : 256 * ((n0 - FF) / 128) + 128 + ((n0 - FF) % 128); }
__device__ __forceinline__ int map_heads(int n0) { const int rem = n0 % 256; return 256 * (n0 / 256) + 128 * ((rem / 32) & 1) + 32 * (rem / 64); }
__device__ __forceinline__ void row_to_bf16(const float* xrow, bf16* orow, float* ssq4, bool scale, int lane) {
    const GAS f32x4* xr = (const GAS f32x4*)xrow + lane;
    f32x4 v[4]; float s = 0.f;
#pragma unroll
    for (int j = 0; j < 4; ++j) { v[j] = xr[64 * j]; s += (v[j].x * v[j].x + v[j].y * v[j].y) + (v[j].z * v[j].z + v[j].w * v[j].w); }
    s = wave_sum(s);
    const float rs = scale ? __builtin_amdgcn_rsqf(s * (1.0f / 1024.0f) + EPS) : 1.0f;
    GAS unsigned long long* o8 = (GAS unsigned long long*)orow + lane;
#pragma unroll
    for (int j = 0; j < 4; ++j) o8[64 * j] = (unsigned long long)pk2(v[j].x * rs, v[j].y * rs) | ((unsigned long long)pk2(v[j].z * rs, v[j].w * rs) << 32);
    if (ssq4 && lane == 0) { *(GAS f32x4*)ssq4 = (f32x4){s, 0.f, 0.f, 0.f}; }
}
struct P0Mat { const float* W; int K, N; const float* gain; bf16* WT; int map; };
__device__ __forceinline__ void p0_prologue(const float* const* in, unsigned char* ws, LAS unsigned char* lds, int vcu, int G, int wave, int lane) {
    LAS float* scr = (LAS float*)(lds + RING_OFF + wave * 16384);
    const int gw = vcu * NWAVES + wave, NGW = G * NWAVES;
    for (int m = gw; m < M; m += NGW) row_to_bf16(in[0] + (size_t)m * D, (bf16*)(ws + WS_XB) + (size_t)m * D, (float*)(ws + WS_SSQ0) + (size_t)m * 4, false, lane);
    for (int m = gw; m < BATCH * MEMLEN; m += NGW) row_to_bf16(in[1] + (size_t)m * D, (bf16*)(ws + WS_MEMB) + (size_t)m * D, nullptr, true, lane);
    constexpr int I_FI = (D / 64) * (2 * FF / 32), I_FO = (FF / 64) * (D / 32), I_WI = (D / 64) * (INW / 32), I_WO = (D / 64) * (D / 32), I_MK = (D / 64) * (512 / 32);
    constexpr int NITEMS = 2 * I_FI + 2 * I_FO + I_WI + I_WO + I_MK;
    for (int it = gw; it < NITEMS; it += NGW) {
        int r = it; const float* W; const float* gain; bf16* WT; int K, N, map;
        if (r < I_FI) { W = in[3]; K = D; N = 2 * FF; gain = in[2]; WT = (bf16*)(ws + WS_W1I); map = 1; }
        else if ((r -= I_FI) < I_FI) { W = in[22]; K = D; N = 2 * FF; gain = in[21]; WT = (bf16*)(ws + WS_W2I); map = 1; }
        else if ((r -= I_FI) < I_FO) { W = in[4]; K = FF; N = D; gain = nullptr; WT = (bf16*)(ws + WS_W1O); map = 0; }
        else if ((r -= I_FO) < I_FO) { W = in[23]; K = FF; N = D; gain = nullptr; WT = (bf16*)(ws + WS_W2O); map = 0; }
        else if ((r -= I_FO) < I_WI) { W = in[7]; K = D; N = INW; gain = in[5]; WT = (bf16*)(ws + WS_WIN); map = 2; }
        else if ((r -= I_WI) < I_WO) { W = in[20]; K = D; N = D; gain = nullptr; WT = (bf16*)(ws + WS_WOUT); map = 0; }
        else { r -= I_WO; W = in[17]; K = D; N = 512; gain = in[6]; WT = (bf16*)(ws + WS_WMKV); map = 0; }
        const int nblk = N / 32, kb = r / nblk, nb = r % nblk, k0 = 64 * kb, n0 = 32 * nb;
        const int dr = map == 1 ? map_swiglu(n0) : map == 2 ? map_heads(n0) : n0;
        p0_transpose_item(W, K, N, gain, WT, dr, scr, k0, n0, lane);
    }
}

template <bool FINAL>
__device__ __forceinline__ void lru_items(const float* const* in, unsigned char* ws, LAS unsigned char* lds, int G, int wave, int lane, int tid) {
    const bf16* U = (const bf16*)(ws + WS_U); bf16* MIX = (bf16*)(ws + WS_MIX);
    float* AGGA = (float*)(ws + WS_AGGA); float* AGGH = (float*)(ws + WS_AGGH);
    LAS float* Wa = (LAS float*)(lds + RING_OFF);
    LAS float* Wx = Wa + 4096;
    LAS float* xs = Wx + 4096 + wave * 64;
    LAS float* Aw = Wx + 4096 + 512;
    LAS float* Hw = Aw + 512;
    for (int id = blockIdx.x; id < BATCH * NBLK * 8; id += G) {
        const int n = id & 7, ck = (id >> 3) & 31, b = id >> 8;
        __syncthreads();
        for (int i = tid; i < 4096; i += 512) { Wa[i] = in[10][n * 4096 + i]; Wx[i] = in[12][n * 4096 + i]; }
        __syncthreads();
        const int gc = n * 64 + lane;
        const float w0 = in[8][gc], w1 = in[8][512 + gc], w2 = in[8][1024 + gc], w3 = in[8][1536 + gc], cb = in[9][gc];
        const float ab = in[11][gc], xbi = in[13][gc];
        const float sp = log1pf(__expf(-in[14][gc]));
        const int t0 = ck * 256 + wave * 32; const size_t rb = (size_t)b * SEQ;
        float xm3 = 0.f, xm2 = 0.f, xm1 = 0.f;
        if (t0 > 0) { xm3 = bf2f(U[(rb + t0 - 3) * INW + gc]); xm2 = bf2f(U[(rb + t0 - 2) * INW + gc]); xm1 = bf2f(U[(rb + t0 - 1) * INW + gc]); }
        float a_[32], b_[32];
#pragma unroll
        for (int tt = 0; tt < 32; ++tt) {
            const float xt = bf2f(U[(rb + t0 + tt) * INW + gc]);
            const float xbv = w0 * xm3 + w1 * xm2 + w2 * xm1 + w3 * xt + cb;
            xm3 = xm2; xm2 = xm1; xm1 = xt;
            xs[lane] = xbv;
            float r = ab, ii = xbi;
#pragma unroll 8
            for (int c = 0; c < 64; ++c) { const float xv = xs[c]; r += xv * Wa[c * 64 + lane]; ii += xv * Wx[c * 64 + lane]; }
            r = sigmoidf_(r); ii = sigmoidf_(ii);
            const float la = -8.0f * r * sp;
            float mult = sqrtf(-expm1f(2.0f * la));
            if (t0 + tt == 0) mult = 1.0f;
            a_[tt] = __expf(la); b_[tt] = mult * ii * xbv;
        }
        float A = 1.f, Hh = 0.f;
#pragma unroll
        for (int tt = 0; tt < 32; ++tt) { Hh = a_[tt] * Hh + b_[tt]; A *= a_[tt]; }
        Aw[wave * 64 + lane] = A; Hw[wave * 64 + lane] = Hh;
        __syncthreads();
        if (!FINAL) {
            if (wave == 0) { float cA = 1.f, cH = 0.f;
#pragma unroll
                for (int v = 0; v < 8; ++v) { const float av = Aw[v * 64 + lane], hv = Hw[v * 64 + lane]; cH = av * cH + hv; cA *= av; }
                AGGA[(size_t)(b * NBLK + ck) * LRUW + gc] = cA; AGGH[(size_t)(b * NBLK + ck) * LRUW + gc] = cH; }
        } else {
            float h = 0.f;
            for (int cc = 0; cc < ck; ++cc) { const float av = AGGA[(size_t)(b * NBLK + cc) * LRUW + gc], hv = AGGH[(size_t)(b * NBLK + cc) * LRUW + gc]; h = av * h + hv; }
            for (int v = 0; v < wave; ++v) { const float av = Aw[v * 64 + lane], hv = Hw[v * 64 + lane]; h = av * h + hv; }
#pragma unroll
            for (int tt = 0; tt < 32; ++tt) { h = a_[tt] * h + b_[tt];
                const float g = bf2f(U[(rb + t0 + tt) * INW + LRUW + gc]);
                MIX[(rb + t0 + tt) * D + gc] = (bf16)f2bf(h * gelu_tanh(g)); }
        }
    }
    __syncthreads();
}
__device__ __forceinline__ void kmean_items(unsigned char* ws, LAS unsigned char* lds, int G, int wave, int lane, int tid) {
    const bf16* U = (const bf16*)(ws + WS_U); float* KM = (float*)(ws + WS_KMEAN);
    LAS float* part = (LAS float*)(lds + RING_OFF);
    for (int id = blockIdx.x; id < BATCH * NBLK; id += G) {
        const int b = id / NBLK, j = id % NBLK;
        float s0 = 0.f, s1 = 0.f, s2 = 0.f, s3 = 0.f;
        for (int r = 0; r < 32; ++r) { const size_t row = (size_t)b * SEQ + j * 256 + wave * 32 + r;
            const uint2 w = *(const uint2*)(U + row * INW + 1280 + 4 * lane);
            s0 += bflo(w.x); s1 += bfhi(w.x); s2 += bflo(w.y); s3 += bfhi(w.y); }
        __syncthreads();
        part[wave * 256 + 4 * lane + 0] = s0; part[wave * 256 + 4 * lane + 1] = s1; part[wave * 256 + 4 * lane + 2] = s2; part[wave * 256 + 4 * lane + 3] = s3;
        __syncthreads();
        if (tid < 256) { float s = 0.f;
#pragma unroll
            for (int v = 0; v < 8; ++v) s += part[v * 256 + tid];
            const int h = tid >> 6, d = tid & 63; KM[((size_t)(b * 4 + h) * NBLK + j) * 64 + d] = s * (1.0f / 256.0f); }
    }
    __syncthreads();
}
__device__ __forceinline__ void memkv_items(const float* const* in, unsigned char* ws, int gw, int NGW, int lane) {
    const bf16* A = (const bf16*)(ws + WS_MEMB); const bf16* Bt = (const bf16*)(ws + WS_WMKV);
    bf16* MK = (bf16*)(ws + WS_MEMK); bf16* MV = (bf16*)(ws + WS_MEMV);
    for (int id = gw; id < 32 * 8; id += NGW) {
        const int rt = id >> 3, ct = id & 7, fr = lane & 15, fq = lane >> 4;
        f32x4 acc[4];
#pragma unroll
        for (int nb = 0; nb < 4; ++nb) acc[nb] = (f32x4){0.f, 0.f, 0.f, 0.f};
        const bf16* ap = A + (size_t)(rt * 16 + fr) * D + fq * 8;
        const bf16* bp = Bt + (size_t)(ct * 64 + fr) * D + fq * 8;
#pragma unroll 4
        for (int ks = 0; ks < 32; ++ks) {
            const bf16x8 a = *(const bf16x8*)(ap + ks * 32);
#pragma unroll
            for (int nb = 0; nb < 4; ++nb) { const bf16x8 bb = *(const bf16x8*)(bp + (size_t)nb * 16 * D + ks * 32); acc[nb] = __builtin_amdgcn_mfma_f32_16x16x32_bf16(a, bb, acc[nb], 0, 0, 0); }
        }
        if (ct < 4) {
#pragma unroll
            for (int reg = 0; reg < 4; ++reg) { float ss = 0.f;
#pragma unroll
                for (int nb = 0; nb < 4; ++nb) ss += acc[nb][reg] * acc[nb][reg];
                ss += __shfl_xor(ss, 1); ss += __shfl_xor(ss, 2); ss += __shfl_xor(ss, 4); ss += __shfl_xor(ss, 8);
                const float rn = __builtin_amdgcn_rsqf(ss * (1.0f / 64.0f) + EPS);
#pragma unroll
                for (int nb = 0; nb < 4; ++nb) MK[(size_t)(rt * 16 + 4 * fq + reg) * 256 + ct * 64 + nb * 16 + fr] = (bf16)f2bf(acc[nb][reg] * rn * in[19][nb * 16 + fr]); }
        } else {
#pragma unroll
            for (int reg = 0; reg < 4; ++reg)
#pragma unroll
                for (int nb = 0; nb < 4; ++nb) MV[(size_t)(rt * 16 + 4 * fq + reg) * 256 + (ct - 4) * 64 + nb * 16 + fr] = (bf16)f2bf(acc[nb][reg]);
        }
    }
}
__device__ __forceinline__ float block_scores(LAS float* p, const float (&q)[64], const bf16* Kb, int pitch, float slope, int dist0, bool causal, int lane) {
    float mx = -INFINITY;
#pragma unroll 1
    for (int kk = 0; kk < 4; ++kk) {
        const int i = lane + 64 * kk; float acc = 0.f;
        const uint4* kp = (const uint4*)(Kb + (size_t)i * pitch);
#pragma unroll
        for (int c = 0; c < 8; ++c) { const uint4 w = kp[c];
            acc += q[8 * c + 0] * bflo(w.x) + q[8 * c + 1] * bfhi(w.x) + q[8 * c + 2] * bflo(w.y) + q[8 * c + 3] * bfhi(w.y)
                 + q[8 * c + 4] * bflo(w.z) + q[8 * c + 5] * bfhi(w.z) + q[8 * c + 6] * bflo(w.w) + q[8 * c + 7] * bfhi(w.w); }
        acc = acc * 0.125f - slope * (float)(dist0 - i);
        if (causal && i > dist0) acc = -INFINITY;
        p[i] = acc; mx = fmaxf(mx, acc);
    }
    return mx;
}
__device__ __forceinline__ float block_exp(LAS float* p, float mx, int lane) {
    float l = 0.f;
#pragma unroll
    for (int kk = 0; kk < 4; ++kk) { const float e = __expf(p[lane + 64 * kk] - mx); p[lane + 64 * kk] = e; l += e; }
    return l;
}
__device__ __forceinline__ float block_pv(float o, const LAS float* p, const bf16* Vb, int pitch, int lane) {
#pragma unroll 8
    for (int i = 0; i < 256; ++i) o += p[i] * bf2f(Vb[(size_t)i * pitch + lane]);
    return o;
}
__device__ __forceinline__ void load_q(float (&q)[64], const bf16* qp) {
    const uint4* p = (const uint4*)qp;
#pragma unroll
    for (int c = 0; c < 8; ++c) { const uint4 w = p[c]; q[8 * c + 0] = bflo(w.x); q[8 * c + 1] = bfhi(w.x); q[8 * c + 2] = bflo(w.y); q[8 * c + 3] = bfhi(w.y);
        q[8 * c + 4] = bflo(w.z); q[8 * c + 5] = bfhi(w.z); q[8 * c + 6] = bflo(w.w); q[8 * c + 7] = bfhi(w.w); }
}
__device__ __forceinline__ void moba_items(unsigned char* ws, LAS unsigned char* lds, int gw, int NGW, int wave, int lane) {
    const bf16* U = (const bf16*)(ws + WS_U); bf16* MIX = (bf16*)(ws + WS_MIX); const float* KM = (const float*)(ws + WS_KMEAN);
    LAS float* p = (LAS float*)(lds + RING_OFF) + wave * 1024;
#pragma unroll 1
    for (int id = gw; id < BATCH * 4 * (SEQ / 32); id += NGW) {
        const int bh = id / (SEQ / 32), tb = (id % (SEQ / 32)) * 32, b = bh >> 2, h = bh & 3, qb = tb >> 8;
        const float slope = exp2f(-2.0f * (float)(h + 1));
        const size_t rb = (size_t)b * SEQ;
        const bf16* Kh = U + rb * INW + 1280 + h * 64; const bf16* Vh = U + rb * INW + 1536 + h * 64;
#pragma unroll 1
        for (int qi = 0; qi < 32; ++qi) {
            const int t = tb + qi; const bf16* qp = U + (rb + t) * INW + 1024 + h * 64;
            const float ql = bf2f(qp[lane]);
            float g1 = -INFINITY, g2 = -INFINITY, g3 = -INFINITY; int i1 = 0, i2 = 0, i3 = 0;
#pragma unroll 1
            for (int j = 0; j < qb; ++j) { const float g = wave_sum(ql * KM[((size_t)bh * NBLK + j) * 64 + lane]);
                if (g > g1) { g3 = g2; i3 = i2; g2 = g1; i2 = i1; g1 = g; i1 = j; } else if (g > g2) { g3 = g2; i3 = i2; g2 = g; i2 = j; } else if (g > g3) { g3 = g; i3 = j; } }
            const int nok = qb < 3 ? qb : 3;
            int blk[4]; blk[0] = i1; blk[1] = i2; blk[2] = i3; blk[3] = qb;
            float q[64]; load_q(q, qp);
            float mx = -INFINITY;
#pragma unroll
            for (int sl = 0; sl < 4; ++sl) { const bool on = (sl == 3) || (sl < nok);
                if (on) mx = fmaxf(mx, block_scores(p + 256 * sl, q, Kh + (size_t)blk[sl] * 256 * INW, INW, slope, t - blk[sl] * 256, sl == 3, lane)); }
            mx = wave_max(mx);
            float l = 0.f, o = 0.f;
#pragma unroll
            for (int sl = 0; sl < 4; ++sl) { const bool on = (sl == 3) || (sl < nok);
                if (on) { l += block_exp(p + 256 * sl, mx, lane); o = block_pv(o, p + 256 * sl, Vh + (size_t)blk[sl] * 256 * INW, INW, lane); } }
            l = wave_sum(l);
            MIX[(rb + t) * D + 512 + h * 64 + lane] = (bf16)f2bf(o / l);
        }
    }
}
__device__ __forceinline__ void memattn_items(unsigned char* ws, LAS unsigned char* lds, int gw, int NGW, int wave, int lane) {
    const bf16* U = (const bf16*)(ws + WS_U); bf16* MIX = (bf16*)(ws + WS_MIX);
    LAS float* p = (LAS float*)(lds + RING_OFF) + wave * 1024;
#pragma unroll 1
    for (int id = gw; id < BATCH * 4 * (SEQ / 32); id += NGW) {
        const int bh = id / (SEQ / 32), tb = (id % (SEQ / 32)) * 32, b = bh >> 2, h = bh & 3;
        const size_t rb = (size_t)b * SEQ;
        const bf16* Kh = (const bf16*)(ws + WS_MEMK) + (size_t)b * MEMLEN * 256 + h * 64; const bf16* Vh = (const bf16*)(ws + WS_MEMV) + (size_t)b * MEMLEN * 256 + h * 64;
#pragma unroll 1
        for (int qi = 0; qi < 32; ++qi) {
            const int t = tb + qi; const bf16* qp = U + (rb + t) * INW + 1792 + h * 64;
            float q[64]; load_q(q, qp);
            const float mx = wave_max(block_scores(p, q, Kh, 256, 0.f, 0, false, lane));
            const float l = wave_sum(block_exp(p, mx, lane));
            const float o = block_pv(0.f, p, Vh, 256, lane);
            MIX[(rb + t) * D + 768 + h * 64 + lane] = (bf16)f2bf(o / l);
        }
    }
}
struct Args { const float* in[24]; float* out; unsigned char* ws; int ph_lo, ph_hi; };
__global__ void __launch_bounds__(NWAVES * 64, 2) hymba_fwd(Args args) {
    extern __shared__ __attribute__((aligned(16))) unsigned char lds[];
    LAS unsigned char* L = (LAS unsigned char*)lds;
    volatile LAS unsigned* MISC = (volatile LAS unsigned*)(L + MISC_OFF);
    const int tid = threadIdx.x, lane = tid & 63, wave = __builtin_amdgcn_readfirstlane(tid >> 6);
    const int G = gridDim.x; const int bx = blockIdx.x; const int vcu = (G % 8 == 0) ? (bx % 8) * (G / 8) + bx / 8 : bx;
    unsigned char* ws = args.ws; const float* const* in = args.in; float* out = args.out;
    gu32* ctl = (gu32*)(ws + WS_CTL);
    for (int u = tid; u < (LDS_BYTES - LDSCTL_OFF) / 4; u += NWAVES * 64) ((LAS unsigned*)(L + LDSCTL_OFF))[u] = 0u;
    __syncthreads();
    XcdBarrier bar; bar.bar = (unsigned*)(ctl + CW_BAR); bar.x = 0; bar.st = nullptr;
    if (N_LAUNCHES == 1) bar = xcd_barrier_post((unsigned*)(ctl + CW_BAR), MISC + 8);
#define GRID_BAR() do { if (N_LAUNCHES == 1) xcd_barrier(bar); } while (0)
    const int lo = args.ph_lo, hi = args.ph_hi;
#ifndef PH_MASK
#define PH_MASK 0x1ff
#endif
#define IN(k) (((PH_MASK >> (k)) & 1) && lo <= (k) && (k) < hi)
#define BOTH(k) (IN(k) && IN((k) + 1))
    bf16* XB = (bf16*)(ws + WS_XB); bf16* HB = (bf16*)(ws + WS_H); bf16* UB = (bf16*)(ws + WS_U); bf16* MIX = (bf16*)(ws + WS_MIX);
    float* SSQ0 = (float*)(ws + WS_SSQ0); float* SSQ1 = (float*)(ws + WS_SSQ1); float* SSQ2 = (float*)(ws + WS_SSQ2);
    const int gw = vcu * NWAVES + wave, NGW = G * NWAVES;

    if (IN(0)) { p0_prologue(in, ws, L, vcu, G, wave, lane);
        if (bx == 0 && tid < 192) ((float*)(ws + WS_GAINS))[tid] = (tid < 64 ? in[15][tid] : tid < 128 ? in[16][tid - 64] : in[18][tid - 128]); if (BOTH(0)) GRID_BAR(); }
    if (IN(1)) {
        pg8::Gemm g{XB, (const bf16*)(ws + WS_W1I), M, 2 * FF, D}; pg8::StaticOrder S; S.init(M, 2 * FF, G, bx);
        pg8::EpiSwiGLU E{HB, FF, SSQ0};
        pg8::gemm_phase<pg8::EpiSwiGLU, pg8::StaticOrder, PG8_ALIGN, PG8_SP2>(L + RING_OFF, g, S, E);
        if (BOTH(1)) GRID_BAR();
    }
    if (IN(2)) {
        pg8::Gemm g{HB, (const bf16*)(ws + WS_W1O), M, D, FF}; pg8::StaticOrder S; S.init(M, D, G, bx);
        pg8::EpiResid E{in[0], out, XB, SSQ1, 0.5f};
        pg8::gemm_phase<pg8::EpiResid, pg8::StaticOrder, false, PG8_SP2>(L + RING_OFF, g, S, E);
        if (BOTH(2)) GRID_BAR();
    }
    if (IN(3)) {
        pg8::Gemm g{XB, (const bf16*)(ws + WS_WIN), M, INW, D}; pg8::StaticOrder S; S.init(M, INW, G, bx);
        pg8::EpiWin E{UB, SSQ1, (const float*)(ws + WS_GAINS)};
        pg8::gemm_phase<pg8::EpiWin, pg8::StaticOrder, PG8_ALIGN, PG8_SP2>(L + RING_OFF, g, S, E);
        if (BOTH(3)) GRID_BAR();
    }
    if (IN(4)) {
        lru_items<false>(in, ws, L, G, wave, lane, tid);
        kmean_items(ws, L, G, wave, lane, tid);
        memkv_items(in, ws, gw, NGW, lane);
        if (BOTH(4)) GRID_BAR();
    }
    if (IN(5)) {
        lru_items<true>(in, ws, L, G, wave, lane, tid);
        moba_items(ws, L, gw, NGW, wave, lane);
        memattn_items(ws, L, gw, NGW, wave, lane);
        if (BOTH(5)) GRID_BAR();
    }
    if (IN(6)) {
        pg8::Gemm g{MIX, (const bf16*)(ws + WS_WOUT), M, D, D}; pg8::StaticOrder S; S.init(M, D, G, bx);
        pg8::EpiResid E{out, out, XB, SSQ2, 1.0f};
        pg8::gemm_phase<pg8::EpiResid, pg8::StaticOrder, false, PG8_SP2>(L + RING_OFF, g, S, E);
        if (BOTH(6)) GRID_BAR();
    }
    if (IN(7)) {
        pg8::Gemm g{XB, (const bf16*)(ws + WS_W2I), M, 2 * FF, D}; pg8::StaticOrder S; S.init(M, 2 * FF, G, bx);
        pg8::EpiSwiGLU E{HB, FF, SSQ2};
        pg8::gemm_phase<pg8::EpiSwiGLU, pg8::StaticOrder, PG8_ALIGN, PG8_SP2>(L + RING_OFF, g, S, E);
        if (BOTH(7)) GRID_BAR();
    }
    if (IN(8)) {
        pg8::Gemm g{HB, (const bf16*)(ws + WS_W2O), M, D, FF}; pg8::StaticOrder S; S.init(M, D, G, bx);
        pg8::EpiResid E{out, out, nullptr, nullptr, 0.5f};
        pg8::gemm_phase<pg8::EpiResid, pg8::StaticOrder, false, PG8_SP2>(L + RING_OFF, g, S, E);
    }
#undef IN
#undef BOTH
}

extern "C" void kernel_launch(void* const* d_in, const int* in_sizes, int n_in, void* d_out, int out_size, void* d_ws, size_t ws_size, hipStream_t stream) {
    static int grid = 0;
    if (grid == 0) {
        if (n_in != 24 || in_sizes[0] != M * D || out_size != M * D || ws_size < WS_END) { fprintf(stderr, "kernel_launch: unexpected shapes (n_in %d, in0 %d, out %d, ws %zu); nothing launched\n", n_in, n_in > 0 ? in_sizes[0] : -1, out_size, ws_size); grid = -1; return; }
        int dev = 0, cus = 0, per_cu = 0;
        if (hipGetDevice(&dev) != hipSuccess || hipDeviceGetAttribute(&cus, hipDeviceAttributeMultiprocessorCount, dev) != hipSuccess) { fprintf(stderr, "kernel_launch: device query failed\n"); grid = -1; return; }
        if (hipFuncSetAttribute((const void*)hymba_fwd, hipFuncAttributeMaxDynamicSharedMemorySize, LDS_BYTES) != hipSuccess) { fprintf(stderr, "kernel_launch: hipFuncSetAttribute failed\n"); grid = -1; return; }
        if (hipOccupancyMaxActiveBlocksPerMultiprocessor(&per_cu, (const void*)hymba_fwd, NWAVES * 64, LDS_BYTES) != hipSuccess) per_cu = 0;
        (void)hipGetLastError();
        if (per_cu < 1 || cus * per_cu < 256) { fprintf(stderr, "kernel_launch: the persistent grid of 256 workgroups is not resident (cus %d, per_cu %d); nothing launched\n", cus, per_cu); grid = -1; return; }
        grid = 256;
    }
    if (grid < 0) return;
    if (hipMemsetAsync((char*)d_ws + WS_CTL, 0, CTL_ZERO_BYTES, stream) != hipSuccess) { fprintf(stderr, "kernel_launch: hipMemsetAsync failed\n"); return; }
    Args a{};
    for (int i = 0; i < 24; ++i) a.in[i] = (const float*)d_in[i];
    a.out = (float*)d_out; a.ws = (unsigned char*)d_ws;
    if (N_LAUNCHES == 1) { a.ph_lo = 0; a.ph_hi = NPHASE; hipLaunchKernelGGL(hymba_fwd, dim3(grid), dim3(NWAVES * 64), LDS_BYTES, stream, a); }
    else for (int p = 0; p < NPHASE; ++p) { a.ph_lo = p; a.ph_hi = p + 1; hipLaunchKernelGGL(hymba_fwd, dim3(grid), dim3(NWAVES * 64), LDS_BYTES, stream, a); }
    const hipError_t le = hipPeekAtLastError();
    if (le != hipSuccess) fprintf(stderr, "kernel_launch: launch failed: %s\n", hipGetErrorName(le));
}
```

```cpp
#define PG8_RSLDS true
#define PG8_RESIDLDS true
#define WT_ALL 1
#include <hip/hip_runtime.h>
#include <cstdio>
#include <cstdint>
typedef unsigned wt_v4u __attribute__((ext_vector_type(4)));
typedef float wt_f4 __attribute__((ext_vector_type(4)));
#ifdef WT_ALL
__device__ __forceinline__ void wt_st16(void* p, wt_v4u v) { asm volatile("global_store_dwordx4 %0, %1, off sc1\n\ts_nop 1" :: "v"(p), "v"(v) : "memory"); }
__device__ __forceinline__ void wt_st16f(void* p, wt_f4 v) { asm volatile("global_store_dwordx4 %0, %1, off sc1\n\ts_nop 1" :: "v"(p), "v"(v) : "memory"); }
__device__ __forceinline__ void wt_st8(void* p, unsigned long long v) { __hip_atomic_store((unsigned long long*)p, v, __ATOMIC_RELAXED, __HIP_MEMORY_SCOPE_AGENT); }
__device__ __forceinline__ void wt_st4(void* p, unsigned v) { __hip_atomic_store((unsigned*)p, v, __ATOMIC_RELAXED, __HIP_MEMORY_SCOPE_AGENT); }
__device__ __forceinline__ void wt_st4f(void* p, float v) { __hip_atomic_store((float*)p, v, __ATOMIC_RELAXED, __HIP_MEMORY_SCOPE_AGENT); }
__device__ __forceinline__ void wt_st2(void* p, unsigned v) { asm volatile("global_store_short %0, %1, off sc1" :: "v"(p), "v"(v) : "memory"); }
#else
__device__ __forceinline__ void wt_st16(void* p, wt_v4u v) { *(__attribute__((address_space(1))) wt_v4u*)p = v; }
__device__ __forceinline__ void wt_st16f(void* p, wt_f4 v) { *(__attribute__((address_space(1))) wt_f4*)p = v; }
__device__ __forceinline__ void wt_st8(void* p, unsigned long long v) { *(__attribute__((address_space(1))) unsigned long long*)p = v; }
__device__ __forceinline__ void wt_st4(void* p, unsigned v) { *(__attribute__((address_space(1))) unsigned*)p = v; }
__device__ __forceinline__ void wt_st4f(void* p, float v) { *(__attribute__((address_space(1))) float*)p = v; }
__device__ __forceinline__ void wt_st2(void* p, unsigned v) { *(__attribute__((address_space(1))) unsigned short*)p = (unsigned short)v; }
#endif
#ifndef PG8_BTILED
#define PG8_BTILED 0
#endif
#ifndef PG8_SPLITEPI
#define PG8_SPLITEPI false
#endif
namespace pg8 {
#define PG8_LAS __attribute__((address_space(3)))
typedef unsigned short bf16_t;
typedef short bf16x8 __attribute__((ext_vector_type(8)));
typedef float f32x4 __attribute__((ext_vector_type(4)));
typedef unsigned u32x4 __attribute__((ext_vector_type(4)));
constexpr int BM = 256, BK = 64, HALF = 128, HTB = HALF * BK * 2  , STAGE_BYTES = 8 * HTB, NXCD = 8, WGM = 4;

__host__ __device__ __forceinline__ int lds_byte(int r, int c) { const int st = (r >> 4) * 2 + (c >> 5), rr = r & 15, cc = c & 31, ob = rr * 64 + cc * 2; return st * 1024 + (ob ^ (((ob >> 9) & 1) << 5)); }
__host__ __device__ __forceinline__ void stage_rc(int b, int& R, int& C) { const int st = b / 1024, sb = b % 1024, swz = sb ^ (((sb >> 9) & 1) << 5); R = (st >> 1) * 16 + swz / 64; C = (st & 1) * 32 + (swz % 64) / 2; }
__host__ __device__ __forceinline__ int perm32(int rho) { const int n = rho >> 4, i = rho & 15; return 8 * (i >> 2) + 4 * n + (i & 3); }

struct Unit { int pm, pn, hm; };
struct Gemm { const bf16_t* A; const bf16_t* Bt; int M, N, K; int nomma = 0; };

struct StaticOrder {
    int nM, nN, nwg, G, c;
    __host__ __device__ void init(int M, int N, int G_, int c_) { nM = M / BM; nN = N / BM; nwg = nM * nN; G = G_; c = c_; }
    __host__ __device__ bool map(long L, Unit& u) const {
        if (L >= nwg) return false;
        int wgid = (int)L; { const int q = nwg / NXCD, r = nwg % NXCD, xcd = wgid % NXCD, off = wgid / NXCD; wgid = (xcd < r ? xcd * (q + 1) : r * (q + 1) + (xcd - r) * q) + off; }
        const int nig = WGM * nN, gid = wgid / nig, fm = gid * WGM, gsz = (nM - fm) < WGM ? (nM - fm) : WGM;
        u.pm = fm + ((wgid % nig) % gsz); u.pn = (wgid % nig) / gsz; u.hm = 0; return true;
    }
    __host__ __device__ bool next(int i, Unit& u) const { return map((long)i * G + c, u); }
    __device__ __forceinline__ void a_ready(const Unit&) const {}
    __device__ __forceinline__ void done(const Unit&) const {}
};

__device__ __forceinline__ unsigned cvt_pk_bf16(float lo, float hi) { unsigned r; asm volatile("v_cvt_pk_bf16_f32 %0, %1, %2" : "=v"(r) : "v"(lo), "v"(hi)); return r; }
typedef float f32x2 __attribute__((ext_vector_type(2)));

template <class Epi, class Sched, bool ALIGN_EPI = false, bool SP2 = false>
__device__ __forceinline__ void gemm_phase(PG8_LAS unsigned char* lds, const Gemm g, const Sched& S, const Epi& E, const int wid) {
    int lane; asm volatile("v_mbcnt_lo_u32_b32 %0, -1, 0\n\tv_mbcnt_hi_u32_b32 %0, -1, %0" : "=v"(lane));
    const int tid = wid * 64 + lane, wr = wid >> 2, wc = wid & 3, fr = lane & 15, fq = lane >> 4;
    const int K = g.K, nt = K / BK;
    static_assert(!PG8_BTILED || SP2, "the tiled weight layout is wired into the SP2 loop only");
    unsigned voffA[2], voffB[2];
#pragma unroll
    for (int i = 0; i < 2; ++i) { int R, C; stage_rc(tid * 16 + i * 8192, R, C); const int Rb = Epi::PERM ? ((R & ~31) + perm32(R & 31)) : R;
        voffA[i] = (unsigned)(R * K + C) * 2u; voffB[i] = PG8_BTILED ? (unsigned)(tid * 16 + i * 8192) : (unsigned)(Rb * K + C) * 2u; }
    const size_t kstep = (size_t)(BK * 2);
    const size_t kstepB = PG8_BTILED ? (size_t)(HALF * BK * 2) : kstep;
    const size_t hstep = (size_t)HALF * K * 2;
    const size_t tstep = 2 * hstep;
    const unsigned ldsw = (unsigned)wid * 1024u;
    const int aoff = lds_byte(wr * 64 + fr, fq * 8), boff = lds_byte(wc * 32 + fr, fq * 8);
#define PG8_SA(b, h) (((b) * 2 + (h)) * HTB)
#define PG8_SB(b, h) ((4 + (b) * 2 + (h)) * HTB)
#define PG8_STAGE(bufoff, gbase, voff) do { _Pragma("unroll") for (int _i = 0; _i < 2; ++_i) \
        __builtin_amdgcn_global_load_lds((const unsigned*)((const char*)(gbase) + (voff)[_i]), (PG8_LAS unsigned*)(lds + (bufoff) + ldsw + _i * 8192), 16, 0, 0); } while (0)
#define PG8_LDA(dst, b, h) do { _Pragma("unroll") for (int m = 0; m < 4; ++m) _Pragma("unroll") for (int k = 0; k < 2; ++k) dst[m][k] = *(const PG8_LAS bf16x8*)(lds + PG8_SA(b, h) + aoff + m * 2048 + k * 1024); } while (0)
#define PG8_LDB(dst, b, h) do { _Pragma("unroll") for (int n = 0; n < 2; ++n) _Pragma("unroll") for (int k = 0; k < 2; ++k) dst[n][k] = *(const PG8_LAS bf16x8*)(lds + PG8_SB(b, h) + boff + n * 2048 + k * 1024); } while (0)
#define PG8_MMA(ai, bj, At, Bt) do { PG8_NOMMA_GUARD __builtin_amdgcn_s_setprio(1); _Pragma("unroll") for (int m = 0; m < 4; ++m) _Pragma("unroll") for (int n = 0; n < 2; ++n) _Pragma("unroll") for (int k = 0; k < 2; ++k) \
        { acc[ai][bj][m][n] = __builtin_amdgcn_mfma_f32_16x16x32_bf16(Bt[n][k], At[m][k], acc[ai][bj][m][n], 0, 0, 0); PG8_EXTRA_MFMA(acc[ai][bj][m][n], At[m][k]); } __builtin_amdgcn_s_setprio(0); } while (0)
#ifndef PG8_DMASPLIT
#define PG8_DMASPLIT 0
#endif
#ifdef PROBE_NOMMA
#define PG8_NOMMA_GUARD if (g.nomma) break;
#else
#define PG8_NOMMA_GUARD
#endif
#ifdef PROBE_DOUBLE_MFMA
#define PG8_EXTRA_MFMA(C, A) do { bf16x8 z_ = {0,0,0,0,0,0,0,0}; asm volatile("" : "+v"(z_)); C = __builtin_amdgcn_mfma_f32_16x16x32_bf16(z_, A, C, 0, 0, 0); } while (0)
#else
#define PG8_EXTRA_MFMA(C, A) do {} while (0)
#endif
#define PG8_WAIT_V(n) asm volatile("s_waitcnt vmcnt(" #n ")" ::: "memory")
#define PG8_WAIT_L(n) asm volatile("s_waitcnt lgkmcnt(" #n ")" ::: "memory")
#define PG8_BAR __builtin_amdgcn_s_barrier()
#define PG8_SCHED __builtin_amdgcn_sched_barrier(0)
    Unit cur, nxt; int ui = 0;
    if (!S.next(0, cur)) return;
    f32x4 acc[2][2][4][2];
#pragma unroll
    for (int a = 0; a < 2; ++a)
#pragma unroll
        for (int b = 0; b < 2; ++b)
#pragma unroll
            for (int m = 0; m < 4; ++m)
#pragma unroll
                for (int n = 0; n < 2; ++n) acc[a][b][m][n] = (f32x4){0.f, 0.f, 0.f, 0.f};
    bf16x8 At[4][2], B0[2][2], B1[2][2];
    PG8_LAS float* const RSL = (PG8_LAS float*)(lds + STAGE_BYTES + 2048);
    unsigned voffR[2] = {0u, 0u};
    if constexpr (Epi::RESID_LDS) {
#pragma unroll
        for (int i = 0; i < 2; ++i) voffR[i] = (unsigned)((16 * i + (lane & 15)) * 2048 + (4 * wid + (lane >> 4)) * 16);
    }
    constexpr size_t RSB = (size_t)32 * 2048;
    const char* cA = (const char*)g.A + (size_t)cur.pm * tstep + (cur.hm == 2 ? hstep : (size_t)0); const char* cB = (const char*)g.Bt + (size_t)cur.pn * tstep;
    size_t hsC = cur.hm ? (size_t)0 : hstep;
    S.a_ready(cur);
    if constexpr (SP2) {
        PG8_STAGE(PG8_SB(0, 0), cB, voffB); PG8_STAGE(PG8_SB(0, 1), cB + hstep, voffB); PG8_STAGE(PG8_SA(0, 0), cA, voffA); PG8_STAGE(PG8_SA(0, 1), cA + hsC, voffA);
        if (wr == 1) PG8_BAR;
        PG8_WAIT_V(2); PG8_BAR;
        PG8_STAGE(PG8_SB(1, 0), cB + kstepB, voffB); PG8_STAGE(PG8_SA(1, 0), cA + kstep, voffA); PG8_STAGE(PG8_SB(1, 1), cB + hstep + kstepB, voffB);
        PG8_WAIT_V(6); PG8_BAR;
    } else {
        PG8_STAGE(PG8_SB(0, 0), cB, voffB); PG8_STAGE(PG8_SA(0, 0), cA, voffA); PG8_STAGE(PG8_SB(0, 1), cB + hstep, voffB); PG8_STAGE(PG8_SA(0, 1), cA + hstep, voffA);
        if (wr == 1) PG8_BAR;
        PG8_WAIT_V(4); PG8_BAR;
        PG8_STAGE(PG8_SB(1, 0), cB + kstep, voffB); PG8_STAGE(PG8_SA(1, 0), cA + kstep, voffA); PG8_STAGE(PG8_SB(1, 1), cB + hstep + kstep, voffB);
        PG8_WAIT_V(6); PG8_BAR;
    }
    for (;;) {
        const bool has_next = S.next(ui + 1, nxt);
        const char* nA = has_next ? (const char*)g.A + (size_t)nxt.pm * tstep + (nxt.hm == 2 ? hstep : (size_t)0) : cA; const char* nB = has_next ? (const char*)g.Bt + (size_t)nxt.pn * tstep : cB;
        const size_t hsN = has_next ? (nxt.hm ? (size_t)0 : hstep) : hsC; const bool halfu = cur.hm != 0;
        for (int t = 0; t < nt; t += 2) {
            const bool last = (t == nt - 2); f32x2 rsE;
            const char* a1 = cA + (size_t)(t + 1) * kstep;
            const char* a2 = last ? nA : cA + (size_t)(t + 2) * kstep; const char* b2 = last ? nB : cB + (size_t)(t + 2) * kstepB;
            const char* a3 = a2 + kstep; const char* b3 = b2 + kstepB;
            if (last && has_next) S.a_ready(nxt);
            bool rl = false; const char* rT = cA;
            if constexpr (Epi::RESID_LDS) { rl = last && !has_next; rT = (const char*)E.base + ((size_t)cur.pm * BM * 1024 + (size_t)cur.pn * BM) * 2; }
            const unsigned vA_[2] = {rl ? voffR[0] : voffA[0], rl ? voffR[1] : voffA[1]}, vB_[2] = {rl ? voffR[0] : voffB[0], rl ? voffR[1] : voffB[1]};
            if constexpr (SP2) {
            if constexpr (Epi::RS_LDS) { if (last) { const float* rp_ = E.ssq + ((size_t)(cur.pm * BM + (tid >> 1)) * 4 + (tid & 1) * 2); asm volatile("global_load_dwordx2 %0, %1, off" : "=v"(rsE) : "v"(rp_) : "memory"); } }
            PG8_LDB(B0, 0, 0); PG8_LDB(B1, 0, 1); PG8_SCHED; PG8_LDA(At, 0, 0); PG8_STAGE(PG8_SA(1, 1), a1 + hsC, voffA);
            PG8_WAIT_V(8); PG8_WAIT_L(0); PG8_BAR; PG8_MMA(0, 0, At, B0); PG8_MMA(0, 1, At, B1); PG8_BAR; PG8_SCHED;
#if PG8_DMASPLIT == 0
            if (!halfu) PG8_LDA(At, 0, 1); PG8_STAGE(PG8_SB(0, 0), rl ? rT + 4 * RSB : b2, vB_); PG8_STAGE(PG8_SB(0, 1), rl ? rT + 5 * RSB : b2 + hstep, vB_); PG8_STAGE(PG8_SA(0, 0), rl ? rT : a2, vA_);
            PG8_WAIT_V(8); PG8_WAIT_L(0); PG8_BAR; if (!halfu) { PG8_MMA(1, 0, At, B0); PG8_MMA(1, 1, At, B1); } PG8_BAR; PG8_SCHED;
#elif PG8_DMASPLIT == 1
            if (!halfu) PG8_LDA(At, 0, 1); PG8_STAGE(PG8_SB(0, 0), rl ? rT + 4 * RSB : b2, vB_); PG8_STAGE(PG8_SB(0, 1), rl ? rT + 5 * RSB : b2 + hstep, vB_);
            PG8_WAIT_V(6); PG8_WAIT_L(0); PG8_BAR; if (!halfu) PG8_MMA(1, 0, At, B0); PG8_SCHED; PG8_STAGE(PG8_SA(0, 0), rl ? rT : a2, vA_); PG8_SCHED; if (!halfu) PG8_MMA(1, 1, At, B1); PG8_BAR; PG8_SCHED;
#else
            if (!halfu) PG8_LDA(At, 0, 1); PG8_STAGE(PG8_SB(0, 0), rl ? rT + 4 * RSB : b2, vB_);
            PG8_WAIT_V(4); PG8_WAIT_L(0); PG8_BAR; if (!halfu) PG8_MMA(1, 0, At, B0); PG8_SCHED; PG8_STAGE(PG8_SB(0, 1), rl ? rT + 5 * RSB : b2 + hstep, vB_); PG8_STAGE(PG8_SA(0, 0), rl ? rT : a2, vA_); PG8_SCHED; if (!halfu) PG8_MMA(1, 1, At, B1); PG8_BAR; PG8_SCHED;
#endif
            if constexpr (Epi::RS_LDS) { if (last) { asm volatile("" : "+v"(rsE)); float s_ = rsE[0] + rsE[1]; s_ += __shfl_xor(s_, 1); RSL[tid >> 1] = __builtin_amdgcn_rsqf(s_ * (1.0f / 1024.0f) + 1e-6f); } }
            PG8_LDB(B0, 1, 0); PG8_LDB(B1, 1, 1); PG8_SCHED; PG8_LDA(At, 1, 0); PG8_STAGE(PG8_SA(0, 1), rl ? rT + RSB : a2 + (last ? hsN : hsC), vA_);
            PG8_WAIT_V(8); PG8_WAIT_L(0); PG8_BAR; PG8_MMA(0, 0, At, B0); PG8_MMA(0, 1, At, B1); PG8_BAR; PG8_SCHED;
#if PG8_DMASPLIT == 0
            if (!halfu) PG8_LDA(At, 1, 1); PG8_STAGE(PG8_SB(1, 0), rl ? rT + 6 * RSB : b3, vB_); PG8_STAGE(PG8_SB(1, 1), rl ? rT + 7 * RSB : b3 + hstep, vB_); PG8_STAGE(PG8_SA(1, 0), rl ? rT + 2 * RSB : a3, vA_);
            PG8_WAIT_V(8); PG8_WAIT_L(0);
            if constexpr (PG8_SPLITEPI && !Epi::AFTER_DRAIN) { if (last) { PG8_SCHED; E.template operator()<0, 1>(acc, cur, wr, wc, fr, fq, RSL); PG8_SCHED; } }
            PG8_BAR; if (!halfu) { PG8_MMA(1, 0, At, B0); PG8_MMA(1, 1, At, B1); } PG8_BAR; PG8_SCHED;
#elif PG8_DMASPLIT == 1
            if (!halfu) PG8_LDA(At, 1, 1); PG8_STAGE(PG8_SB(1, 0), rl ? rT + 6 * RSB : b3, vB_); PG8_STAGE(PG8_SB(1, 1), rl ? rT + 7 * RSB : b3 + hstep, vB_);
            PG8_WAIT_V(6); PG8_WAIT_L(0); PG8_BAR; if (!halfu) PG8_MMA(1, 0, At, B0); PG8_SCHED; PG8_STAGE(PG8_SA(1, 0), rl ? rT + 2 * RSB : a3, vA_); PG8_SCHED; if (!halfu) PG8_MMA(1, 1, At, B1); PG8_BAR; PG8_SCHED;
#else
            if (!halfu) PG8_LDA(At, 1, 1); PG8_STAGE(PG8_SB(1, 0), rl ? rT + 6 * RSB : b3, vB_);
            PG8_WAIT_V(4); PG8_WAIT_L(0); PG8_BAR; if (!halfu) PG8_MMA(1, 0, At, B0); PG8_SCHED; PG8_STAGE(PG8_SB(1, 1), rl ? rT + 7 * RSB : b3 + hstep, vB_); PG8_STAGE(PG8_SA(1, 0), rl ? rT + 2 * RSB : a3, vA_); PG8_SCHED; if (!halfu) PG8_MMA(1, 1, At, B1); PG8_BAR; PG8_SCHED;
#endif
            } else {
            PG8_LDB(B0, 0, 0); PG8_SCHED; PG8_LDA(At, 0, 0); PG8_STAGE(PG8_SA(1, 1), a1 + hstep, voffA);
            PG8_WAIT_L(8); PG8_BAR; PG8_WAIT_L(0); PG8_MMA(0, 0, At, B0); PG8_BAR; PG8_SCHED;
            PG8_LDB(B1, 0, 1); PG8_STAGE(PG8_SB(0, 0), b2, voffB);
            PG8_BAR; PG8_WAIT_L(0); PG8_MMA(0, 1, At, B1); PG8_BAR;
            PG8_LDA(At, 0, 1); PG8_STAGE(PG8_SA(0, 0), a2, voffA);
            PG8_BAR; PG8_WAIT_L(0); PG8_MMA(1, 0, At, B0); PG8_BAR; PG8_SCHED;
            PG8_STAGE(PG8_SB(0, 1), b2 + hstep, voffB);
            PG8_WAIT_V(6); PG8_BAR; PG8_MMA(1, 1, At, B1); PG8_BAR;
            PG8_LDB(B0, 1, 0); PG8_SCHED; PG8_LDA(At, 1, 0); PG8_STAGE(PG8_SA(0, 1), a2 + hstep, voffA);
            PG8_WAIT_L(8); PG8_BAR; PG8_WAIT_L(0); PG8_MMA(0, 0, At, B0); PG8_BAR; PG8_SCHED;
            PG8_LDB(B1, 1, 1); PG8_STAGE(PG8_SB(1, 0), b3, voffB);
            PG8_BAR; PG8_WAIT_L(0); PG8_MMA(0, 1, At, B1); PG8_BAR;
            PG8_LDA(At, 1, 1); PG8_STAGE(PG8_SA(1, 0), a3, voffA);
            PG8_BAR; PG8_WAIT_L(0); PG8_MMA(1, 0, At, B0); PG8_BAR; PG8_SCHED;
            PG8_STAGE(PG8_SB(1, 1), b3 + hstep, voffB);
            PG8_WAIT_V(6); PG8_BAR; PG8_MMA(1, 1, At, B1); PG8_BAR;
            }
        }
        if constexpr (ALIGN_EPI) { if (wr == 0) PG8_BAR; }
        if constexpr (!Epi::AFTER_DRAIN) { if constexpr (PG8_SPLITEPI) E.template operator()<1, 2>(acc, cur, wr, wc, fr, fq, RSL); else E(acc, cur, wr, wc, fr, fq, RSL);
#ifdef PROBE_EPI2
            asm volatile("" ::: "memory"); E(acc, cur, wr, wc, fr, fq, RSL);
#endif
            S.done(cur); }
        if (!has_next) break;
#pragma unroll
        for (int a = 0; a < 2; ++a)
#pragma unroll
            for (int b = 0; b < 2; ++b)
#pragma unroll
                for (int m = 0; m < 4; ++m)
#pragma unroll
                    for (int n = 0; n < 2; ++n) acc[a][b][m][n] = (f32x4){0.f, 0.f, 0.f, 0.f};
        cur = nxt; cA = nA; cB = nB; hsC = hsN; ++ui;
        if constexpr (ALIGN_EPI) { if (wr == 1) PG8_BAR; }
    }
    PG8_WAIT_V(0);
    if constexpr (!ALIGN_EPI) { if (wr == 0) PG8_BAR; }
    PG8_BAR;
    if constexpr (Epi::AFTER_DRAIN) { E.fused(acc, cur, wr, wc, fr, fq, lds, wid, lane); S.done(cur); }
#undef PG8_SA
#undef PG8_SB
#undef PG8_STAGE
#undef PG8_LDA
#undef PG8_LDB
#undef PG8_MMA
#undef PG8_WAIT_V
#undef PG8_WAIT_L
#undef PG8_BAR
#undef PG8_SCHED
}
}
namespace pg8 {
#ifndef PG8_RSLDS
#define PG8_RSLDS false
#endif
#ifndef PG8_RESIDLDS
#define PG8_RESIDLDS false
#endif
constexpr float NORM_EPS_F = 1e-6f;
__device__ __forceinline__ float row_rs(const float* ssq4, int row) {
    const f32x4 s = *(const __attribute__((address_space(1))) f32x4*)(ssq4 + (size_t)row * 4);
    return __builtin_amdgcn_rsqf(((s[0] + s[1]) + (s[2] + s[3])) * (1.0f / 1024.0f) + NORM_EPS_F);
}
__device__ __forceinline__ float silu_mul(float a, float b) { return a * __builtin_amdgcn_rcpf(1.0f + __expf(-a)) * b; }
struct TailHalfOrder : StaticOrder {
    __host__ __device__ bool next(int i, Unit& u) const {
        const int rem = nwg % G, nfull = nwg / G;
        if (rem == 0 || 2 * rem != G || (G % 16) != 0 || (nwg % NXCD) != 0) return StaticOrder::next(i, u);
        if (i < nfull) return StaticOrder::next(i, u);
        if (i > nfull) return false;
        const int x = c % NXCD, q = c / NXCD;
        if (!map((long)nfull * G + x + NXCD * (q >> 1), u)) return false;
        u.hm = 1 + (q & 1); return true;
    }
};
struct EpiSwiGLU {
    static constexpr bool PERM = true, AFTER_DRAIN = false, RS_LDS = PG8_RSLDS, RESID_LDS = false;
    bf16_t* H; int ldh; const float* ssq;
    static __device__ __forceinline__ f32x4 swiglu4(f32x4 a, f32x4 b, float rs) {
        const f32x4 t = a * rs, u = t * (-1.4426950408889634f);
        f32x4 e; e[0] = __builtin_amdgcn_exp2f(u[0]); e[1] = __builtin_amdgcn_exp2f(u[1]); e[2] = __builtin_amdgcn_exp2f(u[2]); e[3] = __builtin_amdgcn_exp2f(u[3]);
        const f32x4 d = e + 1.0f;
        f32x4 s; s[0] = __builtin_amdgcn_rcpf(d[0]); s[1] = __builtin_amdgcn_rcpf(d[1]); s[2] = __builtin_amdgcn_rcpf(d[2]); s[3] = __builtin_amdgcn_rcpf(d[3]);
        return (t * s) * (b * rs);
    }
    template <int AI_LO = 0, int AI_HI = 2>
    __device__ __forceinline__ void operator()(const f32x4 (&acc)[2][2][4][2], const Unit& u, int wr, int wc, int fr, int fq, const PG8_LAS float* rsl) const {
        const int row0 = u.pm * BM + wr * 64 + fr + (u.hm == 2 ? HALF : 0), col0 = u.pn * HALF + wc * 32 + 8 * fq;
        float rsv[2][4];
#pragma unroll
        for (int ai = AI_LO; ai < AI_HI; ++ai)
#pragma unroll
            for (int m = 0; m < 4; ++m) rsv[ai][m] = RS_LDS ? rsl[wr * 64 + fr + ai * HALF + m * 16] : row_rs(ssq, row0 + ai * HALF + m * 16);
#pragma unroll
        for (int ai = AI_LO; ai < AI_HI; ++ai) if (ai == 0 || u.hm == 0)
#pragma unroll
            for (int m = 0; m < 4; ++m) { const int row = row0 + ai * HALF + m * 16; const float rs = rsv[ai][m];
                const f32x4 h0 = swiglu4(acc[ai][0][m][0], acc[ai][1][m][0], rs), h1 = swiglu4(acc[ai][0][m][1], acc[ai][1][m][1], rs);
                u32x4 w; w.x = cvt_pk_bf16(h0[0], h0[1]); w.y = cvt_pk_bf16(h0[2], h0[3]); w.z = cvt_pk_bf16(h1[0], h1[1]); w.w = cvt_pk_bf16(h1[2], h1[3]);
                wt_st16(H + (size_t)row * ldh + col0, w); }
    }
};
__device__ __forceinline__ float bflo_(unsigned w) { return __uint_as_float(w << 16); }
__device__ __forceinline__ float bfhi_(unsigned w) { return __uint_as_float(w & 0xffff0000u); }
struct EpiResid {
    static constexpr bool PERM = true, AFTER_DRAIN = true, RS_LDS = false, RESID_LDS = PG8_RESIDLDS;
    const bf16_t* base; bf16_t* ob; float* outf; float* ssq_out; float alpha;
    __device__ __forceinline__ void fused(f32x4 (&acc)[2][2][4][2], const Unit& u, int wr, int wc, int fr, int fq, PG8_LAS unsigned char* lds, int wid, int lane) const {
        PG8_LAS float* P = (PG8_LAS float*)(lds + (RESID_LDS ? STAGE_BYTES + 4096 : 0));
        const int col0 = u.pn * BM + wc * 32 + 8 * fq;
        u32x4 bw[2][4][2];
        if constexpr (RESID_LDS) {
            if (wr == 1) {
#pragma unroll
                for (int m = 2; m < 4; ++m) { const size_t off = (size_t)(u.pm * BM + wr * 64 + m * 16 + fr) * 1024 + col0;
#pragma unroll
                    for (int bj = 0; bj < 2; ++bj) bw[0][m][bj] = *(const __attribute__((address_space(1))) u32x4*)(base + off + bj * HALF); } }
#pragma unroll
            for (int ai = 0; ai < 2; ++ai)
#pragma unroll
                for (int m = 0; m < 4; ++m) { const int s = ai * 4 + wr * 2 + (m >> 1);
                    if (!(ai == 0 && m >= 2 && wr == 1)) {
#pragma unroll
                        for (int bj = 0; bj < 2; ++bj) bw[ai][m][bj] = *(const PG8_LAS u32x4*)(lds + s * 16384 + (m & 1) * 8192 + (bj * 4 + wc) * 1024 + lane * 16); } }
        } else {
#pragma unroll
        for (int ai = 0; ai < 2; ++ai)
#pragma unroll
            for (int m = 0; m < 4; ++m) { const size_t off = (size_t)(u.pm * BM + ai * HALF + wr * 64 + m * 16 + fr) * 1024 + col0;
#pragma unroll
                for (int bj = 0; bj < 2; ++bj) bw[ai][m][bj] = *(const __attribute__((address_space(1))) u32x4*)(base + off + bj * HALF); }
        }
#pragma unroll
        for (int ai = 0; ai < 2; ++ai)
#pragma unroll
            for (int m = 0; m < 4; ++m) { const int r = ai * HALF + wr * 64 + m * 16 + fr; const size_t off = (size_t)(u.pm * BM + r) * 1024 + col0; float q = 0.f;
#pragma unroll
                for (int bj = 0; bj < 2; ++bj) { const u32x4 w = bw[ai][m][bj];
                    const f32x4 b0 = (f32x4){bflo_(w.x), bfhi_(w.x), bflo_(w.y), bfhi_(w.y)}, b1 = (f32x4){bflo_(w.z), bfhi_(w.z), bflo_(w.w), bfhi_(w.w)};
                    const f32x4 o0 = b0 + acc[ai][bj][m][0] * alpha, o1 = b1 + acc[ai][bj][m][1] * alpha;
                    q += ((o0[0] * o0[0] + o0[1] * o0[1]) + (o0[2] * o0[2] + o0[3] * o0[3])) + ((o1[0] * o1[0] + o1[1] * o1[1]) + (o1[2] * o1[2] + o1[3] * o1[3]));
                    if (ob) { u32x4 v; v.x = cvt_pk_bf16(o0[0], o0[1]); v.y = cvt_pk_bf16(o0[2], o0[3]); v.z = cvt_pk_bf16(o1[0], o1[1]); v.w = cvt_pk_bf16(o1[2], o1[3]); wt_st16(ob + off + bj * HALF, v); }
                    if (outf) { *(__attribute__((address_space(1))) f32x4*)(outf + off + bj * HALF) = o0; *(__attribute__((address_space(1))) f32x4*)(outf + off + bj * HALF + 4) = o1; } }
                q += __shfl_xor(q, 16); q += __shfl_xor(q, 32);
                if (fq == 0) P[r * 4 + wc] = q; }
        asm volatile("s_waitcnt lgkmcnt(0)" ::: "memory"); __builtin_amdgcn_s_barrier(); asm volatile("" ::: "memory");
        if (ssq_out) { const int t = wid * 64 + lane; if (t < 256) { const PG8_LAS f32x4* P4 = (const PG8_LAS f32x4*)P; const f32x4 p = P4[t]; wt_st4f(ssq_out + (size_t)(u.pm * BM + t) * 4 + u.pn, (p[0] + p[1]) + (p[2] + p[3])); } }
    }
};
struct EpiWin {
    static constexpr bool PERM = true, AFTER_DRAIN = false, RS_LDS = PG8_RSLDS, RESID_LDS = false;
    bf16_t* U; const float* ssq; const float* gains;
    template <int AI_LO = 0, int AI_HI = 2>
    __device__ __forceinline__ void operator()(const f32x4 (&acc)[2][2][4][2], const Unit& u, int wr, int wc, int fr, int fq, const PG8_LAS float* rsl) const {
        const int row0 = u.pm * BM + wr * 64 + fr, colL = u.pn * BM + wc * 64 + 8 * fq;
        const bool nrm = (u.pn == 4) || (u.pn == 5) || (u.pn == 7);
        const float* g = gains + ((u.pn == 4) ? 0 : (u.pn == 5) ? 64 : 128);
        f32x4 gv[2][2];
#pragma unroll
        for (int bj = 0; bj < 2; ++bj)
#pragma unroll
            for (int n = 0; n < 2; ++n) gv[bj][n] = nrm ? *(const __attribute__((address_space(1))) f32x4*)(g + 32 * bj + 8 * fq + 4 * n) : (f32x4){1.f, 1.f, 1.f, 1.f};
        float rsv[2][4];
#pragma unroll
        for (int ai = AI_LO; ai < AI_HI; ++ai)
#pragma unroll
            for (int m = 0; m < 4; ++m) rsv[ai][m] = RS_LDS ? rsl[wr * 64 + fr + ai * HALF + m * 16] : row_rs(ssq, row0 + ai * HALF + m * 16);
#pragma unroll
        for (int ai = AI_LO; ai < AI_HI; ++ai)
#pragma unroll
            for (int m = 0; m < 4; ++m) { const int row = row0 + ai * HALF + m * 16; const float rs = rsv[ai][m];
                f32x4 v[2][2]; float ss = 0.f;
#pragma unroll
                for (int bj = 0; bj < 2; ++bj)
#pragma unroll
                    for (int n = 0; n < 2; ++n) { v[bj][n] = acc[ai][bj][m][n] * rs; ss += (v[bj][n][0] * v[bj][n][0] + v[bj][n][1] * v[bj][n][1]) + (v[bj][n][2] * v[bj][n][2] + v[bj][n][3] * v[bj][n][3]); }
                ss += __shfl_xor(ss, 16); ss += __shfl_xor(ss, 32);
                const float rn = nrm ? __builtin_amdgcn_rsqf(ss * (1.0f / 64.0f) + NORM_EPS_F) * ((u.pn == 5) ? 1.0f : 0.18033688011112042f) : 1.0f;
#pragma unroll
                for (int bj = 0; bj < 2; ++bj) { const f32x4 x0 = v[bj][0] * rn * gv[bj][0], x1 = v[bj][1] * rn * gv[bj][1];
                    u32x4 w; w.x = cvt_pk_bf16(x0[0], x0[1]); w.y = cvt_pk_bf16(x0[2], x0[3]); w.z = cvt_pk_bf16(x1[0], x1[1]); w.w = cvt_pk_bf16(x1[2], x1[3]);
                    wt_st16(U + (size_t)row * 2048 + colL + 32 * bj, w); } }
    }
};
}
#ifndef PG8_SP2
#define PG8_SP2 true
#endif
#ifndef PG8_ALIGN
#define PG8_ALIGN true
#endif
#ifndef MK_N_LAUNCHES
#define MK_N_LAUNCHES 1
#endif
constexpr int NWAVES = 8;
constexpr int NPHASE = 9;
constexpr int N_LAUNCHES = MK_N_LAUNCHES;

constexpr int BATCH = 2, SEQ = 8192, D = 1024, FF = 2816, M = BATCH * SEQ;
constexpr int MEMLEN = 256, HD = 64, LRUW = 512, INW = 2048, NBLK = SEQ / 256;
constexpr float EPS = 1e-6f;

constexpr size_t MiB = 1u << 20;
constexpr size_t WS_CTL = 0, CTL_ZERO_BYTES = 64 * 1024;
constexpr size_t WS_SSQ0 = 1 * MiB, WS_SSQ1 = WS_SSQ0 + 256 * 1024, WS_SSQ2 = WS_SSQ1 + 256 * 1024;
constexpr size_t WS_KMEAN = 2 * MiB;
constexpr size_t WS_AGGA = WS_KMEAN + 64 * 1024;
constexpr size_t WS_AGGH = WS_AGGA + 128 * 1024;
constexpr size_t WS_GAINS = WS_AGGH + 128 * 1024;
constexpr size_t WS_PTAB = WS_GAINS + 4096;
constexpr size_t WS_MEMB = 3 * MiB;
constexpr size_t WS_MEMKF = 4 * MiB, WS_MEMVF = WS_MEMKF + 256 * 1024;
constexpr size_t WS_GR = 5 * MiB;
constexpr size_t WS_W1I = 8 * MiB, WS_W1O = 19 * MiB, WS_WIN = 25 * MiB, WS_WOUT = 29 * MiB, WS_WMKV = 31 * MiB, WS_W2I = 32 * MiB, WS_W2O = 43 * MiB;
constexpr size_t WS_WG = 49 * MiB;
constexpr size_t WS_XB = 50 * MiB;
constexpr size_t WS_MIX = 82 * MiB;
constexpr size_t WS_H = 114 * MiB;
constexpr size_t WS_U = WS_H;
constexpr size_t WS_KF = 202 * MiB, WS_VF = 210 * MiB;
constexpr size_t WS_PART2 = 218 * MiB;
constexpr size_t WS_END = 256 * MiB;
static_assert(WS_H + (size_t)M * FF * 2 <= WS_END, "d_ws map");
constexpr int CW_BAR = 1024;

constexpr int RING_OFF = 0, RING_BYTES = 131072;
constexpr int LDSCTL_OFF = RING_BYTES, MISC_OFF = LDSCTL_OFF + 320;
constexpr int LDS_BYTES = 163840;

#define GAS __attribute__((address_space(1)))
#define LAS __attribute__((address_space(3)))
typedef unsigned short bf16;
typedef unsigned v4u __attribute__((ext_vector_type(4)));
typedef float f32x4 __attribute__((ext_vector_type(4)));
typedef short bf16x8 __attribute__((ext_vector_type(8)));
typedef GAS unsigned gu32;
typedef GAS unsigned long long gu64;
#define RLX_AGENT __ATOMIC_RELAXED, __HIP_MEMORY_SCOPE_AGENT
#define LDS_WAIT() asm volatile("s_waitcnt lgkmcnt(0)" ::: "memory")
#define VM_WAIT() asm volatile("s_waitcnt vmcnt(0)" ::: "memory")
__device__ __forceinline__ unsigned long long rt() { return __builtin_amdgcn_s_memrealtime(); }
__device__ __forceinline__ unsigned f2bf(float f) { unsigned u = __builtin_bit_cast(unsigned, f); return (u + 0x7fffu + ((u >> 16) & 1u)) >> 16; }
__device__ __forceinline__ unsigned pk2(float lo, float hi) { return f2bf(lo) | (f2bf(hi) << 16); }

#define XB_TMO      128
#define XB_XCNT(j)  (256  + 64 * (j))
#define XB_XSUB(j)  (1280 + 64 * (j))
#define XB_XGEN(j)  (2304 + 64 * (j))
#define XB_TOP      3328
#define XB_TOPGEN   3392
#define XCD_BAR_WORDS 3456
#define XB_SPIN_CAP (1u << 18)

__device__ __forceinline__ unsigned xb_ld(unsigned* p)              { return __hip_atomic_load(p, __ATOMIC_RELAXED, __HIP_MEMORY_SCOPE_AGENT); }
__device__ __forceinline__ unsigned xb_add(unsigned* p, unsigned v) { return __hip_atomic_fetch_add(p, v, __ATOMIC_RELAXED, __HIP_MEMORY_SCOPE_AGENT); }
__device__ __forceinline__ unsigned xb_xcc_id() { return (unsigned)__builtin_amdgcn_s_getreg((3 << 11) | 20) & 0xFu; }
#define XB_SPIN(cond, bar) do { unsigned _sp = 0; while (cond) { __builtin_amdgcn_s_sleep(1); \
    if ((++_sp & 255u) == 0u) { if (xb_ld(&(bar)[XB_TMO])) break; if (_sp > XB_SPIN_CAP) { atomicAdd(&(bar)[XB_TMO], 1u); break; } } } } while (0)

struct XcdBarrier {
    unsigned* bar; unsigned x;
    volatile LAS unsigned* st;
    int wave;
};
__device__ __forceinline__ bool xb_thread0(int wave) { int ln; asm volatile("v_mbcnt_lo_u32_b32 %0, -1, 0\n\tv_mbcnt_hi_u32_b32 %0, -1, %0" : "=v"(ln)); return wave == 0 && ln == 0; }

__device__ __forceinline__ XcdBarrier xcd_barrier_post(unsigned* bar, volatile LAS unsigned* st, int wave) {
    XcdBarrier b; b.bar = bar; b.x = xb_xcc_id(); b.st = st; b.wave = wave;
    if (xb_thread0(wave)) (void)xb_add(&bar[XB_XCNT(b.x)], 1u);
    return b;
}
__device__ __forceinline__ void xcd_barrier_complete(unsigned* bar, unsigned x, unsigned& nloc, unsigned& nx) {
    const unsigned G = gridDim.x * gridDim.y * gridDim.z;
    unsigned sum, cnt, mine, sp = 0u;
    for (;;) {
        sum = 0u; cnt = 0u; mine = 0u;
#pragma unroll
        for (unsigned j = 0; j < 16; ++j) { const unsigned c = xb_ld(&bar[XB_XCNT(j)]); sum += c; cnt += (c > 0u) ? 1u : 0u; mine = (j == x) ? c : mine; }
        if (sum == G) break;
        __builtin_amdgcn_s_sleep(1);
        if ((++sp & 255u) == 0u) { if (xb_ld(&bar[XB_TMO])) break; if (sp > XB_SPIN_CAP) { atomicAdd(&bar[XB_TMO], 1u); break; } }
    }
    nloc = mine > 0u ? mine : 1u; nx = cnt > 0u ? cnt : 1u;
}

__device__ __forceinline__ void xcd_barrier(const XcdBarrier& b, const bool writeback = true) {
    asm volatile("s_waitcnt vmcnt(0)" ::: "memory");
    __syncthreads();
    if (xb_thread0(b.wave)) {
        unsigned* bar = b.bar;
        __builtin_amdgcn_s_waitcnt(0);
        unsigned nloc = b.st[0], nx = b.st[1];
        if (nloc == 0u) { xcd_barrier_complete(bar, b.x, nloc, nx); b.st[0] = nloc; b.st[1] = nx; }
        const unsigned old = xb_add(&bar[XB_XSUB(b.x)], 1u);
        const unsigned gen = old / nloc;
        if (old + 1u == (gen + 1u) * nloc) {
            if (writeback) __builtin_amdgcn_fence(__ATOMIC_RELEASE, "agent");
            asm volatile("s_waitcnt vmcnt(0)" ::: "memory");
            const unsigned og = xb_add(&bar[XB_TOP], 1u);
            const unsigned tg = og / nx;
#ifdef XB_EARLY_INV
            __builtin_amdgcn_fence(__ATOMIC_ACQUIRE, "agent");
            if (og + 1u == (tg + 1u) * nx) xb_add(&bar[XB_TOPGEN], 1u);
            else XB_SPIN(xb_ld(&bar[XB_TOPGEN]) == tg, bar);
#else
            if (og + 1u == (tg + 1u) * nx) xb_add(&bar[XB_TOPGEN], 1u);
            else XB_SPIN(xb_ld(&bar[XB_TOPGEN]) == tg, bar);
            __builtin_amdgcn_fence(__ATOMIC_ACQUIRE, "agent");
#endif
#ifndef XB_DIRECT
            xb_add(&bar[XB_XGEN(b.x)], 1u);
#endif
            asm volatile("s_waitcnt vmcnt(0)" ::: "memory");
        } else {
#ifdef XB_EARLY_INV
            __builtin_amdgcn_fence(__ATOMIC_ACQUIRE, "agent");
            XB_SPIN(xb_ld(&bar[XB_XGEN(b.x)]) == gen, bar);
#elif defined(XB_DIRECT)
            XB_SPIN(xb_ld(&bar[XB_TOPGEN]) == gen, bar);
            __builtin_amdgcn_fence(__ATOMIC_ACQUIRE, "agent");
#else
            XB_SPIN(xb_ld(&bar[XB_XGEN(b.x)]) == gen, bar);
            __builtin_amdgcn_fence(__ATOMIC_ACQUIRE, "agent");
#endif
            asm volatile("s_waitcnt vmcnt(0)" ::: "memory");
        }
    }
    __syncthreads();
}

#define LB_CNT(l)  (8192 + 64 * (l))
#define LB_EV(e)   (8192 + 64 * (8 + (e)))
__device__ __forceinline__ void label_barrier(unsigned* ctl, unsigned* bar, int label, unsigned members, int wave, bool ev_sig, unsigned* ev, unsigned ev_need) {
    asm volatile("s_waitcnt vmcnt(0)" ::: "memory");
    __syncthreads();
    if (xb_thread0(wave)) {
        __builtin_amdgcn_s_waitcnt(0);
        unsigned* cnt = ctl + LB_CNT(label);
        __builtin_amdgcn_fence(__ATOMIC_RELEASE, "agent");
        asm volatile("s_waitcnt vmcnt(0)" ::: "memory");
        if (ev_sig) (void)xb_add(ev, 1u);
        const unsigned old = xb_add(cnt, 1u);
        const unsigned target = (old / members + 1u) * members;
        XB_SPIN(xb_ld(cnt) < target, bar);
        if (ev_need) XB_SPIN(xb_ld(ev) < ev_need, bar);
        __builtin_amdgcn_fence(__ATOMIC_ACQUIRE, "agent");
        asm volatile("s_waitcnt vmcnt(0)" ::: "memory");
    }
    __syncthreads();
}
__device__ __forceinline__ float bf2f(unsigned short h) { return __uint_as_float((unsigned)h << 16); }
__device__ __forceinline__ float bflo(unsigned w) { return __uint_as_float(w << 16); }
__device__ __forceinline__ float bfhi(unsigned w) { return __uint_as_float(w & 0xffff0000u); }
__device__ __forceinline__ float wave_sum(float v) {
#pragma unroll
    for (int o = 1; o < 64; o <<= 1) v += __shfl_xor(v, o);
    return v;
}
__device__ __forceinline__ float wave_max(float v) {
#pragma unroll
    for (int o = 1; o < 64; o <<= 1) v = fmaxf(v, __shfl_xor(v, o));
    return v;
}
__device__ __forceinline__ float sigmoidf_(float x) { return 1.0f / (1.0f + __expf(-x)); }
__device__ __forceinline__ float gelu_tanh(float x) { const float u = x * __builtin_fmaf(x * x, 0.10294324f, 2.3022082f); return x * __builtin_amdgcn_rcpf(1.0f + __builtin_amdgcn_exp2f(-u)); }
template <int CTRL, int ROWMASK> __device__ __forceinline__ float dppf(float old, float src) { return __builtin_bit_cast(float, __builtin_amdgcn_update_dpp(__builtin_bit_cast(int, old), __builtin_bit_cast(int, src), CTRL, ROWMASK, 0xF, false)); }

__device__ __forceinline__ int kperm16(int o) { return 8 * ((o >> 2) & 1) + 4 * (o >> 3) + (o & 3); }
__device__ __forceinline__ void p0_transpose_item(const float* W, int K, int N, const float* gain, bf16* WT, int dest_row0, LAS float* scr, int k0, int n0, int lane) {
#pragma unroll
    for (int i = 0; i < 32; ++i) { const int kk = 2 * i + (lane >> 5); const float g = gain ? gain[k0 + kk] : 1.0f; scr[kk * 33 + (lane & 31)] = W[(size_t)(k0 + kk) * N + n0 + (lane & 31)] * g; }
    LDS_WAIT(); asm volatile("" ::: "memory");
    const int c = lane & 7;
#pragma unroll
    for (int j = 0; j < 4; ++j) { const int n = (lane >> 3) + 8 * j; const LAS float* s = scr + (8 * c) * 33 + n;
        v4u o; o.x = pk2(s[0 * 33], s[1 * 33]); o.y = pk2(s[2 * 33], s[3 * 33]); o.z = pk2(s[4 * 33], s[5 * 33]); o.w = pk2(s[6 * 33], s[7 * 33]);
        *(GAS v4u*)(WT + (size_t)(dest_row0 + n) * K + k0 + 8 * c) = o; }
    LDS_WAIT(); asm volatile("" ::: "memory");
}
__device__ __forceinline__ int map_swiglu(int n0) { return n0 < FF ? 256 * (n0 / 128) + (n0 % 128) : 256 * ((n0 - FF) / 128) + 128 + ((n0 - FF) % 128); }
__device__ __forceinline__ int map_heads(int n0) { const int rem = n0 % 256; return 256 * (n0 / 256) + 128 * ((rem / 32) & 1) + 32 * (rem / 64); }
__device__ __forceinline__ void row_to_bf16(const float* xrow, bf16* orow, float* ssq4, bool scale, int lane) {
    const GAS f32x4* xr = (const GAS f32x4*)xrow + lane;
    f32x4 v[4]; float s = 0.f;
#pragma unroll
    for (int j = 0; j < 4; ++j) { v[j] = xr[64 * j]; s += (v[j].x * v[j].x + v[j].y * v[j].y) + (v[j].z * v[j].z + v[j].w * v[j].w); }
    s = wave_sum(s);
    const float rs = scale ? __builtin_amdgcn_rsqf(s * (1.0f / 1024.0f) + EPS) : 1.0f;
    GAS unsigned long long* o8 = (GAS unsigned long long*)orow + lane;
#pragma unroll
    for (int j = 0; j < 4; ++j) wt_st8((void*)(o8 + 64 * j), (unsigned long long)pk2(v[j].x * rs, v[j].y * rs) | ((unsigned long long)pk2(v[j].z * rs, v[j].w * rs) << 32));
    if (ssq4 && lane == 0) { wt_st16f(ssq4, (f32x4){s, 0.f, 0.f, 0.f}); }
}
struct P0Item { const float* src; const float* gain; bf16* dst; int K, N; float useg; int grp; };
template <int SET>
__device__ __forceinline__ bool p0_decode(const float* const* in, unsigned char* ws, int it, P0Item& d) {
    constexpr int I_FI = (D / 64) * (2 * FF / 32), I_FO = (FF / 64) * (D / 32), I_WI = (D / 64) * (INW / 32), I_WO = (D / 64) * (D / 32), I_MK = (D / 64) * (512 / 32);
    constexpr int NITEMS = SET == 0 ? 2 * I_FI + I_MK : SET == 1 ? I_FO + I_WO + I_WI : I_FO;
    if (it >= NITEMS) return false;
    int r = it; const float* W; const float* gain; bf16* WT; int K, N, map;
    if (SET == 0) {
        if (r < I_FI) { W = in[3]; K = D; N = 2 * FF; gain = in[2]; WT = (bf16*)(ws + WS_W1I); map = 1; }
        else if ((r -= I_FI) < I_MK) { W = in[17]; K = D; N = 512; gain = in[6]; WT = (bf16*)(ws + WS_WMKV); map = 0; }
        else { r -= I_MK; W = in[22]; K = D; N = 2 * FF; gain = in[21]; WT = (bf16*)(ws + WS_W2I); map = 1; }
    } else if (SET == 1) {
        if (r < I_FO) { W = in[4]; K = FF; N = D; gain = nullptr; WT = (bf16*)(ws + WS_W1O); map = 0; }
        else if ((r -= I_FO) < I_WI) { W = in[7]; K = D; N = INW; gain = in[5]; WT = (bf16*)(ws + WS_WIN); map = 2; }
        else { r -= I_WI; W = in[20]; K = D; N = D; gain = nullptr; WT = (bf16*)(ws + WS_WOUT); map = 0; }
    } else { W = in[23]; K = FF; N = D; gain = nullptr; WT = (bf16*)(ws + WS_W2O); map = 0; }
    const int nblk = N / 32, kb = r / nblk, nb = r % nblk, k0 = 64 * kb, n0 = 32 * nb;
    const int dr = map == 1 ? map_swiglu(n0) : map == 2 ? map_heads(n0) : n0;
    d.src = W + (size_t)k0 * N + n0; d.gain = gain ? gain + k0 : W; d.useg = gain ? 1.0f : 0.0f; d.K = K; d.N = N;
#if PG8_BTILED
    if (WT != (bf16*)(ws + WS_WMKV)) { d.dst = WT + ((size_t)(dr >> 7) * (K >> 6) + (k0 >> 6)) * 8192; d.grp = dr & 96; return true; }
#endif
    d.dst = WT + (size_t)dr * K + k0; d.grp = -1; return true;
}
__device__ __forceinline__ void p0_item_load(const P0Item& d, f32x4 (&v)[8], float (&gv)[8], int lane) {
#pragma unroll
    for (int i = 0; i < 8; ++i) { v[i] = *(const GAS f32x4*)(d.src + (size_t)((lane >> 3) + 8 * i) * d.N + 4 * (lane & 7)); gv[i] = *(const GAS float*)(d.gain + (lane >> 3) + 8 * i); }
}
__device__ __forceinline__ void p0_item_finish(const P0Item& d, const f32x4 (&v)[8], const float (&gv)[8], LAS float* scr, int lane) {
#pragma unroll
    for (int i = 0; i < 8; ++i) { const int kk = (lane >> 3) + 8 * i; const float g = d.useg != 0.0f ? gv[i] : 1.0f; LAS float* s = scr + kk * 33 + 4 * (lane & 7);
        s[0] = v[i].x * g; s[1] = v[i].y * g; s[2] = v[i].z * g; s[3] = v[i].w * g; }
    LDS_WAIT(); asm volatile("" ::: "memory");
    const int c = lane & 7;
#pragma unroll
    for (int j = 0; j < 4; ++j) { const int n = (lane >> 3) + 8 * j; const LAS float* s = scr + (8 * c) * 33 + n;
        v4u o; o.x = pk2(s[0 * 33], s[1 * 33]); o.y = pk2(s[2 * 33], s[3 * 33]); o.z = pk2(s[4 * 33], s[5 * 33]); o.w = pk2(s[6 * 33], s[7 * 33]);
        const size_t eo = d.grp >= 0 ? (size_t)(pg8::lds_byte(d.grp + 16 * ((n >> 2) & 1) + 4 * (n >> 3) + (n & 3), 8 * c) >> 1) : (size_t)n * d.K + 8 * c;
        wt_st16(d.dst + eo, o); }
    LDS_WAIT(); asm volatile("" ::: "memory");
}
template <int SET>
__device__ __forceinline__ void p0_weights(const float* const* in, unsigned char* ws, LAS unsigned char* lds, int widx, int nw, int wave, int lane) {
    LAS float* scr = (LAS float*)(lds + RING_OFF + wave * 16384);
    P0Item d0, d1; f32x4 v0[8], v1[8]; float g0[8], g1[8];
    int it = widx; bool have = p0_decode<SET>(in, ws, it, d0);
    if (have) p0_item_load(d0, v0, g0, lane);
    while (have) {
        const bool have1 = p0_decode<SET>(in, ws, it + nw, d1);
        if (!have1) d1 = d0;
        p0_item_load(d1, v1, g1, lane);
        p0_item_finish(d0, v0, g0, scr, lane);
        it += nw; have = have1; d0 = d1;
#pragma unroll
        for (int i = 0; i < 8; ++i) { v0[i] = v1[i]; g0[i] = g1[i]; }
    }
}
struct P0Mat { const float* W; int K, N; const float* gain; bf16* WT; int map; };
__device__ __forceinline__ void p0_prologue(const float* const* in, unsigned char* ws, LAS unsigned char* lds, int vcu, int G, int wave, int lane) {
    LAS float* scr = (LAS float*)(lds + RING_OFF + wave * 16384);
    const int gw = vcu * NWAVES + wave, NGW = G * NWAVES;
    for (int m = gw; m < M; m += 4 * NGW) {
        f32x4 v[4][4];
#pragma unroll
        for (int r = 0; r < 4; ++r) { const GAS f32x4* xr = (const GAS f32x4*)(in[0] + (size_t)(m + r * NGW) * D) + 2 * lane;
            v[r][0] = xr[0]; v[r][1] = xr[1]; v[r][2] = xr[128]; v[r][3] = xr[129]; }
#pragma unroll
        for (int r = 0; r < 4; ++r) { float sa = 0.f;
#pragma unroll
            for (int j = 0; j < 4; ++j) sa += (v[r][j].x * v[r][j].x + v[r][j].y * v[r][j].y) + (v[r][j].z * v[r][j].z + v[r][j].w * v[r][j].w);
            sa = wave_sum(sa);
            GAS v4u* o16 = (GAS v4u*)((bf16*)(ws + WS_XB) + (size_t)(m + r * NGW) * D) + lane;
            wt_st16((void*)(o16), (v4u){pk2(v[r][0].x, v[r][0].y), pk2(v[r][0].z, v[r][0].w), pk2(v[r][1].x, v[r][1].y), pk2(v[r][1].z, v[r][1].w)});
            wt_st16((void*)(o16 + 64), (v4u){pk2(v[r][2].x, v[r][2].y), pk2(v[r][2].z, v[r][2].w), pk2(v[r][3].x, v[r][3].y), pk2(v[r][3].z, v[r][3].w)});
            if (lane == 0) wt_st16f((float*)(ws + WS_SSQ0) + (size_t)(m + r * NGW) * 4, (f32x4){sa, 0.f, 0.f, 0.f}); }
    }
    for (int m = gw; m < BATCH * MEMLEN; m += NGW) row_to_bf16(in[1] + (size_t)m * D, (bf16*)(ws + WS_MEMB) + (size_t)m * D, nullptr, true, lane);
    for (int f = gw * 64 + lane; f < 8 * 2 * 2 * 4 * 64; f += NGW * 64) {
        const int ln = f & 63, ks = (f >> 6) & 3, blk = (f >> 8) & 1, gate = (f >> 9) & 1, n = f >> 10, r = ln & 31, h = ln >> 5;
        const float* Wg = (gate ? in[12] : in[10]) + (size_t)n * 4096 + 32 * blk + r; float v[8];
#pragma unroll
        for (int j = 0; j < 8; ++j) v[j] = 1.4426950408889634f * Wg[(8 * (2 * ks + (j >> 2)) + 4 * h + (j & 3)) * 64];
        v4u o; o.x = pk2(v[0], v[1]); o.y = pk2(v[2], v[3]); o.z = pk2(v[4], v[5]); o.w = pk2(v[6], v[7]);
        wt_st16((bf16*)(ws + WS_WG) + (size_t)f * 8, o); }
    p0_weights<0>(in, ws, lds, gw, NGW, wave, lane);
    for (int i = gw * 64 + lane; i < BATCH * NBLK * LRUW * 2; i += NGW * 64) wt_st8((unsigned long long*)(ws + WS_GR) + i, 0ull);
}
__device__ __forceinline__ unsigned pkbf(float lo, float hi) { typedef float f2 __attribute__((ext_vector_type(2))); typedef __bf16 b2 __attribute__((ext_vector_type(2))); f2 v = {lo, hi}; b2 r = __builtin_convertvector(v, b2); return __builtin_bit_cast(unsigned, r); }
typedef float f32x16_ __attribute__((ext_vector_type(16)));
constexpr int LRU_ROWB = 136, LRU_XT = 40 * LRU_ROWB, LRU_TILE = LRU_XT + 32 * LRU_ROWB;
__device__ __forceinline__ void lru_load(const bf16* U, int n, int b, int ck, int wave, int lane, v4u (&xv)[5], v4u (&gv)[4]) {
    const int t0 = ck * 256 + wave * 32;
    const int rr = lane >> 3, c16 = lane & 7; const bf16* src = U + ((size_t)b * SEQ + t0 - 3 + rr) * INW + n * 64 + c16 * 8;
#pragma unroll
    for (int i = 0; i < 5; ++i) { const int row = rr + 8 * i; const bool ok = (row < 35) && (t0 - 3 + row >= 0); const int rowc = ok ? row : 3;
        const v4u ld = *(const GAS v4u*)(src + (size_t)(rowc - rr) * INW); xv[i] = ok ? ld : (v4u){0u, 0u, 0u, 0u}; }
#pragma unroll
    for (int i = 0; i < 4; ++i) gv[i] = *(const GAS v4u*)(src + (size_t)(3 + 8 * i) * INW + LRUW);
}
__device__ __forceinline__ void lru_stage(LAS unsigned char* tile, int lane, const v4u (&xv)[5], const v4u (&gv)[4]) {
    typedef unsigned u2v __attribute__((ext_vector_type(2)));
    const int rr = lane >> 3, c16 = lane & 7;
#pragma unroll
    for (int i = 0; i < 5; ++i) { LAS unsigned char* d = tile + (rr + 8 * i) * LRU_ROWB + c16 * 16; *(LAS u2v*)d = (u2v){xv[i].x, xv[i].y}; *(LAS u2v*)(d + 8) = (u2v){xv[i].z, xv[i].w}; }
#pragma unroll
    for (int i = 0; i < 4; ++i) { LAS unsigned char* d = tile + LRU_XT + (rr + 8 * i) * LRU_ROWB + c16 * 16; *(LAS u2v*)d = (u2v){gv[i].x, gv[i].y}; *(LAS u2v*)(d + 8) = (u2v){gv[i].z, gv[i].w}; }
}
__device__ __forceinline__ void lru_local(const bf16* WG, const LAS float* PT, LAS unsigned char* tile, int n, int b, int ck, int wave, int lane, float (&av)[32], float (&bv)[32]) {
    typedef unsigned u2v __attribute__((ext_vector_type(2)));
    const int r32 = lane & 31, hi = lane >> 5;
    const int t0 = ck * 256 + wave * 32, t = t0 + r32;
    const LAS unsigned char* xrow = tile + r32 * LRU_ROWB + 8 * hi;
    unsigned xpk[16];
#pragma unroll
    for (int g = 0; g < 8; ++g) {
        f32x4 acc = *(const LAS f32x4*)(PT + 4 * 64 + 8 * g + 4 * hi);
#pragma unroll
        for (int jj = 0; jj < 4; ++jj) { const u2v w = *(const LAS u2v*)(xrow + jj * LRU_ROWB + 16 * g);
            const f32x4 cw = *(const LAS f32x4*)(PT + jj * 64 + 8 * g + 4 * hi);
            acc[0] += cw[0] * bflo(w.x); acc[1] += cw[1] * bfhi(w.x); acc[2] += cw[2] * bflo(w.y); acc[3] += cw[3] * bfhi(w.y); }
        xpk[2 * g] = pkbf(acc[0], acc[1]); xpk[2 * g + 1] = pkbf(acc[2], acc[3]);
    }
    bf16x8 xf[4];
#pragma unroll
    for (int ks = 0; ks < 4; ++ks) { v4u w; w.x = xpk[4 * ks]; w.y = xpk[4 * ks + 1]; w.z = xpk[4 * ks + 2]; w.w = xpk[4 * ks + 3]; xf[ks] = __builtin_bit_cast(bf16x8, w); }
    f32x16_ aR[2], aI[2];
#pragma unroll
    for (int blk = 0; blk < 2; ++blk)
#pragma unroll
        for (int q4 = 0; q4 < 4; ++q4) { const f32x4 ba = *(const LAS f32x4*)(PT + 6 * 64 + 32 * blk + 8 * q4 + 4 * hi), bx = *(const LAS f32x4*)(PT + 7 * 64 + 32 * blk + 8 * q4 + 4 * hi);
#pragma unroll
            for (int i = 0; i < 4; ++i) { aR[blk][4 * q4 + i] = ba[i]; aI[blk][4 * q4 + i] = bx[i]; } }
#pragma unroll
    for (int blk = 0; blk < 2; ++blk)
#pragma unroll
        for (int ks = 0; ks < 4; ++ks) {
            const bf16x8 wa = *(const GAS bf16x8*)(WG + ((size_t)(((n * 2 + 0) * 2 + blk) * 4 + ks) * 64 + lane) * 8);
            const bf16x8 wx = *(const GAS bf16x8*)(WG + ((size_t)(((n * 2 + 1) * 2 + blk) * 4 + ks) * 64 + lane) * 8);
            aR[blk] = __builtin_amdgcn_mfma_f32_32x32x16_bf16(wa, xf[ks], aR[blk], 0, 0, 0);
            aI[blk] = __builtin_amdgcn_mfma_f32_32x32x16_bf16(wx, xf[ks], aI[blk], 0, 0, 0); }
#pragma unroll
    for (int blk = 0; blk < 2; ++blk)
#pragma unroll
        for (int q4 = 0; q4 < 4; ++q4) { const f32x4 sp4 = *(const LAS f32x4*)(PT + 5 * 64 + 32 * blk + 8 * q4 + 4 * hi);
#pragma unroll
            for (int i = 0; i < 4; ++i) { const int idx = 16 * blk + 4 * q4 + i;
                const float r = __builtin_amdgcn_rcpf(1.0f + __builtin_amdgcn_exp2f(-aR[blk][4 * q4 + i])), ii = __builtin_amdgcn_rcpf(1.0f + __builtin_amdgcn_exp2f(-aI[blk][4 * q4 + i]));
                const float a = __builtin_amdgcn_exp2f(r * sp4[i]);
                float mult = __builtin_amdgcn_sqrtf(__builtin_fmaf(-a, a, 1.0f)); if (t == 0) mult = 1.0f;
                const unsigned xw_ = xpk[idx >> 1]; av[idx] = a; bv[idx] = mult * ii * ((idx & 1) ? bfhi(xw_) : bflo(xw_)); } }
#define LRU_E(i, C) "v_fmac_f32_dpp %" #i ", %" #i ", %" #C " " CTRL "\n\tv_mul_f32_dpp %" #C ", %" #C ", %" #C " " CTRL "\n\t"
#define LRU_STEP4(g) asm volatile("s_nop 1\n\t" LRU_E(0, 4) LRU_E(1, 5) LRU_E(2, 6) LRU_E(3, 7) : "+v"(bv[g]), "+v"(bv[g + 1]), "+v"(bv[g + 2]), "+v"(bv[g + 3]), "+v"(av[g]), "+v"(av[g + 1]), "+v"(av[g + 2]), "+v"(av[g + 3]))
#define LRU_STEP() do { LRU_STEP4(0); LRU_STEP4(4); LRU_STEP4(8); LRU_STEP4(12); LRU_STEP4(16); LRU_STEP4(20); LRU_STEP4(24); LRU_STEP4(28); } while (0)
#define CTRL "row_shr:1 row_mask:0xf bank_mask:0xf"
    LRU_STEP();
#undef CTRL
#define CTRL "row_shr:2 row_mask:0xf bank_mask:0xf"
    LRU_STEP();
#undef CTRL
#define CTRL "row_shr:4 row_mask:0xf bank_mask:0xf"
    LRU_STEP();
#undef CTRL
#define CTRL "row_shr:8 row_mask:0xf bank_mask:0xf"
    LRU_STEP();
#undef CTRL
#define CTRL "row_bcast:15 row_mask:0xa bank_mask:0xf"
    LRU_STEP();
#undef CTRL
#undef LRU_E
#undef LRU_STEP4
#undef LRU_STEP
}
__device__ __forceinline__ void lru_put_agg(LAS float* Aw, LAS float* Hw, int wave, int lane, const float (&av)[32], const float (&bv)[32]) {
    const int r32 = lane & 31, hi = lane >> 5;
    if (r32 == 31) {
#pragma unroll
        for (int k = 0; k < 8; ++k) { const int d = 8 * k + 4 * hi; const int idx = 4 * k;
            *(LAS f32x4*)(Aw + wave * 64 + d) = (f32x4){av[idx], av[idx + 1], av[idx + 2], av[idx + 3]}; *(LAS f32x4*)(Hw + wave * 64 + d) = (f32x4){bv[idx], bv[idx + 1], bv[idx + 2], bv[idx + 3]}; } }
}
__device__ __forceinline__ void lru_publish(gu64* GR, const LAS float* Aw, const LAS float* Hw, int b, int ck, int n, int lane) {
    float cA = 1.f, cH = 0.f; const int gc = n * 64 + lane;
#pragma unroll
    for (int v = 0; v < 8; ++v) { const float a1 = Aw[v * 64 + lane], h1 = Hw[v * 64 + lane]; cH = a1 * cH + h1; cA *= a1; }
    gu64* g = GR + ((size_t)(b * NBLK + ck) * LRUW + gc) * 2;
    __hip_atomic_store(g, (1ull << 32) | (unsigned long long)__float_as_uint(cA), __ATOMIC_RELAXED, __HIP_MEMORY_SCOPE_AGENT);
    __hip_atomic_store(g + 1, (1ull << 32) | (unsigned long long)__float_as_uint(cH), __ATOMIC_RELAXED, __HIP_MEMORY_SCOPE_AGENT);
}
__device__ __forceinline__ float lru_lookback(const gu64* GR, int b, int ck, int n, int lane) {
    const int gc = n * 64 + lane; float h = 0.f;
    if (ck > 0) {
        const gu64* g0 = GR + ((size_t)(b * NBLK) * LRUW + gc) * 2;
#pragma unroll
        for (int half = 0; half < 2; ++half) {
            if (half * 16 < ck) {
                float ca[16], ch[16];
                for (unsigned spins = 0;; ++spins) { bool ok = true;
#pragma unroll
                    for (int cc = 0; cc < 16; ++cc) { const int c1 = half * 16 + cc, c2 = c1 < ck ? c1 : 0;
                        const unsigned long long x = __hip_atomic_load(g0 + (size_t)c2 * LRUW * 2, __ATOMIC_RELAXED, __HIP_MEMORY_SCOPE_AGENT), y = __hip_atomic_load(g0 + (size_t)c2 * LRUW * 2 + 1, __ATOMIC_RELAXED, __HIP_MEMORY_SCOPE_AGENT);
                        ok = ok && ((x >> 32) == 1ull) && ((y >> 32) == 1ull); ca[cc] = __uint_as_float((unsigned)x); ch[cc] = __uint_as_float((unsigned)y); }
                    if (__all(ok) || spins > (1u << 14)) break;
                    __builtin_amdgcn_s_sleep(2); }
#pragma unroll
                for (int cc = 0; cc < 16; ++cc) h = (half * 16 + cc) < ck ? ca[cc] * h + ch[cc] : h;
            }
        }
    }
    return h;
}
__device__ __forceinline__ void lru_finish(bf16* MIX, const LAS float* Aw, const LAS float* Hw, const LAS float* CAR, LAS unsigned char* tile, int n, int b, int ck, int wave, int lane, const float (&av)[32], const float (&bv)[32]) {
    typedef unsigned u2v __attribute__((ext_vector_type(2)));
    const int r32 = lane & 31, hi = lane >> 5;
    LAS unsigned char* grow = tile + LRU_XT + r32 * LRU_ROWB + 8 * hi;
    f32x4 c[8];
#pragma unroll
    for (int k = 0; k < 8; ++k) c[k] = *(const LAS f32x4*)(CAR + 8 * k + 4 * hi);
    for (int v = 0; v < wave; ++v) { const LAS float* ap = Aw + v * 64 + 4 * hi; const LAS float* hp = Hw + v * 64 + 4 * hi;
#pragma unroll
        for (int k = 0; k < 8; ++k) { const f32x4 a1 = *(const LAS f32x4*)(ap + 8 * k), h1 = *(const LAS f32x4*)(hp + 8 * k); c[k] = a1 * c[k] + h1; } }
#pragma unroll
    for (int k = 0; k < 8; ++k) { const int idx = 4 * k;
        const u2v gw = *(const LAS u2v*)(grow + 16 * k);
        const float h0 = bv[idx] + av[idx] * c[k][0], h1_ = bv[idx + 1] + av[idx + 1] * c[k][1], h2 = bv[idx + 2] + av[idx + 2] * c[k][2], h3 = bv[idx + 3] + av[idx + 3] * c[k][3];
        u2v o; o.x = pkbf(h0 * gelu_tanh(bflo(gw.x)), h1_ * gelu_tanh(bfhi(gw.x))); o.y = pkbf(h2 * gelu_tanh(bflo(gw.y)), h3 * gelu_tanh(bfhi(gw.y)));
        *(LAS u2v*)(grow + 16 * k) = o; }
    { const int rr = lane >> 3, c16 = lane & 7; bf16* dst = MIX + ((size_t)b * SEQ + ck * 256 + wave * 32 + rr) * D + n * 64 + c16 * 8;
#pragma unroll
      for (int i = 0; i < 4; ++i) { const LAS unsigned char* s = tile + LRU_XT + (rr + 8 * i) * LRU_ROWB + c16 * 16; const u2v lo = *(const LAS u2v*)s, hi2 = *(const LAS u2v*)(s + 8);
          wt_st16(dst + (size_t)(8 * i) * D, (v4u){lo.x, lo.y, hi2.x, hi2.y}); } }
}
template <bool FINAL>
__device__ __forceinline__ void lru_items(unsigned char* ws, LAS unsigned char* lds, int G, int wave, int tid) {
    const bf16* U = (const bf16*)(ws + WS_U); bf16* MIX = (bf16*)(ws + WS_MIX); const bf16* WG = (const bf16*)(ws + WS_WG);
    gu64* GR = (gu64*)(ws + WS_GR);
    LAS float* PT = (LAS float*)(lds + RING_OFF);
    LAS float* Aw = PT + 512; LAS float* Hw = Aw + 512; LAS float* CAR = Hw + 512;
    LAS unsigned char* tile = lds + RING_OFF + 8192 + wave * 10240;
    static_assert(LRU_TILE <= 10240 && 8192 + 8 * 10240 <= RING_BYTES, "LRU LDS map");
    const int n = blockIdx.x & 7;
    __syncthreads();
    { const int row = tid >> 6, c = tid & 63; PT[row * 64 + c] = ((const float*)(ws + WS_PTAB))[row * 512 + n * 64 + c]; }
    v4u xv[5], gv[4];
    if ((int)blockIdx.x < BATCH * NBLK * 8) { int lane0; asm volatile("v_mbcnt_lo_u32_b32 %0, -1, 0\n\tv_mbcnt_hi_u32_b32 %0, -1, %0" : "=v"(lane0)); lru_load(U, n, (int)blockIdx.x >> 8, ((int)blockIdx.x >> 3) & 31, wave, lane0, xv, gv); }
    for (int id = blockIdx.x; id < BATCH * NBLK * 8; id += G) {
        const int ck = (id >> 3) & 31, b = id >> 8;
        int lane; asm volatile("v_mbcnt_lo_u32_b32 %0, -1, 0\n\tv_mbcnt_hi_u32_b32 %0, -1, %0" : "=v"(lane));
        __syncthreads();
        float av[32], bv[32];
        lru_stage(tile, lane, xv, gv);
        { const int nid = (id + G < BATCH * NBLK * 8) ? id + G : id; lru_load(U, n, nid >> 8, (nid >> 3) & 31, wave, lane, xv, gv); }
        lru_local(WG, PT, tile, n, b, ck, wave, lane, av, bv);
        lru_put_agg(Aw, Hw, wave, lane, av, bv);
        __syncthreads();
        if (wave == 0) lru_publish(GR, Aw, Hw, b, ck, n, lane);
        if (wave == 7) CAR[lane] = lru_lookback(GR, b, ck, n, lane);
        __syncthreads();
        lru_finish(MIX, Aw, Hw, CAR, tile, n, b, ck, wave, lane, av, bv);
    }
    __syncthreads();
}
__device__ __forceinline__ void kvprep_items(unsigned char* ws, LAS unsigned char* lds, int G, int wave, int lane, int tid) {
    const bf16* U = (const bf16*)(ws + WS_U); bf16* KF = (bf16*)(ws + WS_KF); bf16* VF = (bf16*)(ws + WS_VF); float* KM = (float*)(ws + WS_KMEAN);
    LAS unsigned char* KT = lds + RING_OFF;
    LAS unsigned short* VTl = (LAS unsigned short*)(lds + RING_OFF + 36864);
    LAS float* part = (LAS float*)(lds + RING_OFF + 36864 + 33792);
    for (int id = blockIdx.x; id < BATCH * NBLK * 4; id += G) {
        const int h = id & 3, j = (id >> 2) & 31, b = id >> 7, bh = b * 4 + h;
        __syncthreads();
        { const int key = tid >> 1, half = tid & 1; const bf16* rowp = U + ((size_t)b * SEQ + j * 256 + key) * INW + h * 64 + half * 32;
          const uint4* ks = (const uint4*)(rowp + 1280); const uint4* vs = (const uint4*)(rowp + 1536);
          v4u kw[4], vw[4];
#pragma unroll
          for (int c = 0; c < 4; ++c) { kw[c] = *(const GAS v4u*)(ks + c); vw[c] = *(const GAS v4u*)(vs + c); }
#pragma unroll
          for (int c = 0; c < 4; ++c) { *(LAS v4u*)(KT + key * 144 + half * 64 + c * 16) = kw[c];
              LAS unsigned* dst = (LAS unsigned*)(VTl + key * 66 + half * 32 + c * 8); dst[0] = vw[c].x; dst[1] = vw[c].y; dst[2] = vw[c].z; dst[3] = vw[c].w; } }
        __syncthreads();
        { const int d = tid & 63, pt = tid >> 6; float s = 0.f;
#pragma unroll 8
          for (int r = 0; r < 32; ++r) s += bf2f(*(const LAS unsigned short*)(KT + (pt * 32 + r) * 144 + d * 2));
          part[pt * 64 + d] = s; }
        { const int r32 = lane & 31, hi = lane >> 5;
#pragma unroll
          for (int ks = 0; ks < 4; ++ks) { const v4u w = *(const LAS v4u*)(KT + (wave * 32 + r32) * 144 + ks * 32 + hi * 16);
              wt_st16(KF + (((size_t)(bh * 256 + j * 8 + wave) * 4 + ks) * 64 + lane) * 8, w); }
#pragma unroll
          for (int db = 0; db < 2; ++db)
#pragma unroll
              for (int s = 0; s < 2; ++s) { unsigned short v[8];
#pragma unroll
                  for (int jj = 0; jj < 8; ++jj) v[jj] = VTl[(wave * 32 + 16 * s + 8 * (jj >> 2) + 4 * hi + (jj & 3)) * 66 + 32 * db + r32];
                  uint4 w; w.x = v[0] | ((unsigned)v[1] << 16); w.y = v[2] | ((unsigned)v[3] << 16); w.z = v[4] | ((unsigned)v[5] << 16); w.w = v[6] | ((unsigned)v[7] << 16);
                  wt_st16(VF + ((((size_t)(bh * 256 + j * 8 + wave) * 2 + db) * 2 + s) * 64 + lane) * 8, (v4u){w.x, w.y, w.z, w.w}); } }
        __syncthreads();
        if (tid < 64) { float s = 0.f;
#pragma unroll
            for (int v = 0; v < 8; ++v) s += part[v * 64 + tid];
            wt_st4f(KM + ((size_t)bh * NBLK + j) * 64 + tid, s * (1.0f / 256.0f)); }
    }
    __syncthreads();
}
__device__ __forceinline__ void memkv_items(unsigned char* ws, LAS unsigned char* lds, int vcu, int G, int wave, int lane) {
    const bf16* A = (const bf16*)(ws + WS_MEMB); const bf16* Bt = (const bf16*)(ws + WS_WMKV);
    bf16* MK = (bf16*)(ws + WS_MEMKF); bf16* MV = (bf16*)(ws + WS_MEMVF); const float* gk = (const float*)(ws + WS_GAINS) + 256;
    LAS float* red = (LAS float*)(lds + RING_OFF);
    for (int id = vcu; id < 32 * 8; id += G) {
        const int rt = id >> 3, ct = id & 7, fr = lane & 15, fq = lane >> 4;
        f32x4 acc[4];
#pragma unroll
        for (int nb = 0; nb < 4; ++nb) acc[nb] = (f32x4){0.f, 0.f, 0.f, 0.f};
        const bf16* ap = A + (size_t)(rt * 16 + fr) * D + fq * 8 + wave * 128;
        const bf16* bp = Bt + (size_t)(ct * 64 + fr) * D + fq * 8 + wave * 128;
        bf16x8 af[4], bfr[4][4];
#pragma unroll
        for (int ks = 0; ks < 4; ++ks) { af[ks] = *(const GAS bf16x8*)(ap + ks * 32);
#pragma unroll
            for (int nb = 0; nb < 4; ++nb) bfr[ks][nb] = *(const GAS bf16x8*)(bp + (size_t)nb * 16 * D + ks * 32); }
#pragma unroll
        for (int ks = 0; ks < 4; ++ks)
#pragma unroll
            for (int nb = 0; nb < 4; ++nb) acc[nb] = __builtin_amdgcn_mfma_f32_16x16x32_bf16(af[ks], bfr[ks][nb], acc[nb], 0, 0, 0);
        __syncthreads();
#pragma unroll
        for (int nb = 0; nb < 4; ++nb) *(LAS f32x4*)(red + ((wave * 4 + nb) * 64 + lane) * 4) = acc[nb];
        __syncthreads();
        if (wave == 0) {
            float gkv[4];
#pragma unroll
            for (int nb = 0; nb < 4; ++nb) gkv[nb] = *(const GAS float*)(gk + nb * 16 + fr);
#pragma unroll
            for (int nb = 0; nb < 4; ++nb) { f32x4 s = *(const LAS f32x4*)(red + (nb * 64 + lane) * 4);
#pragma unroll
                for (int w = 1; w < 8; ++w) s += *(const LAS f32x4*)(red + ((w * 4 + nb) * 64 + lane) * 4);
                acc[nb] = s; }
#pragma unroll
            for (int reg = 0; reg < 4; ++reg) { const int row = rt * 16 + 4 * fq + reg, bb = row >> 8, m = row & 255, kb = m >> 5, mm = m & 31;
                if (ct < 4) { float ss = 0.f;
#pragma unroll
                    for (int nb = 0; nb < 4; ++nb) ss += acc[nb][reg] * acc[nb][reg];
                    ss += __shfl_xor(ss, 1); ss += __shfl_xor(ss, 2); ss += __shfl_xor(ss, 4); ss += __shfl_xor(ss, 8);
                    const float rn = __builtin_amdgcn_rsqf(ss * (1.0f / 64.0f) + EPS);
#pragma unroll
                    for (int nb = 0; nb < 4; ++nb) { const int d = nb * 16 + fr;
                        wt_st2(MK + ((((size_t)((bb * 4 + ct) * 8 + kb) * 4 + (d >> 4)) * 64) + ((d >> 3) & 1) * 32 + mm) * 8 + (d & 7), f2bf(acc[nb][reg] * rn * gkv[nb])); }
                } else { const int s = mm >> 4, o = mm & 15, hi2 = (o >> 2) & 1, jj = 4 * (o >> 3) + (o & 3);
#pragma unroll
                    for (int nb = 0; nb < 4; ++nb) { const int d = nb * 16 + fr;
                        wt_st2(MV + (((((size_t)((bb * 4 + (ct - 4)) * 8 + kb) * 2 + (d >> 5)) * 2 + s) * 64) + hi2 * 32 + (d & 31)) * 8 + jj, f2bf(acc[nb][reg])); } } }
        }
    }
    __syncthreads();
}
typedef float f32x16 __attribute__((ext_vector_type(16)));
__device__ __forceinline__ int crow(int r, int hi) { return (r & 3) + 8 * (r >> 2) + 4 * hi; }
__device__ __forceinline__ unsigned cvtpk(float lo, float hi) { typedef float f2 __attribute__((ext_vector_type(2))); typedef __bf16 b2 __attribute__((ext_vector_type(2))); f2 v = {lo, hi}; b2 r = __builtin_convertvector(v, b2); return __builtin_bit_cast(unsigned, r); }
__device__ __forceinline__ void attn_task(f32x16& o0, f32x16& o1, float& lsum, const bf16* qrow, const bf16* KFb, const bf16* VFb, int nkb, float cq, float slopeL, int dist0, int lane) {
    const int r32 = lane & 31, hi = lane >> 5; (void)r32;
    bf16x8 qf[4];
#pragma unroll
    for (int ks = 0; ks < 4; ++ks) qf[ks] = *(const bf16x8*)(qrow + 16 * ks + 8 * hi);
    float base[16];
#pragma unroll
    for (int r = 0; r < 16; ++r) base[r] = slopeL * (float)crow(r, hi) + cq;
#pragma unroll
    for (int r = 0; r < 16; ++r) { o0[r] = 0.f; o1[r] = 0.f; }
    lsum = 0.f;
    const bf16* kp = KFb + lane * 8;
    const bf16* vp = VFb + lane * 8;
    bf16x8 kA[4], vA[4];
#define AT_LOADK(k_, kb_) do { _Pragma("unroll") for (int ks = 0; ks < 4; ++ks) k_[ks] = *(const bf16x8*)(kp + ((kb_) * 4 + ks) * 512); } while (0)
#define AT_LOADV(v_, kb_) do { _Pragma("unroll") for (int f = 0; f < 4; ++f) v_[f] = *(const bf16x8*)(vp + ((kb_) * 4 + f) * 512); } while (0)
    AT_LOADK(kA, 0); AT_LOADV(vA, 0);
#pragma unroll 1
    for (int kb = 0; kb < nkb; ++kb) {
        const float c0 = slopeL * (float)(32 * kb); f32x16 sc;
#pragma unroll
        for (int r = 0; r < 16; ++r) sc[r] = base[r] + c0;
#pragma unroll
        for (int ks = 0; ks < 4; ++ks) sc = __builtin_amdgcn_mfma_f32_32x32x16_bf16(kA[ks], qf[ks], sc, 0, 0, 0);
        if (kb + 1 < nkb) AT_LOADK(kA, kb + 1);
#pragma unroll
        for (int r = 0; r < 16; ++r) { float pr = __builtin_amdgcn_exp2f(sc[r]); if (32 * kb + crow(r, hi) > dist0) pr = 0.f; sc[r] = pr; lsum += pr; }
        v4u w0, w1; w0.x = cvtpk(sc[0], sc[1]); w0.y = cvtpk(sc[2], sc[3]); w0.z = cvtpk(sc[4], sc[5]); w0.w = cvtpk(sc[6], sc[7]); w1.x = cvtpk(sc[8], sc[9]); w1.y = cvtpk(sc[10], sc[11]); w1.z = cvtpk(sc[12], sc[13]); w1.w = cvtpk(sc[14], sc[15]);
        const bf16x8 p0 = __builtin_bit_cast(bf16x8, w0), p1 = __builtin_bit_cast(bf16x8, w1);
        o0 = __builtin_amdgcn_mfma_f32_32x32x16_bf16(vA[0], p0, o0, 0, 0, 0); o0 = __builtin_amdgcn_mfma_f32_32x32x16_bf16(vA[1], p1, o0, 0, 0, 0);
        o1 = __builtin_amdgcn_mfma_f32_32x32x16_bf16(vA[2], p0, o1, 0, 0, 0); o1 = __builtin_amdgcn_mfma_f32_32x32x16_bf16(vA[3], p1, o1, 0, 0, 0);
        if (kb + 1 < nkb) AT_LOADV(vA, kb + 1);
    }
#undef AT_LOADK
#undef AT_LOADV
}
constexpr int AU_KMT = 0;
constexpr int AU_SLOT = 0;
constexpr int AU_CNT = LDSCTL_OFF + 512, AU_TC = AU_CNT + 128, AU_TASKS = AU_TC + 16, AU_LIST = AU_TASKS + 240, AU_LACC = AU_LIST + 32 * 256 * 2, AU_END = AU_LACC + 4 * 256 * 4;
static_assert(AU_END <= LDS_BYTES, "MoBA unit LDS map");
__device__ __forceinline__ void moba_unit(unsigned char* ws, LAS unsigned char* lds, int bh, int qb, int wave, int lane, int tid) {
    const bf16* U = (const bf16*)(ws + WS_U); bf16* MIX = (bf16*)(ws + WS_MIX); const float* KM = (const float*)(ws + WS_KMEAN);
    const float* GT = (const float*)(ws + WS_GAINS);
    LAS unsigned* CNT = (LAS unsigned*)(lds + AU_CNT); LAS unsigned* TC = (LAS unsigned*)(lds + AU_TC);
    LAS unsigned short* TASKS = (LAS unsigned short*)(lds + AU_TASKS); LAS unsigned short* LIST = (LAS unsigned short*)(lds + AU_LIST);
    LAS float* KMT = (LAS float*)(lds + AU_KMT); LAS float* LACC = (LAS float*)(lds + AU_LACC);
    LAS unsigned char* SLOT = lds + AU_SLOT;
    const int b = bh >> 2, h = bh & 3, r32 = lane & 31, hi = lane >> 5;
    const size_t rb = (size_t)b * SEQ;
    const float slopeL = exp2f(-2.0f * (float)(h + 1)) * 1.4426950408889634f;
    const float MB2 = GT[192];
    const bf16* Qh = U + (rb + (size_t)qb * 256) * INW + 1024 + h * 64;
    const bf16* KFh = (const bf16*)(ws + WS_KF) + (size_t)bh * 256 * 2048;
    const bf16* VFh = (const bf16*)(ws + WS_VF) + (size_t)bh * 256 * 2048;
#ifndef REP_MB_SETUP
#define REP_MB_SETUP 1
#endif
    for (int rsu_ = 0; rsu_ < REP_MB_SETUP; ++rsu_) {
    __syncthreads();
    if (tid < 36) CNT[tid] = 0u;
    const int ql = wave * 32 + r32;
    unsigned qw[32];
    { const GAS v4u* p = (const GAS v4u*)(Qh + (size_t)ql * INW);
#pragma unroll
      for (int c = 0; c < 8; ++c) { const v4u w = p[c]; qw[4 * c] = w.x; qw[4 * c + 1] = w.y; qw[4 * c + 2] = w.z; qw[4 * c + 3] = w.w; } }
    for (int i = tid; i < qb * 64; i += 512) KMT[(i >> 6) * 65 + (i & 63)] = *(const GAS float*)(KM + (size_t)bh * NBLK * 64 + i);
    __syncthreads();
    if (qb > 0) {
        f32x16 g;
#pragma unroll
        for (int r = 0; r < 16; ++r) g[r] = 0.f;
#pragma unroll
        for (int ks = 0; ks < 32; ++ks) { const float a = KMT[r32 * 65 + 2 * ks + hi]; const float bq = hi ? bfhi(qw[ks]) : bflo(qw[ks]); g = __builtin_amdgcn_mfma_f32_32x32x2f32(a, bq, g, 0, 0, 0); }
        float g1 = -INFINITY, g2 = -INFINITY, g3 = -INFINITY; int i1 = 0, i2 = 0, i3 = 0;
#pragma unroll
        for (int r = 0; r < 16; ++r) { const int j = crow(r, hi); const float gv = (j < qb) ? g[r] : -INFINITY;
            const bool c1 = gv > g1, c2 = gv > g2, c3 = gv > g3;
            g3 = c2 ? g2 : (c3 ? gv : g3); i3 = c2 ? i2 : (c3 ? j : i3);
            g2 = c1 ? g1 : (c2 ? gv : g2); i2 = c1 ? i1 : (c2 ? j : i2);
            g1 = c1 ? gv : g1; i1 = c1 ? j : i1; }
        float pg[3]; int pi[3];
        pg[0] = __shfl_xor(g1, 32); pg[1] = __shfl_xor(g2, 32); pg[2] = __shfl_xor(g3, 32); pi[0] = __shfl_xor(i1, 32); pi[1] = __shfl_xor(i2, 32); pi[2] = __shfl_xor(i3, 32);
#pragma unroll
        for (int k = 0; k < 3; ++k) { const float gv = pg[k]; const int j = pi[k];
            const bool c1 = gv > g1 || (gv == g1 && j < i1), c2 = gv > g2 || (gv == g2 && j < i2), c3 = gv > g3 || (gv == g3 && j < i3);
            g3 = c2 ? g2 : (c3 ? gv : g3); i3 = c2 ? i2 : (c3 ? j : i3);
            g2 = c1 ? g1 : (c2 ? gv : g2); i2 = c1 ? i1 : (c2 ? j : i2);
            g1 = c1 ? gv : g1; i1 = c1 ? j : i1; }
        if (hi == 0) { const int nok = qb < 3 ? qb : 3;
            if (nok > 0) { const unsigned pos = atomicAdd((unsigned*)&CNT[i1], 1u); LIST[i1 * 256 + pos] = (unsigned short)ql; }
            if (nok > 1) { const unsigned pos = atomicAdd((unsigned*)&CNT[i2], 1u); LIST[i2 * 256 + pos] = (unsigned short)(ql | 0x100); }
            if (nok > 2) { const unsigned pos = atomicAdd((unsigned*)&CNT[i3], 1u); LIST[i3 * 256 + pos] = (unsigned short)(ql | 0x200); } }
    }
    __syncthreads();
    if (wave == 0) {
        const unsigned c = (lane < qb && lane < 32) ? CNT[lane] : 0u; const int ng = (int)((c + 31u) >> 5);
        int incl = ng;
#pragma unroll
        for (int o = 1; o < 64; o <<= 1) { const int t = __shfl_up(incl, o); if (lane >= o) incl += t; }
        const int off = incl - ng, total = __shfl(incl, 63);
#ifdef MB_SHARED_FIRST
        for (int g = 0; g < ng; ++g) TASKS[16 + off + g] = (unsigned short)((lane << 8) | g);
        if (lane < 8) { TASKS[lane] = (unsigned short)(0x4000 | lane); TASKS[8 + lane] = (unsigned short)(0x8000 | lane); }
#else
        for (int g = 0; g < ng; ++g) TASKS[off + g] = (unsigned short)((lane << 8) | g);
        if (lane < 8) { TASKS[total + lane] = (unsigned short)(0x8000 | (7 - lane)); TASKS[total + 8 + lane] = (unsigned short)(0x4000 | lane); }
#endif
        if (lane == 0) TC[0] = (unsigned)(total + 16);
    }
    __syncthreads();
    }
    const int ntasks = (int)TC[0];
#ifndef REP_MB_STREAM
#define REP_MB_STREAM 1
#endif
#ifdef MB_ROT4
    for (int rst_ = 0; rst_ < REP_MB_STREAM; ++rst_)
    if (wave < ntasks) {
        int lane; asm volatile("v_mbcnt_lo_u32_b32 %0, -1, 0\n\tv_mbcnt_hi_u32_b32 %0, -1, %0" : "=v"(lane));
        const int r32 = lane & 31, hi = lane >> 5; unsigned loffB = (unsigned)lane * 16u;
        int t = wave;
        int c_j, c_nkb, c_slot, c_ql, c_dist0; bool c_valid, c_own, c_mem;
#define MB_DECODE(T, J, NKB, SLOT, QL, DIST0, VALID, OWN, MEM) do { const unsigned tk_ = (unsigned)__builtin_amdgcn_readfirstlane((int)TASKS[T]); MEM = (tk_ & 0x4000u) != 0u; OWN = (tk_ & 0x8000u) != 0u; \
        if (MEM) { QL = (int)(tk_ & 7u) * 32 + r32; SLOT = 4; J = 0; NKB = 8; DIST0 = 1 << 20; VALID = true; } \
        else if (OWN) { const int w_ = (int)(tk_ & 7u); QL = w_ * 32 + r32; SLOT = 3; J = qb; NKB = (w_ + 2) & ~1; DIST0 = QL; VALID = true; } \
        else { J = (int)(tk_ >> 8); const int g_ = (int)(tk_ & 0xffu); const int cnt_ = (int)CNT[J]; const int idx_ = 32 * g_ + r32; VALID = idx_ < cnt_; const unsigned e_ = LIST[J * 256 + (VALID ? idx_ : 32 * g_)]; \
               QL = (int)(e_ & 0xffu); SLOT = (int)(e_ >> 8); NKB = 8; DIST0 = 1 << 20; } } while (0)
        MB_DECODE(t, c_j, c_nkb, c_slot, c_ql, c_dist0, c_valid, c_own, c_mem);
        bf16x8 qf[4], qfn[4], kA[4], vA[4], kB[4], vB[4];
        const bf16* MKFh = (const bf16*)(ws + WS_MEMKF) + (size_t)bh * 8 * 2048; const bf16* MVFh = (const bf16*)(ws + WS_MEMVF) + (size_t)bh * 8 * 2048; const float MBM = GT[193];
        { const bf16* qrow = Qh + (size_t)c_ql * INW + 8 * hi + (c_mem ? 768 : 0);
#pragma unroll
          for (int ks = 0; ks < 4; ++ks) qf[ks] = *(const GAS bf16x8*)(qrow + 16 * ks); }
        const bf16* kp = c_mem ? MKFh : KFh + (size_t)c_j * 16384; const bf16* vp = c_mem ? MVFh : VFh + (size_t)c_j * 16384;
#define MB_LOADF(F_, P, KB) do { const GAS char* b_ = (const GAS char*)((P) + (KB) * 2048); _Pragma("unroll") for (int f = 0; f < 4; ++f) F_[f] = *(const GAS bf16x8*)(b_ + f * 1024 + loffB); } while (0)
#define MB_QK(K_, KB) const float c0_ = __builtin_fmaf(c_slope, (float)(32 * (KB)), cqh); f32x16 sc; _Pragma("unroll") for (int r = 0; r < 16; ++r) sc[r] = __builtin_fmaf(c_slope, (float)((r & 3) + 8 * (r >> 2)), c0_); \
        _Pragma("unroll") for (int ks = 0; ks < 4; ++ks) sc = __builtin_amdgcn_mfma_f32_32x32x16_bf16(K_[ks], qf[ks], sc, 0, 0, 0);
#define MB_PV(V_, KB) \
        if (c_own) { _Pragma("unroll") for (int r = 0; r < 16; ++r) { float pr = __builtin_amdgcn_exp2f(sc[r]); if (32 * (KB) + crow(r, hi) > c_dist0) pr = 0.f; sc[r] = pr; ls += pr; } } \
        else { _Pragma("unroll") for (int r = 0; r < 16; ++r) { const float pr = __builtin_amdgcn_exp2f(sc[r]); sc[r] = pr; ls += pr; } } \
        v4u w0_, w1_; w0_.x = cvtpk(sc[0], sc[1]); w0_.y = cvtpk(sc[2], sc[3]); w0_.z = cvtpk(sc[4], sc[5]); w0_.w = cvtpk(sc[6], sc[7]); w1_.x = cvtpk(sc[8], sc[9]); w1_.y = cvtpk(sc[10], sc[11]); w1_.z = cvtpk(sc[12], sc[13]); w1_.w = cvtpk(sc[14], sc[15]); \
        const bf16x8 p0_ = __builtin_bit_cast(bf16x8, w0_), p1_ = __builtin_bit_cast(bf16x8, w1_); \
        o0 = __builtin_amdgcn_mfma_f32_32x32x16_bf16(V_[0], p0_, o0, 0, 0, 0); o0 = __builtin_amdgcn_mfma_f32_32x32x16_bf16(V_[1], p1_, o0, 0, 0, 0); \
        o1 = __builtin_amdgcn_mfma_f32_32x32x16_bf16(V_[2], p0_, o1, 0, 0, 0); o1 = __builtin_amdgcn_mfma_f32_32x32x16_bf16(V_[3], p1_, o1, 0, 0, 0);
#define MB_SB __builtin_amdgcn_sched_barrier(0)
#define MB_PINK asm volatile("" :: "v"(sc) : "memory")
#define MB_PINV asm volatile("" :: "v"(o0), "v"(o1) : "memory")
        MB_LOADF(kA, kp, 0); MB_LOADF(vA, vp, 0); MB_LOADF(kB, kp, 1); MB_LOADF(vB, vp, 1);
#pragma unroll 1
        for (;;) {
            const int tn = t + 8; const bool has_next = tn < ntasks;
            int n_j = 0, n_nkb = 0, n_slot = 0, n_ql = 0, n_dist0 = 0; bool n_valid = false, n_own = false, n_mem = false;
            const bf16* kpn = kp; const bf16* vpn = vp;
            if (has_next) { MB_DECODE(tn, n_j, n_nkb, n_slot, n_ql, n_dist0, n_valid, n_own, n_mem);
                const bf16* qrow = Qh + (size_t)n_ql * INW + 8 * hi + (n_mem ? 768 : 0);
#pragma unroll
                for (int ks = 0; ks < 4; ++ks) qfn[ks] = *(const GAS bf16x8*)(qrow + 16 * ks);
                kpn = n_mem ? MKFh : KFh + (size_t)n_j * 16384; vpn = n_mem ? MVFh : VFh + (size_t)n_j * 16384; }
            const float c_slope = c_mem ? 0.f : slopeL;
            const float cq = c_mem ? -MBM : -MB2 - slopeL * (float)((qb - c_j) * 256 + c_ql);
            const float cqh = __builtin_fmaf(c_slope, (float)(4 * hi), cq);
            f32x16 o0, o1; float ls = 0.f;
#pragma unroll
            for (int r = 0; r < 16; ++r) { o0[r] = 0.f; o1[r] = 0.f; }
#pragma unroll 1
            for (int kb = 0; kb < c_nkb; kb += 2) {
                const bool more = kb + 2 < c_nkb; const bf16* kq = more ? kp : kpn; const bf16* vq = more ? vp : vpn; const int kbq = more ? kb + 2 : 0;
                { MB_QK(kA, kb) MB_PINK; MB_LOADF(kA, kq, kbq); MB_SB; MB_PV(vA, kb) MB_PINV; MB_LOADF(vA, vq, kbq); MB_SB; }
                { MB_QK(kB, kb + 1) MB_PINK; MB_LOADF(kB, kq, kbq + 1); MB_SB; MB_PV(vB, kb + 1) MB_PINV; MB_LOADF(vB, vq, kbq + 1); MB_SB; }
            }
            ls += __shfl_xor(ls, 32);
            if (c_mem) { const float il = 1.0f / ls; bf16* dst = MIX + (rb + (size_t)qb * 256 + c_ql) * D + 768 + h * 64;
#pragma unroll
                for (int q4 = 0; q4 < 4; ++q4) { uint2 w;
                    w.x = cvtpk(o0[4 * q4] * il, o0[4 * q4 + 1] * il); w.y = cvtpk(o0[4 * q4 + 2] * il, o0[4 * q4 + 3] * il); wt_st8(dst + 8 * q4 + 4 * hi, (unsigned long long)w.x | ((unsigned long long)w.y << 32));
                    w.x = cvtpk(o1[4 * q4] * il, o1[4 * q4 + 1] * il); w.y = cvtpk(o1[4 * q4 + 2] * il, o1[4 * q4 + 3] * il); wt_st8(dst + 32 + 8 * q4 + 4 * hi, (unsigned long long)w.x | ((unsigned long long)w.y << 32)); } }
            else if (c_valid) { LAS unsigned char* rowp = SLOT + (c_slot * 256 + c_ql) * 128; const int sw = c_ql & 15;
                typedef unsigned u2v __attribute__((ext_vector_type(2)));
#pragma unroll
                for (int q4 = 0; q4 < 4; ++q4) { *(LAS u2v*)(rowp + (((2 * q4 + hi) ^ sw) << 3)) = (u2v){cvtpk(o0[4 * q4], o0[4 * q4 + 1]), cvtpk(o0[4 * q4 + 2], o0[4 * q4 + 3])};
                    *(LAS u2v*)(rowp + (((8 + 2 * q4 + hi) ^ sw) << 3)) = (u2v){cvtpk(o1[4 * q4], o1[4 * q4 + 1]), cvtpk(o1[4 * q4 + 2], o1[4 * q4 + 3])}; }
                if (hi == 0) LACC[c_slot * 256 + c_ql] = ls; }
            if (!has_next) break;
            t = tn; c_j = n_j; c_nkb = n_nkb; c_slot = n_slot; c_ql = n_ql; c_dist0 = n_dist0; c_valid = n_valid; c_own = n_own; c_mem = n_mem; kp = kpn; vp = vpn;
#pragma unroll
            for (int ks = 0; ks < 4; ++ks) qf[ks] = qfn[ks];
        }
#undef MB_DECODE
#undef MB_LOADF
#undef MB_QK
#undef MB_PV
#undef MB_SB
#undef MB_PINK
#undef MB_PINV
    }
#else
    for (int rst_ = 0; rst_ < REP_MB_STREAM; ++rst_)
    if (wave < ntasks) {
        int lane; asm volatile("v_mbcnt_lo_u32_b32 %0, -1, 0\n\tv_mbcnt_hi_u32_b32 %0, -1, %0" : "=v"(lane));
        const int r32 = lane & 31, hi = lane >> 5;
        int t = wave;
        int c_j, c_nkb, c_slot, c_ql, c_dist0; bool c_valid, c_own;
#define MB_DECODE(T, J, NKB, SLOT, QL, DIST0, VALID, OWN) do { const unsigned tk_ = TASKS[T]; \
        if (tk_ & 0x4000u) { QL = (int)(tk_ & 7u) * 32 + r32; SLOT = 4; J = 0; NKB = 8; DIST0 = 1 << 20; VALID = true; OWN = false; } \
        else if (tk_ & 0x8000u) { const int w_ = (int)(tk_ & 7u); QL = w_ * 32 + r32; SLOT = 3; J = qb; NKB = (w_ + 2) & ~1; DIST0 = QL; VALID = true; OWN = true; } \
        else { J = (int)(tk_ >> 8); const int g_ = (int)(tk_ & 0xffu); const int cnt_ = (int)CNT[J]; const int idx_ = 32 * g_ + r32; VALID = idx_ < cnt_; const unsigned e_ = LIST[J * 256 + (VALID ? idx_ : 32 * g_)]; \
               QL = (int)(e_ & 0xffu); SLOT = (int)(e_ >> 8); NKB = 8; DIST0 = 1 << 20; OWN = false; } } while (0)
        MB_DECODE(t, c_j, c_nkb, c_slot, c_ql, c_dist0, c_valid, c_own);
        bf16x8 qf[4], qfn[4], kA[4], vA[4], kB[4], vB[4];
        const bf16* MKFh = (const bf16*)(ws + WS_MEMKF) + (size_t)bh * 8 * 2048; const bf16* MVFh = (const bf16*)(ws + WS_MEMVF) + (size_t)bh * 8 * 2048; const float MBM = GT[193];
        { const bf16* qrow = Qh + (size_t)c_ql * INW + 8 * hi + (c_slot == 4 ? 768 : 0);
#pragma unroll
          for (int ks = 0; ks < 4; ++ks) qf[ks] = *(const GAS bf16x8*)(qrow + 16 * ks); }
        const bf16* kp = (c_slot == 4 ? MKFh : KFh + (size_t)c_j * 16384) + lane * 8; const bf16* vp = (c_slot == 4 ? MVFh : VFh + (size_t)c_j * 16384) + lane * 8;
#ifdef MB_PROBE_VAR
        const int pvar_ = (REP_MB_STREAM == 2 && rst_ == 0) ? MB_PROBE_VAR : 0;
#define MB_KBE(KB) (pvar_ == 1 ? 0 : (KB))
#define MB_NOEXP (pvar_ == 2)
#define MB_NOMMA (pvar_ == 3)
#define MB_NKB(n) (pvar_ == 4 ? 0 : (n))
#else
#define MB_NKB(n) (n)
#define MB_KBE(KB) (KB)
#define MB_NOEXP false
#define MB_NOMMA false
#endif
#define MB_LOADK(K_, KP, KB) do { _Pragma("unroll") for (int f = 0; f < 4; ++f) K_[f] = *(const GAS bf16x8*)((KP) + (MB_KBE(KB) * 4 + f) * 512); } while (0)
#define MB_LOADV(V_, VP, KB) do { _Pragma("unroll") for (int f = 0; f < 4; ++f) V_[f] = *(const GAS bf16x8*)((VP) + (MB_KBE(KB) * 4 + f) * 512); } while (0)
#define MB_LOAD(K_, V_, KP, VP, KB) do { MB_LOADK(K_, KP, KB); MB_LOADV(V_, VP, KB); } while (0)
#define MB_QK(K_, KB) const float c0_ = __builtin_fmaf(c_slope, (float)(32 * (KB)), cqh); f32x16 sc; _Pragma("unroll") for (int r = 0; r < 16; ++r) sc[r] = __builtin_fmaf(c_slope, (float)((r & 3) + 8 * (r >> 2)), c0_); \
        if (!MB_NOMMA) { _Pragma("unroll") for (int ks = 0; ks < 4; ++ks) sc = __builtin_amdgcn_mfma_f32_32x32x16_bf16(K_[ks], qf[ks], sc, 0, 0, 0); }
#define MB_PV(V_, KB) \
        if (MB_NOEXP) { _Pragma("unroll") for (int r = 0; r < 16; ++r) ls += sc[r]; } else \
        if (c_own) { _Pragma("unroll") for (int r = 0; r < 16; ++r) { float pr = __builtin_amdgcn_exp2f(sc[r]); if (32 * (KB) + crow(r, hi) > c_dist0) pr = 0.f; sc[r] = pr; ls += pr; } } \
        else { _Pragma("unroll") for (int r = 0; r < 16; ++r) { const float pr = __builtin_amdgcn_exp2f(sc[r]); sc[r] = pr; ls += pr; } } \
        v4u w0_, w1_; w0_.x = cvtpk(sc[0], sc[1]); w0_.y = cvtpk(sc[2], sc[3]); w0_.z = cvtpk(sc[4], sc[5]); w0_.w = cvtpk(sc[6], sc[7]); w1_.x = cvtpk(sc[8], sc[9]); w1_.y = cvtpk(sc[10], sc[11]); w1_.z = cvtpk(sc[12], sc[13]); w1_.w = cvtpk(sc[14], sc[15]); \
        const bf16x8 p0_ = __builtin_bit_cast(bf16x8, w0_), p1_ = __builtin_bit_cast(bf16x8, w1_); \
        if (!MB_NOMMA) { o0 = __builtin_amdgcn_mfma_f32_32x32x16_bf16(V_[0], p0_, o0, 0, 0, 0); o0 = __builtin_amdgcn_mfma_f32_32x32x16_bf16(V_[1], p1_, o0, 0, 0, 0); \
        o1 = __builtin_amdgcn_mfma_f32_32x32x16_bf16(V_[2], p0_, o1, 0, 0, 0); o1 = __builtin_amdgcn_mfma_f32_32x32x16_bf16(V_[3], p1_, o1, 0, 0, 0); } \
        else { _Pragma("unroll") for (int f = 0; f < 4; ++f) asm volatile("" :: "v"(V_[f])); asm volatile("" :: "v"(p0_), "v"(p1_)); }
#define MB_COMP(K_, V_, KB) do { MB_QK(K_, KB) MB_PV(V_, KB) } while (0)
        MB_LOAD(kA, vA, kp, vp, 0);
#pragma unroll 1
        for (;;) {
            const int tn = t + 8; const bool has_next = tn < ntasks;
            int n_j = 0, n_nkb = 0, n_slot = 0, n_ql = 0, n_dist0 = 0; bool n_valid = false, n_own = false;
            const bf16* kpn = kp; const bf16* vpn = vp;
            if (has_next) { MB_DECODE(tn, n_j, n_nkb, n_slot, n_ql, n_dist0, n_valid, n_own);
                const bf16* qrow = Qh + (size_t)n_ql * INW + 8 * hi + (n_slot == 4 ? 768 : 0);
#pragma unroll
                for (int ks = 0; ks < 4; ++ks) qfn[ks] = *(const GAS bf16x8*)(qrow + 16 * ks);
                kpn = (n_slot == 4 ? MKFh : KFh + (size_t)n_j * 16384) + lane * 8; vpn = (n_slot == 4 ? MVFh : VFh + (size_t)n_j * 16384) + lane * 8; }
            const float c_slope = c_slot == 4 ? 0.f : slopeL;
            const float cq = c_slot == 4 ? -MBM : -MB2 - slopeL * (float)((qb - c_j) * 256 + c_ql);
            const float cqh = __builtin_fmaf(c_slope, (float)(4 * hi), cq);
            f32x16 o0, o1; float ls = 0.f;
#pragma unroll
            for (int r = 0; r < 16; ++r) { o0[r] = 0.f; o1[r] = 0.f; }
#pragma unroll 1
            for (int kb = 0; kb < MB_NKB(c_nkb); kb += 2) {
                MB_LOAD(kB, vB, kp, vp, kb + 1);
                MB_COMP(kA, vA, kb);
                { const bool more = kb + 2 < c_nkb; const bf16* kq = more ? kp : kpn; const bf16* vq = more ? vp : vpn; const int kbq = more ? kb + 2 : 0;
                  MB_LOAD(kA, vA, kq, vq, kbq); }
                MB_COMP(kB, vB, kb + 1);
            }
            ls += __shfl_xor(ls, 32);
            if (c_slot == 4) { const float il = 1.0f / ls; bf16* dst = MIX + (rb + (size_t)qb * 256 + c_ql) * D + 768 + h * 64;
#pragma unroll
                for (int q4 = 0; q4 < 4; ++q4) { uint2 w;
                    w.x = cvtpk(o0[4 * q4] * il, o0[4 * q4 + 1] * il); w.y = cvtpk(o0[4 * q4 + 2] * il, o0[4 * q4 + 3] * il); wt_st8(dst + 8 * q4 + 4 * hi, (unsigned long long)w.x | ((unsigned long long)w.y << 32));
                    w.x = cvtpk(o1[4 * q4] * il, o1[4 * q4 + 1] * il); w.y = cvtpk(o1[4 * q4 + 2] * il, o1[4 * q4 + 3] * il); wt_st8(dst + 32 + 8 * q4 + 4 * hi, (unsigned long long)w.x | ((unsigned long long)w.y << 32)); } }
            else if (c_valid) { LAS unsigned char* rowp = SLOT + (c_slot * 256 + c_ql) * 128; const int sw = c_ql & 15;
                typedef unsigned u2v __attribute__((ext_vector_type(2)));
#pragma unroll
                for (int q4 = 0; q4 < 4; ++q4) { *(LAS u2v*)(rowp + (((2 * q4 + hi) ^ sw) << 3)) = (u2v){cvtpk(o0[4 * q4], o0[4 * q4 + 1]), cvtpk(o0[4 * q4 + 2], o0[4 * q4 + 3])};
                    *(LAS u2v*)(rowp + (((8 + 2 * q4 + hi) ^ sw) << 3)) = (u2v){cvtpk(o1[4 * q4], o1[4 * q4 + 1]), cvtpk(o1[4 * q4 + 2], o1[4 * q4 + 3])}; }
                if (hi == 0) LACC[c_slot * 256 + c_ql] = ls; }
            if (!has_next) break;
            t = tn; c_j = n_j; c_nkb = n_nkb; c_slot = n_slot; c_ql = n_ql; c_dist0 = n_dist0; c_valid = n_valid; c_own = n_own; kp = kpn; vp = vpn;
#pragma unroll
            for (int ks = 0; ks < 4; ++ks) qf[ks] = qfn[ks];
        }
#undef MB_DECODE
#undef MB_LOAD
#undef MB_COMP
#undef MB_QK
#undef MB_PV
#undef MB_LOADK
#undef MB_LOADV
    }
#endif
    __syncthreads();
    { int lane; asm volatile("v_mbcnt_lo_u32_b32 %0, -1, 0\n\tv_mbcnt_hi_u32_b32 %0, -1, %0" : "=v"(lane)); const int tid = wave * 64 + lane;
      const int row = tid >> 1, half = tid & 1; const int nok = qb < 3 ? qb : 3; const int sw = row & 15;
      typedef unsigned u2v __attribute__((ext_vector_type(2)));
      float acc[32]; float l = LACC[3 * 256 + row];
      { const LAS unsigned char* rowp = SLOT + (3 * 256 + row) * 128;
#pragma unroll
        for (int c = 0; c < 8; ++c) { const u2v w = *(const LAS u2v*)(rowp + (((8 * half + c) ^ sw) << 3)); acc[4 * c] = bflo(w.x); acc[4 * c + 1] = bfhi(w.x); acc[4 * c + 2] = bflo(w.y); acc[4 * c + 3] = bfhi(w.y); } }
#pragma unroll
      for (int s = 0; s < 3; ++s) if (s < nok) { const LAS unsigned char* rowp = SLOT + (s * 256 + row) * 128; l += LACC[s * 256 + row];
#pragma unroll
        for (int c = 0; c < 8; ++c) { const u2v w = *(const LAS u2v*)(rowp + (((8 * half + c) ^ sw) << 3)); acc[4 * c] += bflo(w.x); acc[4 * c + 1] += bfhi(w.x); acc[4 * c + 2] += bflo(w.y); acc[4 * c + 3] += bfhi(w.y); } }
      const float il = 1.0f / l;
      uint4* dst = (uint4*)(MIX + (rb + (size_t)qb * 256 + row) * D + 512 + h * 64 + half * 32);
#pragma unroll
      for (int c = 0; c < 4; ++c) { uint4 w; w.x = cvtpk(acc[8 * c] * il, acc[8 * c + 1] * il); w.y = cvtpk(acc[8 * c + 2] * il, acc[8 * c + 3] * il); w.z = cvtpk(acc[8 * c + 4] * il, acc[8 * c + 5] * il); w.w = cvtpk(acc[8 * c + 6] * il, acc[8 * c + 7] * il); wt_st16(dst + c, (v4u){w.x, w.y, w.z, w.w}); } }
    __syncthreads();
}
__device__ __forceinline__ void memattn_unit(unsigned char* ws, int bh, int qb, int wave, int lane) {
    const bf16* U = (const bf16*)(ws + WS_U); bf16* MIX = (bf16*)(ws + WS_MIX); const float* GT = (const float*)(ws + WS_GAINS);
    const int b = bh >> 2, h = bh & 3, r32 = lane & 31, hi = lane >> 5;
    const size_t row = (size_t)b * SEQ + qb * 256 + wave * 32 + r32;
    const bf16* KFh = (const bf16*)(ws + WS_MEMKF) + (size_t)bh * 8 * 2048;
    const bf16* VFh = (const bf16*)(ws + WS_MEMVF) + (size_t)bh * 8 * 2048;
    f32x16 o0, o1; float ls;
    attn_task(o0, o1, ls, U + row * INW + 1792 + h * 64, KFh, VFh, 8, -GT[193], 0.f, 1 << 20, lane);
    ls += __shfl_xor(ls, 32);
    const float il = 1.0f / ls;
    bf16* dst = MIX + row * D + 768 + h * 64;
#pragma unroll
    for (int q4 = 0; q4 < 4; ++q4) { uint2 w;
        w.x = cvtpk(o0[4 * q4] * il, o0[4 * q4 + 1] * il); w.y = cvtpk(o0[4 * q4 + 2] * il, o0[4 * q4 + 3] * il); wt_st8(dst + 8 * q4 + 4 * hi, (unsigned long long)w.x | ((unsigned long long)w.y << 32));
        w.x = cvtpk(o1[4 * q4] * il, o1[4 * q4 + 1] * il); w.y = cvtpk(o1[4 * q4 + 2] * il, o1[4 * q4 + 3] * il); wt_st8(dst + 32 + 8 * q4 + 4 * hi, (unsigned long long)w.x | ((unsigned long long)w.y << 32)); }
}
struct Args { const float* in[24]; float* out; unsigned char* ws; int ph_lo, ph_hi; };
__global__ void __launch_bounds__(NWAVES * 64, 2) hymba_fwd(Args args) {
    extern __shared__ __attribute__((aligned(16))) unsigned char lds[];
    LAS unsigned char* L = (LAS unsigned char*)lds;
    volatile LAS unsigned* MISC = (volatile LAS unsigned*)(L + MISC_OFF);
    const int wave = __builtin_amdgcn_readfirstlane(threadIdx.x >> 6);
#define LANE_TID() int lane; asm volatile("v_mbcnt_lo_u32_b32 %0, -1, 0\n\tv_mbcnt_hi_u32_b32 %0, -1, %0" : "=v"(lane)); const int tid = wave * 64 + lane; (void)tid
    const int G = gridDim.x; const int bx = blockIdx.x; const int vcu = (G % 8 == 0) ? (bx % 8) * (G / 8) + bx / 8 : bx;
    unsigned char* const ws0 = args.ws; const float* const* in = args.in; float* out = args.out;
    gu32* ctl = (gu32*)(ws0 + WS_CTL);
    { LANE_TID(); for (int u = tid; u < (LDS_BYTES - LDSCTL_OFF) / 4; u += NWAVES * 64) ((LAS unsigned*)(L + LDSCTL_OFF))[u] = 0u; }
    __syncthreads();
    XcdBarrier bar; bar.bar = (unsigned*)(ctl + CW_BAR); bar.x = 0; bar.st = nullptr; bar.wave = wave;
    if (N_LAUNCHES == 1) bar = xcd_barrier_post((unsigned*)(ctl + CW_BAR), MISC + 8, wave);
#define GRID_BAR() do { if (N_LAUNCHES == 1) xcd_barrier(bar); } while (0)
#ifdef WT_ALL
#define GRID_BAR_NW() do { if (N_LAUNCHES == 1) xcd_barrier(bar, false); } while (0)
#else
#define GRID_BAR_NW() GRID_BAR()
#endif
#ifdef LABEL_BARS
#define LABEL_BAR(sig, e, need) do { if (N_LAUNCHES == 1) { if (G % 8 == 0) label_barrier((unsigned*)ctl, (unsigned*)(ctl + CW_BAR), bx & 7, (unsigned)(G / 8), wave, (sig), (unsigned*)(ctl + LB_EV(e)), (unsigned)(need)); else xcd_barrier(bar); } } while (0)
#else
#define LABEL_BAR(sig, e, need) GRID_BAR()
#endif
    const int lo = args.ph_lo, hi = args.ph_hi;
#ifndef PH_MASK
#define PH_MASK 0x1ff
#endif
#define IN(k) (((PH_MASK >> (k)) & 1) && lo <= (k) && (k) < hi)
#define BOTH(k) (IN(k) && IN((k) + 1))
#ifndef REP_MASK
#define REP_MASK 0
#endif
#define REPS(k) (((REP_MASK >> (k)) & 1) ? 2 : 1)
#ifndef REP_SUB
#define REP_SUB 0
#endif
#define RSUB(k) for (int rs_ = 0; rs_ < (((REP_SUB >> (k)) & 1) ? 2 : 1); ++rs_)
#define WSP() unsigned char* ws = ws0; asm volatile("" : "+s"(ws)); (void)ws
#define XB ((bf16*)(ws + WS_XB))
#define HB ((bf16*)(ws + WS_H))
#define UB ((bf16*)(ws + WS_U))
#define MIX ((bf16*)(ws + WS_MIX))
#define SSQ0 ((float*)(ws + WS_SSQ0))
#define SSQ1 ((float*)(ws + WS_SSQ1))
#define SSQ2 ((float*)(ws + WS_SSQ2))

    for (int rep = 0; rep < REPS(0); ++rep) if (IN(0)) { WSP(); LANE_TID(); p0_prologue(in, ws, L, vcu, G, wave, lane);
        if (bx == 0 && tid < 192) wt_st4f((float*)(ws + WS_GAINS) + tid, (tid < 64 ? in[15][tid] : tid < 128 ? in[16][tid - 64] : in[18][tid - 128]));
        if (bx == 0 && tid < 64) wt_st4f((float*)(ws + WS_GAINS) + 256 + tid, in[19][tid]);
        if (bx == 1) { float* PTB = (float*)(ws + WS_PTAB);
            for (int i = tid; i < 8 * 512; i += 512) { const int row = i >> 9, gc = i & 511; float v;
                if (row < 4) v = in[8][row * 512 + gc]; else if (row == 4) v = in[9][gc]; else if (row == 5) v = -8.0f * 1.4426950408889634f * log1pf(__expf(-in[14][gc])); else if (row == 6) v = 1.4426950408889634f * in[11][gc]; else v = 1.4426950408889634f * in[13][gc];
                wt_st4f(PTB + i, v); } }
        if (bx == 0 && wave == 3) {
            const float mq = wave_max(fabsf(in[15][lane])), mk = wave_max(fabsf(in[16][lane])), cq = wave_max(fabsf(in[18][lane])), ck = wave_max(fabsf(in[19][lane]));
            if (lane == 0) { wt_st4f((float*)(ws + WS_GAINS) + 192, 8.0f * mq * mk * 1.4426950408889634f); wt_st4f((float*)(ws + WS_GAINS) + 193, 8.0f * cq * ck * 1.4426950408889634f); } } if (BOTH(0)) GRID_BAR_NW(); }
    for (int rep = 0; rep < REPS(1); ++rep) if (IN(1)) { WSP();
        pg8::Gemm g{XB, (const bf16*)(ws + WS_W1I), M, 2 * FF, D}; pg8::StaticOrder S; S.init(M, 2 * FF, G, bx);
#ifdef PROBE_NOMMA
        g.nomma = (REPS(1) == 2 && rep == 0) ? 1 : 0;
#endif
        pg8::EpiSwiGLU E{HB, FF, SSQ0};
        pg8::gemm_phase<pg8::EpiSwiGLU, pg8::StaticOrder, PG8_ALIGN, PG8_SP2>(L + RING_OFF, g, S, E, wave);
        bool tail1 = false; int ntail1 = 0;
        { pg8::Unit u6; const int nwg = (M / 256) * (2 * FF / 256), nshort = (nwg % G) ? G - nwg % G : 0;
          if (nshort > 0 && !S.next(nwg / G, u6)) { __syncthreads(); LANE_TID(); memkv_items(ws, L, bx - (G - nshort), nshort, wave, lane);
              p0_weights<1>(in, ws, L, (bx - (G - nshort)) * NWAVES + wave, nshort * NWAVES, wave, lane); tail1 = true; }
          else if (nshort == 0) { __syncthreads(); LANE_TID(); p0_weights<1>(in, ws, L, vcu * NWAVES + wave, G * NWAVES, wave, lane); tail1 = true; }
          ntail1 = nshort > 0 ? nshort : G; }
        if (BOTH(1)) GRID_BAR_NW();
    }
    for (int rep = 0; rep < REPS(2); ++rep) if (IN(2)) { WSP();
        pg8::Gemm g{HB, (const bf16*)(ws + WS_W1O), M, D, FF}; pg8::StaticOrder S; S.init(M, D, G, bx);
        pg8::EpiResid E{XB, XB, nullptr, SSQ1, 0.5f};
        pg8::gemm_phase<pg8::EpiResid, pg8::StaticOrder, false, PG8_SP2>(L + RING_OFF, g, S, E, wave);
        if (BOTH(2)) GRID_BAR_NW();
    }
    for (int rep = 0; rep < REPS(3); ++rep) if (IN(3)) { WSP();
        pg8::Gemm g{XB, (const bf16*)(ws + WS_WIN), M, INW, D}; pg8::StaticOrder S; S.init(M, INW, G, bx);
        pg8::EpiWin E{UB, SSQ1, (const float*)(ws + WS_GAINS)};
        pg8::gemm_phase<pg8::EpiWin, pg8::StaticOrder, PG8_ALIGN, PG8_SP2>(L + RING_OFF, g, S, E, wave);
        if (BOTH(3)) GRID_BAR_NW();
    }
#ifdef EXTRA_BARS
    for (int eb = 0; eb < EXTRA_BARS; ++eb) GRID_BAR();
#endif
    for (int rep = 0; rep < REPS(4); ++rep) if (IN(4)) {
        RSUB(0) { WSP(); LANE_TID(); lru_items<true>(ws, L, G, wave, tid); }
        RSUB(1) { WSP(); LANE_TID(); kvprep_items(ws, L, G, wave, lane, tid); }
        if ((((M / 256) * (2 * FF / 256)) % G) == 0) RSUB(2) { WSP(); LANE_TID(); memkv_items(ws, L, vcu, G, wave, lane); }
        if (BOTH(4)) GRID_BAR_NW();
    }
    for (int rep = 0; rep < REPS(5); ++rep) if (IN(5)) {
#ifndef NO_MOBA
        RSUB(4) { WSP(); LANE_TID(); for (int id = vcu; id < BATCH * 4 * NBLK; id += G) moba_unit(ws, L, id >> 5, id & 31, wave, lane, tid); }
#endif
        if (BOTH(5)) GRID_BAR_NW();
    }
    if (IN(6)) { WSP();
        pg8::Gemm g{MIX, (const bf16*)(ws + WS_WOUT), M, D, D}; pg8::StaticOrder S; S.init(M, D, G, bx);
        pg8::EpiResid E{XB, XB, nullptr, SSQ2, 1.0f};
        pg8::gemm_phase<pg8::EpiResid, pg8::StaticOrder, false, PG8_SP2>(L + RING_OFF, g, S, E, wave);
        if (BOTH(6)) GRID_BAR_NW();
    }
    for (int rep = 0; rep < REPS(7); ++rep) if (IN(7)) { WSP();
        pg8::Gemm g{XB, (const bf16*)(ws + WS_W2I), M, 2 * FF, D}; pg8::StaticOrder S; S.init(M, 2 * FF, G, bx);
#ifdef PROBE_NOMMA
        g.nomma = (REPS(7) == 2 && rep == 0) ? 1 : 0;
#endif
        pg8::EpiSwiGLU E{HB, FF, SSQ2};
        pg8::gemm_phase<pg8::EpiSwiGLU, pg8::StaticOrder, PG8_ALIGN, PG8_SP2>(L + RING_OFF, g, S, E, wave);
        bool tail7 = false; int ntail7 = 0;
        { pg8::Unit u6; const int nwg = (M / 256) * (2 * FF / 256), nshort = (nwg % G) ? G - nwg % G : 0;
          if (rep == 0) { if (nshort > 0 && !S.next(nwg / G, u6)) { __syncthreads(); LANE_TID(); p0_weights<2>(in, ws, L, (bx - (G - nshort)) * NWAVES + wave, nshort * NWAVES, wave, lane); tail7 = true; }
                          else if (nshort == 0) { __syncthreads(); LANE_TID(); p0_weights<2>(in, ws, L, vcu * NWAVES + wave, G * NWAVES, wave, lane); tail7 = true; } }
          ntail7 = nshort > 0 ? nshort : G; }
        if (BOTH(7)) GRID_BAR_NW();
    }
    for (int rep = 0; rep < REPS(8); ++rep) if (IN(8)) { WSP();
        pg8::Gemm g{HB, (const bf16*)(ws + WS_W2O), M, D, FF}; pg8::StaticOrder S; S.init(M, D, G, bx);
        pg8::EpiResid E{XB, nullptr, out, nullptr, 0.5f};
        pg8::gemm_phase<pg8::EpiResid, pg8::StaticOrder, false, PG8_SP2>(L + RING_OFF, g, S, E, wave);
        if (rep + 1 < REPS(8)) GRID_BAR();
    }
#undef IN
#undef BOTH
}

extern "C" void kernel_launch(void* const* d_in, const int* in_sizes, int n_in, void* d_out, int out_size, void* d_ws, size_t ws_size, hipStream_t stream) {
    static int grid = 0;
    if (grid == 0) {
        if (n_in != 24 || in_sizes[0] != M * D || out_size != M * D || ws_size < WS_END) { fprintf(stderr, "kernel_launch: unexpected shapes (n_in %d, in0 %d, out %d, ws %zu); nothing launched\n", n_in, n_in > 0 ? in_sizes[0] : -1, out_size, ws_size); grid = -1; return; }
        int dev = 0, cus = 0, per_cu = 0;
        if (hipGetDevice(&dev) != hipSuccess || hipDeviceGetAttribute(&cus, hipDeviceAttributeMultiprocessorCount, dev) != hipSuccess) { fprintf(stderr, "kernel_launch: device query failed\n"); grid = -1; return; }
        if (hipFuncSetAttribute((const void*)hymba_fwd, hipFuncAttributeMaxDynamicSharedMemorySize, LDS_BYTES) != hipSuccess) { fprintf(stderr, "kernel_launch: hipFuncSetAttribute failed\n"); grid = -1; return; }
        if (hipOccupancyMaxActiveBlocksPerMultiprocessor(&per_cu, (const void*)hymba_fwd, NWAVES * 64, LDS_BYTES) != hipSuccess) per_cu = 0;
        (void)hipGetLastError();
        if (per_cu < 1 || cus * per_cu < 256) { fprintf(stderr, "kernel_launch: the persistent grid of 256 workgroups is not resident (cus %d, per_cu %d); nothing launched\n", cus, per_cu); grid = -1; return; }
        grid = 256;
    }
    if (grid < 0) return;
    if (hipMemsetAsync((char*)d_ws + WS_CTL, 0, CTL_ZERO_BYTES, stream) != hipSuccess) { fprintf(stderr, "kernel_launch: hipMemsetAsync failed\n"); return; }
    Args a{};
    for (int i = 0; i < 24; ++i) a.in[i] = (const float*)d_in[i];
    a.out = (float*)d_out; a.ws = (unsigned char*)d_ws;
    if (N_LAUNCHES == 1) { a.ph_lo = 0; a.ph_hi = NPHASE; hipLaunchKernelGGL(hymba_fwd, dim3(grid), dim3(NWAVES * 64), LDS_BYTES, stream, a); }
    else for (int p = 0; p < NPHASE; ++p) { a.ph_lo = p; a.ph_hi = p + 1; hipLaunchKernelGGL(hymba_fwd, dim3(grid), dim3(NWAVES * 64), LDS_BYTES, stream, a); }
    const hipError_t le = hipPeekAtLastError();
    if (le != hipSuccess) fprintf(stderr, "kernel_launch: launch failed: %s\n", hipGetErrorName(le));
}
```

```cpp
#define PG8_RSLDS true
#define PG8_RESIDLDS true
#define WT_ALL 1
#include <hip/hip_runtime.h>
#include <cstdio>
#include <cstdint>
typedef unsigned wt_v4u __attribute__((ext_vector_type(4)));
typedef float wt_f4 __attribute__((ext_vector_type(4)));
#ifdef WT_ALL
__device__ __forceinline__ void wt_st16(void* p, wt_v4u v) { asm volatile("global_store_dwordx4 %0, %1, off sc1\n\ts_nop 1" :: "v"(p), "v"(v) : "memory"); }
__device__ __forceinline__ void wt_st16f(void* p, wt_f4 v) { asm volatile("global_store_dwordx4 %0, %1, off sc1\n\ts_nop 1" :: "v"(p), "v"(v) : "memory"); }
__device__ __forceinline__ void wt_st8(void* p, unsigned long long v) { __hip_atomic_store((unsigned long long*)p, v, __ATOMIC_RELAXED, __HIP_MEMORY_SCOPE_AGENT); }
__device__ __forceinline__ void wt_st4(void* p, unsigned v) { __hip_atomic_store((unsigned*)p, v, __ATOMIC_RELAXED, __HIP_MEMORY_SCOPE_AGENT); }
__device__ __forceinline__ void wt_st4f(void* p, float v) { __hip_atomic_store((float*)p, v, __ATOMIC_RELAXED, __HIP_MEMORY_SCOPE_AGENT); }
__device__ __forceinline__ void wt_st2(void* p, unsigned v) { asm volatile("global_store_short %0, %1, off sc1" :: "v"(p), "v"(v) : "memory"); }
#else
__device__ __forceinline__ void wt_st16(void* p, wt_v4u v) { *(__attribute__((address_space(1))) wt_v4u*)p = v; }
__device__ __forceinline__ void wt_st16f(void* p, wt_f4 v) { *(__attribute__((address_space(1))) wt_f4*)p = v; }
__device__ __forceinline__ void wt_st8(void* p, unsigned long long v) { *(__attribute__((address_space(1))) unsigned long long*)p = v; }
__device__ __forceinline__ void wt_st4(void* p, unsigned v) { *(__attribute__((address_space(1))) unsigned*)p = v; }
__device__ __forceinline__ void wt_st4f(void* p, float v) { *(__attribute__((address_space(1))) float*)p = v; }
__device__ __forceinline__ void wt_st2(void* p, unsigned v) { *(__attribute__((address_space(1))) unsigned short*)p = (unsigned short)v; }
#endif
#ifndef PG8_BTILED
#define PG8_BTILED 0
#endif
#ifndef PG8_SPLITEPI
#define PG8_SPLITEPI false
#endif
namespace pg8 {
#define PG8_LAS __attribute__((address_space(3)))
typedef unsigned short bf16_t;
typedef short bf16x8 __attribute__((ext_vector_type(8)));
typedef float f32x4 __attribute__((ext_vector_type(4)));
typedef unsigned u32x4 __attribute__((ext_vector_type(4)));
constexpr int BM = 256, BK = 64, HALF = 128, HTB = HALF * BK * 2  , STAGE_BYTES = 8 * HTB, NXCD = 8, WGM = 4;

__host__ __device__ __forceinline__ int lds_byte(int r, int c) { const int st = (r >> 4) * 2 + (c >> 5), rr = r & 15, cc = c & 31, ob = rr * 64 + cc * 2; return st * 1024 + (ob ^ (((ob >> 9) & 1) << 5)); }
__host__ __device__ __forceinline__ void stage_rc(int b, int& R, int& C) { const int st = b / 1024, sb = b % 1024, swz = sb ^ (((sb >> 9) & 1) << 5); R = (st >> 1) * 16 + swz / 64; C = (st & 1) * 32 + (swz % 64) / 2; }
__host__ __device__ __forceinline__ int perm32(int rho) { const int n = rho >> 4, i = rho & 15; return 8 * (i >> 2) + 4 * n + (i & 3); }

struct Unit { int pm, pn, hm; };
struct Gemm { const bf16_t* A; const bf16_t* Bt; int M, N, K; int nomma = 0; };

struct StaticOrder {
    int nM, nN, nwg, G, c;
    __host__ __device__ void init(int M, int N, int G_, int c_) { nM = M / BM; nN = N / BM; nwg = nM * nN; G = G_; c = c_; }
    __host__ __device__ bool map(long L, Unit& u) const {
        if (L >= nwg) return false;
        int wgid = (int)L; { const int q = nwg / NXCD, r = nwg % NXCD, xcd = wgid % NXCD, off = wgid / NXCD; wgid = (xcd < r ? xcd * (q + 1) : r * (q + 1) + (xcd - r) * q) + off; }
        const int nig = WGM * nN, gid = wgid / nig, fm = gid * WGM, gsz = (nM - fm) < WGM ? (nM - fm) : WGM;
        u.pm = fm + ((wgid % nig) % gsz); u.pn = (wgid % nig) / gsz; u.hm = 0; return true;
    }
    __host__ __device__ bool next(int i, Unit& u) const { return map((long)i * G + c, u); }
    __device__ __forceinline__ void a_ready(const Unit&) const {}
    __device__ __forceinline__ void done(const Unit&) const {}
};

__device__ __forceinline__ unsigned cvt_pk_bf16(float lo, float hi) { unsigned r; asm volatile("v_cvt_pk_bf16_f32 %0, %1, %2" : "=v"(r) : "v"(lo), "v"(hi)); return r; }
typedef float f32x2 __attribute__((ext_vector_type(2)));

template <class Epi, class Sched, bool ALIGN_EPI = false, bool SP2 = false>
__device__ __forceinline__ void gemm_phase(PG8_LAS unsigned char* lds, const Gemm g, const Sched& S, const Epi& E, const int wid) {
    int lane; asm volatile("v_mbcnt_lo_u32_b32 %0, -1, 0\n\tv_mbcnt_hi_u32_b32 %0, -1, %0" : "=v"(lane));
    const int tid = wid * 64 + lane, wr = wid >> 2, wc = wid & 3, fr = lane & 15, fq = lane >> 4;
    const int K = g.K, nt = K / BK;
    static_assert(!PG8_BTILED || SP2, "the tiled weight layout is wired into the SP2 loop only");
    unsigned voffA[2], voffB[2];
#pragma unroll
    for (int i = 0; i < 2; ++i) { int R, C; stage_rc(tid * 16 + i * 8192, R, C); const int Rb = Epi::PERM ? ((R & ~31) + perm32(R & 31)) : R;
        voffA[i] = (unsigned)(R * K + C) * 2u; voffB[i] = PG8_BTILED ? (unsigned)(tid * 16 + i * 8192) : (unsigned)(Rb * K + C) * 2u; }
    const size_t kstep = (size_t)(BK * 2);
    const size_t kstepB = PG8_BTILED ? (size_t)(HALF * BK * 2) : kstep;
    const size_t hstep = (size_t)HALF * K * 2;
    const size_t tstep = 2 * hstep;
    const unsigned ldsw = (unsigned)wid * 1024u;
    const int aoff = lds_byte(wr * 64 + fr, fq * 8), boff = lds_byte(wc * 32 + fr, fq * 8);
#define PG8_SA(b, h) (((b) * 2 + (h)) * HTB)
#define PG8_SB(b, h) ((4 + (b) * 2 + (h)) * HTB)
#define PG8_STAGE(bufoff, gbase, voff) do { _Pragma("unroll") for (int _i = 0; _i < 2; ++_i) \
        __builtin_amdgcn_global_load_lds((const unsigned*)((const char*)(gbase) + (voff)[_i]), (PG8_LAS unsigned*)(lds + (bufoff) + ldsw + _i * 8192), 16, 0, 0); } while (0)
#define PG8_LDA(dst, b, h) do { _Pragma("unroll") for (int m = 0; m < 4; ++m) _Pragma("unroll") for (int k = 0; k < 2; ++k) dst[m][k] = *(const PG8_LAS bf16x8*)(lds + PG8_SA(b, h) + aoff + m * 2048 + k * 1024); } while (0)
#define PG8_LDB(dst, b, h) do { _Pragma("unroll") for (int n = 0; n < 2; ++n) _Pragma("unroll") for (int k = 0; k < 2; ++k) dst[n][k] = *(const PG8_LAS bf16x8*)(lds + PG8_SB(b, h) + boff + n * 2048 + k * 1024); } while (0)
#define PG8_MMA(ai, bj, At, Bt) do { PG8_NOMMA_GUARD __builtin_amdgcn_s_setprio(1); _Pragma("unroll") for (int m = 0; m < 4; ++m) _Pragma("unroll") for (int n = 0; n < 2; ++n) _Pragma("unroll") for (int k = 0; k < 2; ++k) \
        { acc[ai][bj][m][n] = __builtin_amdgcn_mfma_f32_16x16x32_bf16(Bt[n][k], At[m][k], acc[ai][bj][m][n], 0, 0, 0); PG8_EXTRA_MFMA(acc[ai][bj][m][n], At[m][k]); } __builtin_amdgcn_s_setprio(0); } while (0)
#ifndef PG8_DMASPLIT
#define PG8_DMASPLIT 0
#endif
#ifdef PROBE_NOMMA
#define PG8_NOMMA_GUARD if (g.nomma) break;
#else
#define PG8_NOMMA_GUARD
#endif
#ifdef PROBE_DOUBLE_MFMA
#define PG8_EXTRA_MFMA(C, A) do { bf16x8 z_ = {0,0,0,0,0,0,0,0}; asm volatile("" : "+v"(z_)); C = __builtin_amdgcn_mfma_f32_16x16x32_bf16(z_, A, C, 0, 0, 0); } while (0)
#else
#define PG8_EXTRA_MFMA(C, A) do {} while (0)
#endif
#define PG8_WAIT_V(n) asm volatile("s_waitcnt vmcnt(" #n ")" ::: "memory")
#define PG8_WAIT_L(n) asm volatile("s_waitcnt lgkmcnt(" #n ")" ::: "memory")
#define PG8_BAR __builtin_amdgcn_s_barrier()
#define PG8_SCHED __builtin_amdgcn_sched_barrier(0)
    Unit cur, nxt; int ui = 0;
    if (!S.next(0, cur)) return;
    f32x4 acc[2][2][4][2];
#pragma unroll
    for (int a = 0; a < 2; ++a)
#pragma unroll
        for (int b = 0; b < 2; ++b)
#pragma unroll
            for (int m = 0; m < 4; ++m)
#pragma unroll
                for (int n = 0; n < 2; ++n) acc[a][b][m][n] = (f32x4){0.f, 0.f, 0.f, 0.f};
    bf16x8 At[4][2], B0[2][2], B1[2][2];
    PG8_LAS float* const RSL = (PG8_LAS float*)(lds + STAGE_BYTES + 2048);
    unsigned voffR[2] = {0u, 0u};
    if constexpr (Epi::RESID_LDS) {
#pragma unroll
        for (int i = 0; i < 2; ++i) voffR[i] = (unsigned)((16 * i + (lane & 15)) * 2048 + (4 * wid + (lane >> 4)) * 16);
    }
    constexpr size_t RSB = (size_t)32 * 2048;
    const char* cA = (const char*)g.A + (size_t)cur.pm * tstep + (cur.hm == 2 ? hstep : (size_t)0); const char* cB = (const char*)g.Bt + (size_t)cur.pn * tstep;
    size_t hsC = cur.hm ? (size_t)0 : hstep;
    S.a_ready(cur);
    if constexpr (SP2) {
        PG8_STAGE(PG8_SB(0, 0), cB, voffB); PG8_STAGE(PG8_SB(0, 1), cB + hstep, voffB); PG8_STAGE(PG8_SA(0, 0), cA, voffA); PG8_STAGE(PG8_SA(0, 1), cA + hsC, voffA);
        if (wr == 1) PG8_BAR;
        PG8_WAIT_V(2); PG8_BAR;
        PG8_STAGE(PG8_SB(1, 0), cB + kstepB, voffB); PG8_STAGE(PG8_SA(1, 0), cA + kstep, voffA); PG8_STAGE(PG8_SB(1, 1), cB + hstep + kstepB, voffB);
        PG8_WAIT_V(6); PG8_BAR;
    } else {
        PG8_STAGE(PG8_SB(0, 0), cB, voffB); PG8_STAGE(PG8_SA(0, 0), cA, voffA); PG8_STAGE(PG8_SB(0, 1), cB + hstep, voffB); PG8_STAGE(PG8_SA(0, 1), cA + hstep, voffA);
        if (wr == 1) PG8_BAR;
        PG8_WAIT_V(4); PG8_BAR;
        PG8_STAGE(PG8_SB(1, 0), cB + kstep, voffB); PG8_STAGE(PG8_SA(1, 0), cA + kstep, voffA); PG8_STAGE(PG8_SB(1, 1), cB + hstep + kstep, voffB);
        PG8_WAIT_V(6); PG8_BAR;
    }
    for (;;) {
        const bool has_next = S.next(ui + 1, nxt);
        const char* nA = has_next ? (const char*)g.A + (size_t)nxt.pm * tstep + (nxt.hm == 2 ? hstep : (size_t)0) : cA; const char* nB = has_next ? (const char*)g.Bt + (size_t)nxt.pn * tstep : cB;
        const size_t hsN = has_next ? (nxt.hm ? (size_t)0 : hstep) : hsC; const bool halfu = cur.hm != 0;
        for (int t = 0; t < nt; t += 2) {
            const bool last = (t == nt - 2); f32x2 rsE;
            const char* a1 = cA + (size_t)(t + 1) * kstep;
            const char* a2 = last ? nA : cA + (size_t)(t + 2) * kstep; const char* b2 = last ? nB : cB + (size_t)(t + 2) * kstepB;
            const char* a3 = a2 + kstep; const char* b3 = b2 + kstepB;
            if (last && has_next) S.a_ready(nxt);
            bool rl = false; const char* rT = cA;
            if constexpr (Epi::RESID_LDS) { rl = last && !has_next; rT = (const char*)E.base + ((size_t)cur.pm * BM * 1024 + (size_t)cur.pn * BM) * 2; }
            const unsigned vA_[2] = {rl ? voffR[0] : voffA[0], rl ? voffR[1] : voffA[1]}, vB_[2] = {rl ? voffR[0] : voffB[0], rl ? voffR[1] : voffB[1]};
            if constexpr (SP2) {
            if constexpr (Epi::RS_LDS) { if (last) { const float* rp_ = E.ssq + ((size_t)(cur.pm * BM + (tid >> 1)) * 4 + (tid & 1) * 2); asm volatile("global_load_dwordx2 %0, %1, off" : "=v"(rsE) : "v"(rp_) : "memory"); } }
            PG8_LDB(B0, 0, 0); PG8_LDB(B1, 0, 1); PG8_SCHED; PG8_LDA(At, 0, 0); PG8_STAGE(PG8_SA(1, 1), a1 + hsC, voffA);
            PG8_WAIT_V(8); PG8_WAIT_L(0); PG8_BAR; PG8_MMA(0, 0, At, B0); PG8_MMA(0, 1, At, B1); PG8_BAR; PG8_SCHED;
#if PG8_DMASPLIT == 0
            if (!halfu) PG8_LDA(At, 0, 1); PG8_STAGE(PG8_SB(0, 0), rl ? rT + 4 * RSB : b2, vB_); PG8_STAGE(PG8_SB(0, 1), rl ? rT + 5 * RSB : b2 + hstep, vB_); PG8_STAGE(PG8_SA(0, 0), rl ? rT : a2, vA_);
            PG8_WAIT_V(8); PG8_WAIT_L(0); PG8_BAR; if (!halfu) { PG8_MMA(1, 0, At, B0); PG8_MMA(1, 1, At, B1); } PG8_BAR; PG8_SCHED;
#elif PG8_DMASPLIT == 1
            if (!halfu) PG8_LDA(At, 0, 1); PG8_STAGE(PG8_SB(0, 0), rl ? rT + 4 * RSB : b2, vB_); PG8_STAGE(PG8_SB(0, 1), rl ? rT + 5 * RSB : b2 + hstep, vB_);
            PG8_WAIT_V(6); PG8_WAIT_L(0); PG8_BAR; if (!halfu) PG8_MMA(1, 0, At, B0); PG8_SCHED; PG8_STAGE(PG8_SA(0, 0), rl ? rT : a2, vA_); PG8_SCHED; if (!halfu) PG8_MMA(1, 1, At, B1); PG8_BAR; PG8_SCHED;
#else
            if (!halfu) PG8_LDA(At, 0, 1); PG8_STAGE(PG8_SB(0, 0), rl ? rT + 4 * RSB : b2, vB_);
            PG8_WAIT_V(4); PG8_WAIT_L(0); PG8_BAR; if (!halfu) PG8_MMA(1, 0, At, B0); PG8_SCHED; PG8_STAGE(PG8_SB(0, 1), rl ? rT + 5 * RSB : b2 + hstep, vB_); PG8_STAGE(PG8_SA(0, 0), rl ? rT : a2, vA_); PG8_SCHED; if (!halfu) PG8_MMA(1, 1, At, B1); PG8_BAR; PG8_SCHED;
#endif
            if constexpr (Epi::RS_LDS) { if (last) { asm volatile("" : "+v"(rsE)); float s_ = rsE[0] + rsE[1]; s_ += __shfl_xor(s_, 1); RSL[tid >> 1] = __builtin_amdgcn_rsqf(s_ * (1.0f / 1024.0f) + 1e-6f); } }
            PG8_LDB(B0, 1, 0); PG8_LDB(B1, 1, 1); PG8_SCHED; PG8_LDA(At, 1, 0); PG8_STAGE(PG8_SA(0, 1), rl ? rT + RSB : a2 + (last ? hsN : hsC), vA_);
            PG8_WAIT_V(8); PG8_WAIT_L(0); PG8_BAR; PG8_MMA(0, 0, At, B0); PG8_MMA(0, 1, At, B1); PG8_BAR; PG8_SCHED;
#if PG8_DMASPLIT == 0
            if (!halfu) PG8_LDA(At, 1, 1); PG8_STAGE(PG8_SB(1, 0), rl ? rT + 6 * RSB : b3, vB_); PG8_STAGE(PG8_SB(1, 1), rl ? rT + 7 * RSB : b3 + hstep, vB_); PG8_STAGE(PG8_SA(1, 0), rl ? rT + 2 * RSB : a3, vA_);
            PG8_WAIT_V(8); PG8_WAIT_L(0);
            if constexpr (PG8_SPLITEPI && !Epi::AFTER_DRAIN) { if (last) { PG8_SCHED; E.template operator()<0, 1>(acc, cur, wr, wc, fr, fq, RSL); PG8_SCHED; } }
            PG8_BAR; if (!halfu) { PG8_MMA(1, 0, At, B0); PG8_MMA(1, 1, At, B1); } PG8_BAR; PG8_SCHED;
#elif PG8_DMASPLIT == 1
            if (!halfu) PG8_LDA(At, 1, 1); PG8_STAGE(PG8_SB(1, 0), rl ? rT + 6 * RSB : b3, vB_); PG8_STAGE(PG8_SB(1, 1), rl ? rT + 7 * RSB : b3 + hstep, vB_);
            PG8_WAIT_V(6); PG8_WAIT_L(0); PG8_BAR; if (!halfu) PG8_MMA(1, 0, At, B0); PG8_SCHED; PG8_STAGE(PG8_SA(1, 0), rl ? rT + 2 * RSB : a3, vA_); PG8_SCHED; if (!halfu) PG8_MMA(1, 1, At, B1); PG8_BAR; PG8_SCHED;
#else
            if (!halfu) PG8_LDA(At, 1, 1); PG8_STAGE(PG8_SB(1, 0), rl ? rT + 6 * RSB : b3, vB_);
            PG8_WAIT_V(4); PG8_WAIT_L(0); PG8_BAR; if (!halfu) PG8_MMA(1, 0, At, B0); PG8_SCHED; PG8_STAGE(PG8_SB(1, 1), rl ? rT + 7 * RSB : b3 + hstep, vB_); PG8_STAGE(PG8_SA(1, 0), rl ? rT + 2 * RSB : a3, vA_); PG8_SCHED; if (!halfu) PG8_MMA(1, 1, At, B1); PG8_BAR; PG8_SCHED;
#endif
            } else {
            PG8_LDB(B0, 0, 0); PG8_SCHED; PG8_LDA(At, 0, 0); PG8_STAGE(PG8_SA(1, 1), a1 + hstep, voffA);
            PG8_WAIT_L(8); PG8_BAR; PG8_WAIT_L(0); PG8_MMA(0, 0, At, B0); PG8_BAR; PG8_SCHED;
            PG8_LDB(B1, 0, 1); PG8_STAGE(PG8_SB(0, 0), b2, voffB);
            PG8_BAR; PG8_WAIT_L(0); PG8_MMA(0, 1, At, B1); PG8_BAR;
            PG8_LDA(At, 0, 1); PG8_STAGE(PG8_SA(0, 0), a2, voffA);
            PG8_BAR; PG8_WAIT_L(0); PG8_MMA(1, 0, At, B0); PG8_BAR; PG8_SCHED;
            PG8_STAGE(PG8_SB(0, 1), b2 + hstep, voffB);
            PG8_WAIT_V(6); PG8_BAR; PG8_MMA(1, 1, At, B1); PG8_BAR;
            PG8_LDB(B0, 1, 0); PG8_SCHED; PG8_LDA(At, 1, 0); PG8_STAGE(PG8_SA(0, 1), a2 + hstep, voffA);
            PG8_WAIT_L(8); PG8_BAR; PG8_WAIT_L(0); PG8_MMA(0, 0, At, B0); PG8_BAR; PG8_SCHED;
            PG8_LDB(B1, 1, 1); PG8_STAGE(PG8_SB(1, 0), b3, voffB);
            PG8_BAR; PG8_WAIT_L(0); PG8_MMA(0, 1, At, B1); PG8_BAR;
            PG8_LDA(At, 1, 1); PG8_STAGE(PG8_SA(1, 0), a3, voffA);
            PG8_BAR; PG8_WAIT_L(0); PG8_MMA(1, 0, At, B0); PG8_BAR; PG8_SCHED;
            PG8_STAGE(PG8_SB(1, 1), b3 + hstep, voffB);
            PG8_WAIT_V(6); PG8_BAR; PG8_MMA(1, 1, At, B1); PG8_BAR;
            }
        }
        if constexpr (ALIGN_EPI) { if (wr == 0) PG8_BAR; }
        if constexpr (!Epi::AFTER_DRAIN) { if constexpr (PG8_SPLITEPI) E.template operator()<1, 2>(acc, cur, wr, wc, fr, fq, RSL); else E(acc, cur, wr, wc, fr, fq, RSL);
#ifdef PROBE_EPI2
            asm volatile("" ::: "memory"); E(acc, cur, wr, wc, fr, fq, RSL);
#endif
            S.done(cur); }
        if (!has_next) break;
#pragma unroll
        for (int a = 0; a < 2; ++a)
#pragma unroll
            for (int b = 0; b < 2; ++b)
#pragma unroll
                for (int m = 0; m < 4; ++m)
#pragma unroll
                    for (int n = 0; n < 2; ++n) acc[a][b][m][n] = (f32x4){0.f, 0.f, 0.f, 0.f};
        cur = nxt; cA = nA; cB = nB; hsC = hsN; ++ui;
        if constexpr (ALIGN_EPI) { if (wr == 1) PG8_BAR; }
    }
    PG8_WAIT_V(0);
    if constexpr (!ALIGN_EPI) { if (wr == 0) PG8_BAR; }
    PG8_BAR;
    if constexpr (Epi::AFTER_DRAIN) { E.fused(acc, cur, wr, wc, fr, fq, lds, wid, lane); S.done(cur); }
#undef PG8_SA
#undef PG8_SB
#undef PG8_STAGE
#undef PG8_LDA
#undef PG8_LDB
#undef PG8_MMA
#undef PG8_WAIT_V
#undef PG8_WAIT_L
#undef PG8_BAR
#undef PG8_SCHED
}
}
namespace pg8 {
#ifndef PG8_RSLDS
#define PG8_RSLDS false
#endif
#ifndef PG8_RESIDLDS
#define PG8_RESIDLDS false
#endif
constexpr float NORM_EPS_F = 1e-6f;
__device__ __forceinline__ float row_rs(const float* ssq4, int row) {
    const f32x4 s = *(const __attribute__((address_space(1))) f32x4*)(ssq4 + (size_t)row * 4);
    return __builtin_amdgcn_rsqf(((s[0] + s[1]) + (s[2] + s[3])) * (1.0f / 1024.0f) + NORM_EPS_F);
}
__device__ __forceinline__ float silu_mul(float a, float b) { return a * __builtin_amdgcn_rcpf(1.0f + __expf(-a)) * b; }
struct TailHalfOrder : StaticOrder {
    __host__ __device__ bool next(int i, Unit& u) const {
        const int rem = nwg % G, nfull = nwg / G;
        if (rem == 0 || 2 * rem != G || (G % 16) != 0 || (nwg % NXCD) != 0) return StaticOrder::next(i, u);
        if (i < nfull) return StaticOrder::next(i, u);
        if (i > nfull) return false;
        const int x = c % NXCD, q = c / NXCD;
        if (!map((long)nfull * G + x + NXCD * (q >> 1), u)) return false;
        u.hm = 1 + (q & 1); return true;
    }
};
struct EpiSwiGLU {
    static constexpr bool PERM = true, AFTER_DRAIN = false, RS_LDS = PG8_RSLDS, RESID_LDS = false;
    bf16_t* H; int ldh; const float* ssq;
    static __device__ __forceinline__ f32x4 swiglu4(f32x4 a, f32x4 b, float rs) {
        const f32x4 t = a * rs, u = t * (-1.4426950408889634f);
        f32x4 e; e[0] = __builtin_amdgcn_exp2f(u[0]); e[1] = __builtin_amdgcn_exp2f(u[1]); e[2] = __builtin_amdgcn_exp2f(u[2]); e[3] = __builtin_amdgcn_exp2f(u[3]);
        const f32x4 d = e + 1.0f;
        f32x4 s; s[0] = __builtin_amdgcn_rcpf(d[0]); s[1] = __builtin_amdgcn_rcpf(d[1]); s[2] = __builtin_amdgcn_rcpf(d[2]); s[3] = __builtin_amdgcn_rcpf(d[3]);
        return (t * s) * (b * rs);
    }
    template <int AI_LO = 0, int AI_HI = 2>
    __device__ __forceinline__ void operator()(const f32x4 (&acc)[2][2][4][2], const Unit& u, int wr, int wc, int fr, int fq, const PG8_LAS float* rsl) const {
        const int row0 = u.pm * BM + wr * 64 + fr + (u.hm == 2 ? HALF : 0), col0 = u.pn * HALF + wc * 32 + 8 * fq;
        float rsv[2][4];
#pragma unroll
        for (int ai = AI_LO; ai < AI_HI; ++ai)
#pragma unroll
            for (int m = 0; m < 4; ++m) rsv[ai][m] = RS_LDS ? rsl[wr * 64 + fr + ai * HALF + m * 16] : row_rs(ssq, row0 + ai * HALF + m * 16);
#pragma unroll
        for (int ai = AI_LO; ai < AI_HI; ++ai) if (ai == 0 || u.hm == 0)
#pragma unroll
            for (int m = 0; m < 4; ++m) { const int row = row0 + ai * HALF + m * 16; const float rs = rsv[ai][m];
                const f32x4 h0 = swiglu4(acc[ai][0][m][0], acc[ai][1][m][0], rs), h1 = swiglu4(acc[ai][0][m][1], acc[ai][1][m][1], rs);
                u32x4 w; w.x = cvt_pk_bf16(h0[0], h0[1]); w.y = cvt_pk_bf16(h0[2], h0[3]); w.z = cvt_pk_bf16(h1[0], h1[1]); w.w = cvt_pk_bf16(h1[2], h1[3]);
                wt_st16(H + (size_t)row * ldh + col0, w); }
    }
};
__device__ __forceinline__ float bflo_(unsigned w) { return __uint_as_float(w << 16); }
__device__ __forceinline__ float bfhi_(unsigned w) { return __uint_as_float(w & 0xffff0000u); }
struct EpiResid {
    static constexpr bool PERM = true, AFTER_DRAIN = true, RS_LDS = false, RESID_LDS = PG8_RESIDLDS;
    const bf16_t* base; bf16_t* ob; float* outf; float* ssq_out; float alpha;
    __device__ __forceinline__ void fused(f32x4 (&acc)[2][2][4][2], const Unit& u, int wr, int wc, int fr, int fq, PG8_LAS unsigned char* lds, int wid, int lane) const {
        PG8_LAS float* P = (PG8_LAS float*)(lds + (RESID_LDS ? STAGE_BYTES + 4096 : 0));
        const int col0 = u.pn * BM + wc * 32 + 8 * fq;
        u32x4 bw[2][4][2];
        if constexpr (RESID_LDS) {
            if (wr == 1) {
#pragma unroll
                for (int m = 2; m < 4; ++m) { const size_t off = (size_t)(u.pm * BM + wr * 64 + m * 16 + fr) * 1024 + col0;
#pragma unroll
                    for (int bj = 0; bj < 2; ++bj) bw[0][m][bj] = *(const __attribute__((address_space(1))) u32x4*)(base + off + bj * HALF); } }
#pragma unroll
            for (int ai = 0; ai < 2; ++ai)
#pragma unroll
                for (int m = 0; m < 4; ++m) { const int s = ai * 4 + wr * 2 + (m >> 1);
                    if (!(ai == 0 && m >= 2 && wr == 1)) {
#pragma unroll
                        for (int bj = 0; bj < 2; ++bj) bw[ai][m][bj] = *(const PG8_LAS u32x4*)(lds + s * 16384 + (m & 1) * 8192 + (bj * 4 + wc) * 1024 + lane * 16); } }
        } else {
#pragma unroll
        for (int ai = 0; ai < 2; ++ai)
#pragma unroll
            for (int m = 0; m < 4; ++m) { const size_t off = (size_t)(u.pm * BM + ai * HALF + wr * 64 + m * 16 + fr) * 1024 + col0;
#pragma unroll
                for (int bj = 0; bj < 2; ++bj) bw[ai][m][bj] = *(const __attribute__((address_space(1))) u32x4*)(base + off + bj * HALF); }
        }
#pragma unroll
        for (int ai = 0; ai < 2; ++ai)
#pragma unroll
            for (int m = 0; m < 4; ++m) { const int r = ai * HALF + wr * 64 + m * 16 + fr; const size_t off = (size_t)(u.pm * BM + r) * 1024 + col0; float q = 0.f;
#pragma unroll
                for (int bj = 0; bj < 2; ++bj) { const u32x4 w = bw[ai][m][bj];
                    const f32x4 b0 = (f32x4){bflo_(w.x), bfhi_(w.x), bflo_(w.y), bfhi_(w.y)}, b1 = (f32x4){bflo_(w.z), bfhi_(w.z), bflo_(w.w), bfhi_(w.w)};
                    const f32x4 o0 = b0 + acc[ai][bj][m][0] * alpha, o1 = b1 + acc[ai][bj][m][1] * alpha;
                    q += ((o0[0] * o0[0] + o0[1] * o0[1]) + (o0[2] * o0[2] + o0[3] * o0[3])) + ((o1[0] * o1[0] + o1[1] * o1[1]) + (o1[2] * o1[2] + o1[3] * o1[3]));
                    if (ob) { u32x4 v; v.x = cvt_pk_bf16(o0[0], o0[1]); v.y = cvt_pk_bf16(o0[2], o0[3]); v.z = cvt_pk_bf16(o1[0], o1[1]); v.w = cvt_pk_bf16(o1[2], o1[3]); wt_st16(ob + off + bj * HALF, v); }
                    if (outf) { *(__attribute__((address_space(1))) f32x4*)(outf + off + bj * HALF) = o0; *(__attribute__((address_space(1))) f32x4*)(outf + off + bj * HALF + 4) = o1; } }
                q += __shfl_xor(q, 16); q += __shfl_xor(q, 32);
                if (fq == 0) P[r * 4 + wc] = q; }
        asm volatile("s_waitcnt lgkmcnt(0)" ::: "memory"); __builtin_amdgcn_s_barrier(); asm volatile("" ::: "memory");
        if (ssq_out) { const int t = wid * 64 + lane; if (t < 256) { const PG8_LAS f32x4* P4 = (const PG8_LAS f32x4*)P; const f32x4 p = P4[t]; wt_st4f(ssq_out + (size_t)(u.pm * BM + t) * 4 + u.pn, (p[0] + p[1]) + (p[2] + p[3])); } }
    }
};
struct EpiWin {
    static constexpr bool PERM = true, AFTER_DRAIN = false, RS_LDS = PG8_RSLDS, RESID_LDS = false;
    bf16_t* U; const float* ssq; const float* gains;
    template <int AI_LO = 0, int AI_HI = 2>
    __device__ __forceinline__ void operator()(const f32x4 (&acc)[2][2][4][2], const Unit& u, int wr, int wc, int fr, int fq, const PG8_LAS float* rsl) const {
        const int row0 = u.pm * BM + wr * 64 + fr, colL = u.pn * BM + wc * 64 + 8 * fq;
        const bool nrm = (u.pn == 4) || (u.pn == 5) || (u.pn == 7);
        const float* g = gains + ((u.pn == 4) ? 0 : (u.pn == 5) ? 64 : 128);
        f32x4 gv[2][2];
#pragma unroll
        for (int bj = 0; bj < 2; ++bj)
#pragma unroll
            for (int n = 0; n < 2; ++n) gv[bj][n] = nrm ? *(const __attribute__((address_space(1))) f32x4*)(g + 32 * bj + 8 * fq + 4 * n) : (f32x4){1.f, 1.f, 1.f, 1.f};
        float rsv[2][4];
#pragma unroll
        for (int ai = AI_LO; ai < AI_HI; ++ai)
#pragma unroll
            for (int m = 0; m < 4; ++m) rsv[ai][m] = RS_LDS ? rsl[wr * 64 + fr + ai * HALF + m * 16] : row_rs(ssq, row0 + ai * HALF + m * 16);
#pragma unroll
        for (int ai = AI_LO; ai < AI_HI; ++ai)
#pragma unroll
            for (int m = 0; m < 4; ++m) { const int row = row0 + ai * HALF + m * 16; const float rs = rsv[ai][m];
                f32x4 v[2][2]; float ss = 0.f;
#pragma unroll
                for (int bj = 0; bj < 2; ++bj)
#pragma unroll
                    for (int n = 0; n < 2; ++n) { v[bj][n] = acc[ai][bj][m][n] * rs; ss += (v[bj][n][0] * v[bj][n][0] + v[bj][n][1] * v[bj][n][1]) + (v[bj][n][2] * v[bj][n][2] + v[bj][n][3] * v[bj][n][3]); }
                ss += __shfl_xor(ss, 16); ss += __shfl_xor(ss, 32);
                const float rn = nrm ? __builtin_amdgcn_rsqf(ss * (1.0f / 64.0f) + NORM_EPS_F) * ((u.pn == 5) ? 1.0f : 0.18033688011112042f) : 1.0f;
#pragma unroll
                for (int bj = 0; bj < 2; ++bj) { const f32x4 x0 = v[bj][0] * rn * gv[bj][0], x1 = v[bj][1] * rn * gv[bj][1];
                    u32x4 w; w.x = cvt_pk_bf16(x0[0], x0[1]); w.y = cvt_pk_bf16(x0[2], x0[3]); w.z = cvt_pk_bf16(x1[0], x1[1]); w.w = cvt_pk_bf16(x1[2], x1[3]);
                    wt_st16(U + (size_t)row * 2048 + colL + 32 * bj, w); } }
    }
};
}
#ifndef PG8_SP2
#define PG8_SP2 true
#endif
#ifndef PG8_ALIGN
#define PG8_ALIGN true
#endif
#ifndef MK_N_LAUNCHES
#define MK_N_LAUNCHES 1
#endif
constexpr int NWAVES = 8;
constexpr int NPHASE = 9;
constexpr int N_LAUNCHES = MK_N_LAUNCHES;

constexpr int BATCH = 2, SEQ = 8192, D = 1024, FF = 2816, M = BATCH * SEQ;
constexpr int MEMLEN = 256, HD = 64, LRUW = 512, INW = 2048, NBLK = SEQ / 256;
constexpr float EPS = 1e-6f;

constexpr size_t MiB = 1u << 20;
constexpr size_t WS_CTL = 0, CTL_ZERO_BYTES = 64 * 1024;
constexpr size_t WS_SSQ0 = 1 * MiB, WS_SSQ1 = WS_SSQ0 + 256 * 1024, WS_SSQ2 = WS_SSQ1 + 256 * 1024;
constexpr size_t WS_KMEAN = 2 * MiB;
constexpr size_t WS_AGGA = WS_KMEAN + 64 * 1024;
constexpr size_t WS_AGGH = WS_AGGA + 128 * 1024;
constexpr size_t WS_GAINS = WS_AGGH + 128 * 1024;
constexpr size_t WS_PTAB = WS_GAINS + 4096;
constexpr size_t WS_MEMB = 3 * MiB;
constexpr size_t WS_MEMKF = 4 * MiB, WS_MEMVF = WS_MEMKF + 256 * 1024;
constexpr size_t WS_GR = 5 * MiB;
constexpr size_t WS_W1I = 8 * MiB, WS_W1O = 19 * MiB, WS_WIN = 25 * MiB, WS_WOUT = 29 * MiB, WS_WMKV = 31 * MiB, WS_W2I = 32 * MiB, WS_W2O = 43 * MiB;
constexpr size_t WS_WG = 49 * MiB;
constexpr size_t WS_XB = 50 * MiB;
constexpr size_t WS_MIX = 82 * MiB;
constexpr size_t WS_H = 114 * MiB;
constexpr size_t WS_U = WS_H;
constexpr size_t WS_KF = 202 * MiB, WS_VF = 210 * MiB;
constexpr size_t WS_PART2 = 218 * MiB;
constexpr size_t WS_END = 256 * MiB;
static_assert(WS_H + (size_t)M * FF * 2 <= WS_END, "d_ws map");
constexpr int CW_BAR = 1024;

constexpr int RING_OFF = 0, RING_BYTES = 131072;
constexpr int LDSCTL_OFF = RING_BYTES, MISC_OFF = LDSCTL_OFF + 320;
constexpr int LDS_BYTES = 163840;

#define GAS __attribute__((address_space(1)))
#define LAS __attribute__((address_space(3)))
typedef unsigned short bf16;
typedef unsigned v4u __attribute__((ext_vector_type(4)));
typedef float f32x4 __attribute__((ext_vector_type(4)));
typedef short bf16x8 __attribute__((ext_vector_type(8)));
typedef GAS unsigned gu32;
typedef GAS unsigned long long gu64;
#define RLX_AGENT __ATOMIC_RELAXED, __HIP_MEMORY_SCOPE_AGENT
#define LDS_WAIT() asm volatile("s_waitcnt lgkmcnt(0)" ::: "memory")
#define VM_WAIT() asm volatile("s_waitcnt vmcnt(0)" ::: "memory")
__device__ __forceinline__ unsigned long long rt() { return __builtin_amdgcn_s_memrealtime(); }
__device__ __forceinline__ unsigned f2bf(float f) { unsigned u = __builtin_bit_cast(unsigned, f); return (u + 0x7fffu + ((u >> 16) & 1u)) >> 16; }
__device__ __forceinline__ unsigned pk2(float lo, float hi) { return f2bf(lo) | (f2bf(hi) << 16); }

#define XB_TMO      128
#define XB_XCNT(j)  (256  + 64 * (j))
#define XB_XSUB(j)  (1280 + 64 * (j))
#define XB_XGEN(j)  (2304 + 64 * (j))
#define XB_TOP      3328
#define XB_TOPGEN   3392
#define XCD_BAR_WORDS 3456
#define XB_SPIN_CAP (1u << 18)

__device__ __forceinline__ unsigned xb_ld(unsigned* p)              { return __hip_atomic_load(p, __ATOMIC_RELAXED, __HIP_MEMORY_SCOPE_AGENT); }
__device__ __forceinline__ unsigned xb_add(unsigned* p, unsigned v) { return __hip_atomic_fetch_add(p, v, __ATOMIC_RELAXED, __HIP_MEMORY_SCOPE_AGENT); }
__device__ __forceinline__ unsigned xb_xcc_id() { return (unsigned)__builtin_amdgcn_s_getreg((3 << 11) | 20) & 0xFu; }
#define XB_SPIN(cond, bar) do { unsigned _sp = 0; while (cond) { __builtin_amdgcn_s_sleep(1); \
    if ((++_sp & 255u) == 0u) { if (xb_ld(&(bar)[XB_TMO])) break; if (_sp > XB_SPIN_CAP) { atomicAdd(&(bar)[XB_TMO], 1u); break; } } } } while (0)

struct XcdBarrier {
    unsigned* bar; unsigned x;
    volatile LAS unsigned* st;
    int wave;
};
__device__ __forceinline__ bool xb_thread0(int wave) { int ln; asm volatile("v_mbcnt_lo_u32_b32 %0, -1, 0\n\tv_mbcnt_hi_u32_b32 %0, -1, %0" : "=v"(ln)); return wave == 0 && ln == 0; }

__device__ __forceinline__ XcdBarrier xcd_barrier_post(unsigned* bar, volatile LAS unsigned* st, int wave) {
    XcdBarrier b; b.bar = bar; b.x = xb_xcc_id(); b.st = st; b.wave = wave;
    if (xb_thread0(wave)) (void)xb_add(&bar[XB_XCNT(b.x)], 1u);
    return b;
}
__device__ __forceinline__ void xcd_barrier_complete(unsigned* bar, unsigned x, unsigned& nloc, unsigned& nx) {
    const unsigned G = gridDim.x * gridDim.y * gridDim.z;
    unsigned sum, cnt, mine, sp = 0u;
    for (;;) {
        sum = 0u; cnt = 0u; mine = 0u;
#pragma unroll
        for (unsigned j = 0; j < 16; ++j) { const unsigned c = xb_ld(&bar[XB_XCNT(j)]); sum += c; cnt += (c > 0u) ? 1u : 0u; mine = (j == x) ? c : mine; }
        if (sum == G) break;
        __builtin_amdgcn_s_sleep(1);
        if ((++sp & 255u) == 0u) { if (xb_ld(&bar[XB_TMO])) break; if (sp > XB_SPIN_CAP) { atomicAdd(&bar[XB_TMO], 1u); break; } }
    }
    nloc = mine > 0u ? mine : 1u; nx = cnt > 0u ? cnt : 1u;
}

__device__ __forceinline__ void xcd_barrier(const XcdBarrier& b, const bool writeback = true) {
    asm volatile("s_waitcnt vmcnt(0)" ::: "memory");
    __syncthreads();
    if (xb_thread0(b.wave)) {
        unsigned* bar = b.bar;
        __builtin_amdgcn_s_waitcnt(0);
        unsigned nloc = b.st[0], nx = b.st[1];
        if (nloc == 0u) { xcd_barrier_complete(bar, b.x, nloc, nx); b.st[0] = nloc; b.st[1] = nx; }
        const unsigned old = xb_add(&bar[XB_XSUB(b.x)], 1u);
        const unsigned gen = old / nloc;
        if (old + 1u == (gen + 1u) * nloc) {
            if (writeback) __builtin_amdgcn_fence(__ATOMIC_RELEASE, "agent");
            asm volatile("s_waitcnt vmcnt(0)" ::: "memory");
            const unsigned og = xb_add(&bar[XB_TOP], 1u);
            const unsigned tg = og / nx;
#ifdef XB_EARLY_INV
            __builtin_amdgcn_fence(__ATOMIC_ACQUIRE, "agent");
            if (og + 1u == (tg + 1u) * nx) xb_add(&bar[XB_TOPGEN], 1u);
            else XB_SPIN(xb_ld(&bar[XB_TOPGEN]) == tg, bar);
#else
            if (og + 1u == (tg + 1u) * nx) xb_add(&bar[XB_TOPGEN], 1u);
            else XB_SPIN(xb_ld(&bar[XB_TOPGEN]) == tg, bar);
            __builtin_amdgcn_fence(__ATOMIC_ACQUIRE, "agent");
#endif
#ifndef XB_DIRECT
            xb_add(&bar[XB_XGEN(b.x)], 1u);
#endif
            asm volatile("s_waitcnt vmcnt(0)" ::: "memory");
        } else {
#ifdef XB_EARLY_INV
            __builtin_amdgcn_fence(__ATOMIC_ACQUIRE, "agent");
            XB_SPIN(xb_ld(&bar[XB_XGEN(b.x)]) == gen, bar);
#elif defined(XB_DIRECT)
            XB_SPIN(xb_ld(&bar[XB_TOPGEN]) == gen, bar);
            __builtin_amdgcn_fence(__ATOMIC_ACQUIRE, "agent");
#else
            XB_SPIN(xb_ld(&bar[XB_XGEN(b.x)]) == gen, bar);
            __builtin_amdgcn_fence(__ATOMIC_ACQUIRE, "agent");
#endif
            asm volatile("s_waitcnt vmcnt(0)" ::: "memory");
        }
    }
    __syncthreads();
}

#define LB_CNT(l)  (8192 + 64 * (l))
#define LB_EV(e)   (8192 + 64 * (8 + (e)))
__device__ __forceinline__ void label_barrier(unsigned* ctl, unsigned* bar, int label, unsigned members, int wave, bool ev_sig, unsigned* ev, unsigned ev_need) {
    asm volatile("s_waitcnt vmcnt(0)" ::: "memory");
    __syncthreads();
    if (xb_thread0(wave)) {
        __builtin_amdgcn_s_waitcnt(0);
        unsigned* cnt = ctl + LB_CNT(label);
        __builtin_amdgcn_fence(__ATOMIC_RELEASE, "agent");
        asm volatile("s_waitcnt vmcnt(0)" ::: "memory");
        if (ev_sig) (void)xb_add(ev, 1u);
        const unsigned old = xb_add(cnt, 1u);
        const unsigned target = (old / members + 1u) * members;
        XB_SPIN(xb_ld(cnt) < target, bar);
        if (ev_need) XB_SPIN(xb_ld(ev) < ev_need, bar);
        __builtin_amdgcn_fence(__ATOMIC_ACQUIRE, "agent");
        asm volatile("s_waitcnt vmcnt(0)" ::: "memory");
    }
    __syncthreads();
}
__device__ __forceinline__ float bf2f(unsigned short h) { return __uint_as_float((unsigned)h << 16); }
__device__ __forceinline__ float bflo(unsigned w) { return __uint_as_float(w << 16); }
__device__ __forceinline__ float bfhi(unsigned w) { return __uint_as_float(w & 0xffff0000u); }
__device__ __forceinline__ float wave_sum(float v) {
#pragma unroll
    for (int o = 1; o < 64; o <<= 1) v += __shfl_xor(v, o);
    return v;
}
__device__ __forceinline__ float wave_max(float v) {
#pragma unroll
    for (int o = 1; o < 64; o <<= 1) v = fmaxf(v, __shfl_xor(v, o));
    return v;
}
__device__ __forceinline__ float sigmoidf_(float x) { return 1.0f / (1.0f + __expf(-x)); }
__device__ __forceinline__ float gelu_tanh(float x) { const float u = x * __builtin_fmaf(x * x, 0.10294324f, 2.3022082f); return x * __builtin_amdgcn_rcpf(1.0f + __builtin_amdgcn_exp2f(-u)); }
template <int CTRL, int ROWMASK> __device__ __forceinline__ float dppf(float old, float src) { return __builtin_bit_cast(float, __builtin_amdgcn_update_dpp(__builtin_bit_cast(int, old), __builtin_bit_cast(int, src), CTRL, ROWMASK, 0xF, false)); }

__device__ __forceinline__ int kperm16(int o) { return 8 * ((o >> 2) & 1) + 4 * (o >> 3) + (o & 3); }
__device__ __forceinline__ void p0_transpose_item(const float* W, int K, int N, const float* gain, bf16* WT, int dest_row0, LAS float* scr, int k0, int n0, int lane) {
#pragma unroll
    for (int i = 0; i < 32; ++i) { const int kk = 2 * i + (lane >> 5); const float g = gain ? gain[k0 + kk] : 1.0f; scr[kk * 33 + (lane & 31)] = W[(size_t)(k0 + kk) * N + n0 + (lane & 31)] * g; }
    LDS_WAIT(); asm volatile("" ::: "memory");
    const int c = lane & 7;
#pragma unroll
    for (int j = 0; j < 4; ++j) { const int n = (lane >> 3) + 8 * j; const LAS float* s = scr + (8 * c) * 33 + n;
        v4u o; o.x = pk2(s[0 * 33], s[1 * 33]); o.y = pk2(s[2 * 33], s[3 * 33]); o.z = pk2(s[4 * 33], s[5 * 33]); o.w = pk2(s[6 * 33], s[7 * 33]);
        *(GAS v4u*)(WT + (size_t)(dest_row0 + n) * K + k0 + 8 * c) = o; }
    LDS_WAIT(); asm volatile("" ::: "memory");
}
__device__ __forceinline__ int map_swiglu(int n0) { return n0 < FF ? 256 * (n0 / 128) + (n0 % 128) : 256 * ((n0 - FF) / 128) + 128 + ((n0 - FF) % 128); }
__device__ __forceinline__ int map_heads(int n0) { const int rem = n0 % 256; return 256 * (n0 / 256) + 128 * ((rem / 32) & 1) + 32 * (rem / 64); }
__device__ __forceinline__ void row_to_bf16(const float* xrow, bf16* orow, float* ssq4, bool scale, int lane) {
    const GAS f32x4* xr = (const GAS f32x4*)xrow + lane;
    f32x4 v[4]; float s = 0.f;
#pragma unroll
    for (int j = 0; j < 4; ++j) { v[j] = xr[64 * j]; s += (v[j].x * v[j].x + v[j].y * v[j].y) + (v[j].z * v[j].z + v[j].w * v[j].w); }
    s = wave_sum(s);
    const float rs = scale ? __builtin_amdgcn_rsqf(s * (1.0f / 1024.0f) + EPS) : 1.0f;
    GAS unsigned long long* o8 = (GAS unsigned long long*)orow + lane;
#pragma unroll
    for (int j = 0; j < 4; ++j) wt_st8((void*)(o8 + 64 * j), (unsigned long long)pk2(v[j].x * rs, v[j].y * rs) | ((unsigned long long)pk2(v[j].z * rs, v[j].w * rs) << 32));
    if (ssq4 && lane == 0) { wt_st16f(ssq4, (f32x4){s, 0.f, 0.f, 0.f}); }
}
struct P0Item { const float* src; const float* gain; bf16* dst; int K, N; float useg; int grp; };
template <int SET>
__device__ __forceinline__ bool p0_decode(const float* const* in, unsigned char* ws, int it, P0Item& d) {
    constexpr int I_FI = (D / 64) * (2 * FF / 32), I_FO = (FF / 64) * (D / 32), I_WI = (D / 64) * (INW / 32), I_WO = (D / 64) * (D / 32), I_MK = (D / 64) * (512 / 32);
    constexpr int NITEMS = SET == 0 ? 2 * I_FI + I_MK : SET == 1 ? I_FO + I_WO + I_WI : I_FO;
    if (it >= NITEMS) return false;
    int r = it; const float* W; const float* gain; bf16* WT; int K, N, map;
    if (SET == 0) {
        if (r < I_FI) { W = in[3]; K = D; N = 2 * FF; gain = in[2]; WT = (bf16*)(ws + WS_W1I); map = 1; }
        else if ((r -= I_FI) < I_MK) { W = in[17]; K = D; N = 512; gain = in[6]; WT = (bf16*)(ws + WS_WMKV); map = 0; }
        else { r -= I_MK; W = in[22]; K = D; N = 2 * FF; gain = in[21]; WT = (bf16*)(ws + WS_W2I); map = 1; }
    } else if (SET == 1) {
        if (r < I_FO) { W = in[4]; K = FF; N = D; gain = nullptr; WT = (bf16*)(ws + WS_W1O); map = 0; }
        else if ((r -= I_FO) < I_WI) { W = in[7]; K = D; N = INW; gain = in[5]; WT = (bf16*)(ws + WS_WIN); map = 2; }
        else { r -= I_WI; W = in[20]; K = D; N = D; gain = nullptr; WT = (bf16*)(ws + WS_WOUT); map = 0; }
    } else { W = in[23]; K = FF; N = D; gain = nullptr; WT = (bf16*)(ws + WS_W2O); map = 0; }
    const int nblk = N / 32, kb = r / nblk, nb = r % nblk, k0 = 64 * kb, n0 = 32 * nb;
    const int dr = map == 1 ? map_swiglu(n0) : map == 2 ? map_heads(n0) : n0;
    d.src = W + (size_t)k0 * N + n0; d.gain = gain ? gain + k0 : W; d.useg = gain ? 1.0f : 0.0f; d.K = K; d.N = N;
#if PG8_BTILED
    if (WT != (bf16*)(ws + WS_WMKV)) { d.dst = WT + ((size_t)(dr >> 7) * (K >> 6) + (k0 >> 6)) * 8192; d.grp = dr & 96; return true; }
#endif
    d.dst = WT + (size_t)dr * K + k0; d.grp = -1; return true;
}
__device__ __forceinline__ void p0_item_load(const P0Item& d, f32x4 (&v)[8], float (&gv)[8], int lane) {
#pragma unroll
    for (int i = 0; i < 8; ++i) { v[i] = *(const GAS f32x4*)(d.src + (size_t)((lane >> 3) + 8 * i) * d.N + 4 * (lane & 7)); gv[i] = *(const GAS float*)(d.gain + (lane >> 3) + 8 * i); }
}
__device__ __forceinline__ void p0_item_finish(const P0Item& d, const f32x4 (&v)[8], const float (&gv)[8], LAS float* scr, int lane) {
#pragma unroll
    for (int i = 0; i < 8; ++i) { const int kk = (lane >> 3) + 8 * i; const float g = d.useg != 0.0f ? gv[i] : 1.0f; LAS float* s = scr + kk * 33 + 4 * (lane & 7);
        s[0] = v[i].x * g; s[1] = v[i].y * g; s[2] = v[i].z * g; s[3] = v[i].w * g; }
    LDS_WAIT(); asm volatile("" ::: "memory");
    const int c = lane & 7;
#pragma unroll
    for (int j = 0; j < 4; ++j) { const int n = (lane >> 3) + 8 * j; const LAS float* s = scr + (8 * c) * 33 + n;
        v4u o; o.x = pk2(s[0 * 33], s[1 * 33]); o.y = pk2(s[2 * 33], s[3 * 33]); o.z = pk2(s[4 * 33], s[5 * 33]); o.w = pk2(s[6 * 33], s[7 * 33]);
        const size_t eo = d.grp >= 0 ? (size_t)(pg8::lds_byte(d.grp + 16 * ((n >> 2) & 1) + 4 * (n >> 3) + (n & 3), 8 * c) >> 1) : (size_t)n * d.K + 8 * c;
        wt_st16(d.dst + eo, o); }
    LDS_WAIT(); asm volatile("" ::: "memory");
}
template <int SET>
__device__ __forceinline__ void p0_weights(const float* const* in, unsigned char* ws, LAS unsigned char* lds, int widx, int nw, int wave, int lane) {
    LAS float* scr = (LAS float*)(lds + RING_OFF + wave * 16384);
    P0Item d0, d1; f32x4 v0[8], v1[8]; float g0[8], g1[8];
    int it = widx; bool have = p0_decode<SET>(in, ws, it, d0);
    if (have) p0_item_load(d0, v0, g0, lane);
    while (have) {
        const bool have1 = p0_decode<SET>(in, ws, it + nw, d1);
        if (!have1) d1 = d0;
        p0_item_load(d1, v1, g1, lane);
        p0_item_finish(d0, v0, g0, scr, lane);
        it += nw; have = have1; d0 = d1;
#pragma unroll
        for (int i = 0; i < 8; ++i) { v0[i] = v1[i]; g0[i] = g1[i]; }
    }
}
struct P0Mat { const float* W; int K, N; const float* gain; bf16* WT; int map; };
__device__ __forceinline__ void p0_prologue(const float* const* in, unsigned char* ws, LAS unsigned char* lds, int vcu, int G, int wave, int lane) {
    LAS float* scr = (LAS float*)(lds + RING_OFF + wave * 16384);
    const int gw = vcu * NWAVES + wave, NGW = G * NWAVES;
    for (int m = gw; m < M; m += 4 * NGW) {
        f32x4 v[4][4];
#pragma unroll
        for (int r = 0; r < 4; ++r) { const GAS f32x4* xr = (const GAS f32x4*)(in[0] + (size_t)(m + r * NGW) * D) + 2 * lane;
            v[r][0] = xr[0]; v[r][1] = xr[1]; v[r][2] = xr[128]; v[r][3] = xr[129]; }
#pragma unroll
        for (int r = 0; r < 4; ++r) { float sa = 0.f;
#pragma unroll
            for (int j = 0; j < 4; ++j) sa += (v[r][j].x * v[r][j].x + v[r][j].y * v[r][j].y) + (v[r][j].z * v[r][j].z + v[r][j].w * v[r][j].w);
            sa = wave_sum(sa);
            GAS v4u* o16 = (GAS v4u*)((bf16*)(ws + WS_XB) + (size_t)(m + r * NGW) * D) + lane;
            wt_st16((void*)(o16), (v4u){pk2(v[r][0].x, v[r][0].y), pk2(v[r][0].z, v[r][0].w), pk2(v[r][1].x, v[r][1].y), pk2(v[r][1].z, v[r][1].w)});
            wt_st16((void*)(o16 + 64), (v4u){pk2(v[r][2].x, v[r][2].y), pk2(v[r][2].z, v[r][2].w), pk2(v[r][3].x, v[r][3].y), pk2(v[r][3].z, v[r][3].w)});
            if (lane == 0) wt_st16f((float*)(ws + WS_SSQ0) + (size_t)(m + r * NGW) * 4, (f32x4){sa, 0.f, 0.f, 0.f}); }
    }
    for (int m = gw; m < BATCH * MEMLEN; m += NGW) row_to_bf16(in[1] + (size_t)m * D, (bf16*)(ws + WS_MEMB) + (size_t)m * D, nullptr, true, lane);
    for (int f = gw * 64 + lane; f < 8 * 2 * 2 * 4 * 64; f += NGW * 64) {
        const int ln = f & 63, ks = (f >> 6) & 3, blk = (f >> 8) & 1, gate = (f >> 9) & 1, n = f >> 10, r = ln & 31, h = ln >> 5;
        const float* Wg = (gate ? in[12] : in[10]) + (size_t)n * 4096 + 32 * blk + r; float v[8];
#pragma unroll
        for (int j = 0; j < 8; ++j) v[j] = 1.4426950408889634f * Wg[(8 * (2 * ks + (j >> 2)) + 4 * h + (j & 3)) * 64];
        v4u o; o.x = pk2(v[0], v[1]); o.y = pk2(v[2], v[3]); o.z = pk2(v[4], v[5]); o.w = pk2(v[6], v[7]);
        wt_st16((bf16*)(ws + WS_WG) + (size_t)f * 8, o); }
    p0_weights<0>(in, ws, lds, gw, NGW, wave, lane);
    for (int i = gw * 64 + lane; i < BATCH * NBLK * LRUW * 2; i += NGW * 64) wt_st8((unsigned long long*)(ws + WS_GR) + i, 0ull);
}
__device__ __forceinline__ unsigned pkbf(float lo, float hi) { typedef float f2 __attribute__((ext_vector_type(2))); typedef __bf16 b2 __attribute__((ext_vector_type(2))); f2 v = {lo, hi}; b2 r = __builtin_convertvector(v, b2); return __builtin_bit_cast(unsigned, r); }
typedef float f32x16_ __attribute__((ext_vector_type(16)));
constexpr int LRU_ROWB = 136, LRU_XT = 40 * LRU_ROWB, LRU_TILE = LRU_XT + 32 * LRU_ROWB;
__device__ __forceinline__ void lru_load(const bf16* U, int n, int b, int ck, int wave, int lane, v4u (&xv)[5], v4u (&gv)[4]) {
    const int t0 = ck * 256 + wave * 32;
    const int rr = lane >> 3, c16 = lane & 7; const bf16* src = U + ((size_t)b * SEQ + t0 - 3 + rr) * INW + n * 64 + c16 * 8;
#pragma unroll
    for (int i = 0; i < 5; ++i) { const int row = rr + 8 * i; const bool ok = (row < 35) && (t0 - 3 + row >= 0); const int rowc = ok ? row : 3;
        const v4u ld = *(const GAS v4u*)(src + (size_t)(rowc - rr) * INW); xv[i] = ok ? ld : (v4u){0u, 0u, 0u, 0u}; }
#pragma unroll
    for (int i = 0; i < 4; ++i) gv[i] = *(const GAS v4u*)(src + (size_t)(3 + 8 * i) * INW + LRUW);
}
__device__ __forceinline__ void lru_stage(LAS unsigned char* tile, int lane, const v4u (&xv)[5], const v4u (&gv)[4]) {
    typedef unsigned u2v __attribute__((ext_vector_type(2)));
    const int rr = lane >> 3, c16 = lane & 7;
#pragma unroll
    for (int i = 0; i < 5; ++i) { LAS unsigned char* d = tile + (rr + 8 * i) * LRU_ROWB + c16 * 16; *(LAS u2v*)d = (u2v){xv[i].x, xv[i].y}; *(LAS u2v*)(d + 8) = (u2v){xv[i].z, xv[i].w}; }
#pragma unroll
    for (int i = 0; i < 4; ++i) { LAS unsigned char* d = tile + LRU_XT + (rr + 8 * i) * LRU_ROWB + c16 * 16; *(LAS u2v*)d = (u2v){gv[i].x, gv[i].y}; *(LAS u2v*)(d + 8) = (u2v){gv[i].z, gv[i].w}; }
}
__device__ __forceinline__ void lru_local(const bf16* WG, const LAS float* PT, LAS unsigned char* tile, int n, int b, int ck, int wave, int lane, float (&av)[32], float (&bv)[32]) {
    typedef unsigned u2v __attribute__((ext_vector_type(2)));
    const int r32 = lane & 31, hi = lane >> 5;
    const int t0 = ck * 256 + wave * 32, t = t0 + r32;
    const LAS unsigned char* xrow = tile + r32 * LRU_ROWB + 8 * hi;
    unsigned xpk[16];
#pragma unroll
    for (int g = 0; g < 8; ++g) {
        f32x4 acc = *(const LAS f32x4*)(PT + 4 * 64 + 8 * g + 4 * hi);
#pragma unroll
        for (int jj = 0; jj < 4; ++jj) { const u2v w = *(const LAS u2v*)(xrow + jj * LRU_ROWB + 16 * g);
            const f32x4 cw = *(const LAS f32x4*)(PT + jj * 64 + 8 * g + 4 * hi);
            acc[0] += cw[0] * bflo(w.x); acc[1] += cw[1] * bfhi(w.x); acc[2] += cw[2] * bflo(w.y); acc[3] += cw[3] * bfhi(w.y); }
        xpk[2 * g] = pkbf(acc[0], acc[1]); xpk[2 * g + 1] = pkbf(acc[2], acc[3]);
    }
    bf16x8 xf[4];
#pragma unroll
    for (int ks = 0; ks < 4; ++ks) { v4u w; w.x = xpk[4 * ks]; w.y = xpk[4 * ks + 1]; w.z = xpk[4 * ks + 2]; w.w = xpk[4 * ks + 3]; xf[ks] = __builtin_bit_cast(bf16x8, w); }
    f32x16_ aR[2], aI[2];
#pragma unroll
    for (int blk = 0; blk < 2; ++blk)
#pragma unroll
        for (int q4 = 0; q4 < 4; ++q4) { const f32x4 ba = *(const LAS f32x4*)(PT + 6 * 64 + 32 * blk + 8 * q4 + 4 * hi), bx = *(const LAS f32x4*)(PT + 7 * 64 + 32 * blk + 8 * q4 + 4 * hi);
#pragma unroll
            for (int i = 0; i < 4; ++i) { aR[blk][4 * q4 + i] = ba[i]; aI[blk][4 * q4 + i] = bx[i]; } }
#pragma unroll
    for (int blk = 0; blk < 2; ++blk)
#pragma unroll
        for (int ks = 0; ks < 4; ++ks) {
            const bf16x8 wa = *(const GAS bf16x8*)(WG + ((size_t)(((n * 2 + 0) * 2 + blk) * 4 + ks) * 64 + lane) * 8);
            const bf16x8 wx = *(const GAS bf16x8*)(WG + ((size_t)(((n * 2 + 1) * 2 + blk) * 4 + ks) * 64 + lane) * 8);
            aR[blk] = __builtin_amdgcn_mfma_f32_32x32x16_bf16(wa, xf[ks], aR[blk], 0, 0, 0);
            aI[blk] = __builtin_amdgcn_mfma_f32_32x32x16_bf16(wx, xf[ks], aI[blk], 0, 0, 0); }
#pragma unroll
    for (int blk = 0; blk < 2; ++blk)
#pragma unroll
        for (int q4 = 0; q4 < 4; ++q4) { const f32x4 sp4 = *(const LAS f32x4*)(PT + 5 * 64 + 32 * blk + 8 * q4 + 4 * hi);
#pragma unroll
            for (int i = 0; i < 4; ++i) { const int idx = 16 * blk + 4 * q4 + i;
                const float r = __builtin_amdgcn_rcpf(1.0f + __builtin_amdgcn_exp2f(-aR[blk][4 * q4 + i])), ii = __builtin_amdgcn_rcpf(1.0f + __builtin_amdgcn_exp2f(-aI[blk][4 * q4 + i]));
                const float a = __builtin_amdgcn_exp2f(r * sp4[i]);
                float mult = __builtin_amdgcn_sqrtf(__builtin_fmaf(-a, a, 1.0f)); if (t == 0) mult = 1.0f;
                const unsigned xw_ = xpk[idx >> 1]; av[idx] = a; bv[idx] = mult * ii * ((idx & 1) ? bfhi(xw_) : bflo(xw_)); } }
#define LRU_E(i, C) "v_fmac_f32_dpp %" #i ", %" #i ", %" #C " " CTRL "\n\tv_mul_f32_dpp %" #C ", %" #C ", %" #C " " CTRL "\n\t"
#define LRU_STEP4(g) asm volatile("s_nop 1\n\t" LRU_E(0, 4) LRU_E(1, 5) LRU_E(2, 6) LRU_E(3, 7) : "+v"(bv[g]), "+v"(bv[g + 1]), "+v"(bv[g + 2]), "+v"(bv[g + 3]), "+v"(av[g]), "+v"(av[g + 1]), "+v"(av[g + 2]), "+v"(av[g + 3]))
#define LRU_STEP() do { LRU_STEP4(0); LRU_STEP4(4); LRU_STEP4(8); LRU_STEP4(12); LRU_STEP4(16); LRU_STEP4(20); LRU_STEP4(24); LRU_STEP4(28); } while (0)
#define CTRL "row_shr:1 row_mask:0xf bank_mask:0xf"
    LRU_STEP();
#undef CTRL
#define CTRL "row_shr:2 row_mask:0xf bank_mask:0xf"
    LRU_STEP();
#undef CTRL
#define CTRL "row_shr:4 row_mask:0xf bank_mask:0xf"
    LRU_STEP();
#undef CTRL
#define CTRL "row_shr:8 row_mask:0xf bank_mask:0xf"
    LRU_STEP();
#undef CTRL
#define CTRL "row_bcast:15 row_mask:0xa bank_mask:0xf"
    LRU_STEP();
#undef CTRL
#undef LRU_E
#undef LRU_STEP4
#undef LRU_STEP
}
__device__ __forceinline__ void lru_put_agg(LAS float* Aw, LAS float* Hw, int wave, int lane, const float (&av)[32], const float (&bv)[32]) {
    const int r32 = lane & 31, hi = lane >> 5;
    if (r32 == 31) {
#pragma unroll
        for (int k = 0; k < 8; ++k) { const int d = 8 * k + 4 * hi; const int idx = 4 * k;
            *(LAS f32x4*)(Aw + wave * 64 + d) = (f32x4){av[idx], av[idx + 1], av[idx + 2], av[idx + 3]}; *(LAS f32x4*)(Hw + wave * 64 + d) = (f32x4){bv[idx], bv[idx + 1], bv[idx + 2], bv[idx + 3]}; } }
}
__device__ __forceinline__ void lru_publish(gu64* GR, const LAS float* Aw, const LAS float* Hw, int b, int ck, int n, int lane) {
    float cA = 1.f, cH = 0.f; const int gc = n * 64 + lane;
#pragma unroll
    for (int v = 0; v < 8; ++v) { const float a1 = Aw[v * 64 + lane], h1 = Hw[v * 64 + lane]; cH = a1 * cH + h1; cA *= a1; }
    gu64* g = GR + ((size_t)(b * NBLK + ck) * LRUW + gc) * 2;
    __hip_atomic_store(g, (1ull << 32) | (unsigned long long)__float_as_uint(cA), __ATOMIC_RELAXED, __HIP_MEMORY_SCOPE_AGENT);
    __hip_atomic_store(g + 1, (1ull << 32) | (unsigned long long)__float_as_uint(cH), __ATOMIC_RELAXED, __HIP_MEMORY_SCOPE_AGENT);
}
__device__ __forceinline__ float lru_lookback(const gu64* GR, int b, int ck, int n, int lane) {
    const int gc = n * 64 + lane; float h = 0.f;
    if (ck > 0) {
        const gu64* g0 = GR + ((size_t)(b * NBLK) * LRUW + gc) * 2;
#pragma unroll
        for (int half = 0; half < 2; ++half) {
            if (half * 16 < ck) {
                float ca[16], ch[16];
                for (unsigned spins = 0;; ++spins) { bool ok = true;
#pragma unroll
                    for (int cc = 0; cc < 16; ++cc) { const int c1 = half * 16 + cc, c2 = c1 < ck ? c1 : 0;
                        const unsigned long long x = __hip_atomic_load(g0 + (size_t)c2 * LRUW * 2, __ATOMIC_RELAXED, __HIP_MEMORY_SCOPE_AGENT), y = __hip_atomic_load(g0 + (size_t)c2 * LRUW * 2 + 1, __ATOMIC_RELAXED, __HIP_MEMORY_SCOPE_AGENT);
                        ok = ok && ((x >> 32) == 1ull) && ((y >> 32) == 1ull); ca[cc] = __uint_as_float((unsigned)x); ch[cc] = __uint_as_float((unsigned)y); }
                    if (__all(ok) || spins > (1u << 14)) break;
                    __builtin_amdgcn_s_sleep(2); }
#pragma unroll
                for (int cc = 0; cc < 16; ++cc) h = (half * 16 + cc) < ck ? ca[cc] * h + ch[cc] : h;
            }
        }
    }
    return h;
}
__device__ __forceinline__ void lru_finish(bf16* MIX, const LAS float* Aw, const LAS float* Hw, const LAS float* CAR, LAS unsigned char* tile, int n, int b, int ck, int wave, int lane, const float (&av)[32], const float (&bv)[32]) {
    typedef unsigned u2v __attribute__((ext_vector_type(2)));
    const int r32 = lane & 31, hi = lane >> 5;
    LAS unsigned char* grow = tile + LRU_XT + r32 * LRU_ROWB + 8 * hi;
    f32x4 c[8];
#pragma unroll
    for (int k = 0; k < 8; ++k) c[k] = *(const LAS f32x4*)(CAR + 8 * k + 4 * hi);
    for (int v = 0; v < wave; ++v) { const LAS float* ap = Aw + v * 64 + 4 * hi; const LAS float* hp = Hw + v * 64 + 4 * hi;
#pragma unroll
        for (int k = 0; k < 8; ++k) { const f32x4 a1 = *(const LAS f32x4*)(ap + 8 * k), h1 = *(const LAS f32x4*)(hp + 8 * k); c[k] = a1 * c[k] + h1; } }
#pragma unroll
    for (int k = 0; k < 8; ++k) { const int idx = 4 * k;
        const u2v gw = *(const LAS u2v*)(grow + 16 * k);
        const float h0 = bv[idx] + av[idx] * c[k][0], h1_ = bv[idx + 1] + av[idx + 1] * c[k][1], h2 = bv[idx + 2] + av[idx + 2] * c[k][2], h3 = bv[idx + 3] + av[idx + 3] * c[k][3];
        u2v o; o.x = pkbf(h0 * gelu_tanh(bflo(gw.x)), h1_ * gelu_tanh(bfhi(gw.x))); o.y = pkbf(h2 * gelu_tanh(bflo(gw.y)), h3 * gelu_tanh(bfhi(gw.y)));
        *(LAS u2v*)(grow + 16 * k) = o; }
    { const int rr = lane >> 3, c16 = lane & 7; bf16* dst = MIX + ((size_t)b * SEQ + ck * 256 + wave * 32 + rr) * D + n * 64 + c16 * 8;
#pragma unroll
      for (int i = 0; i < 4; ++i) { const LAS unsigned char* s = tile + LRU_XT + (rr + 8 * i) * LRU_ROWB + c16 * 16; const u2v lo = *(const LAS u2v*)s, hi2 = *(const LAS u2v*)(s + 8);
          wt_st16(dst + (size_t)(8 * i) * D, (v4u){lo.x, lo.y, hi2.x, hi2.y}); } }
}
template <bool FINAL>
__device__ __forceinline__ void lru_items(unsigned char* ws, LAS unsigned char* lds, int G, int wave, int tid) {
    const bf16* U = (const bf16*)(ws + WS_U); bf16* MIX = (bf16*)(ws + WS_MIX); const bf16* WG = (const bf16*)(ws + WS_WG);
    gu64* GR = (gu64*)(ws + WS_GR);
    LAS float* PT = (LAS float*)(lds + RING_OFF);
    LAS float* Aw = PT + 512; LAS float* Hw = Aw + 512; LAS float* CAR = Hw + 512;
    LAS unsigned char* tile = lds + RING_OFF + 8192 + wave * 10240;
    static_assert(LRU_TILE <= 10240 && 8192 + 8 * 10240 <= RING_BYTES, "LRU LDS map");
    const int n = blockIdx.x & 7;
    __syncthreads();
    { const int row = tid >> 6, c = tid & 63; PT[row * 64 + c] = ((const float*)(ws + WS_PTAB))[row * 512 + n * 64 + c]; }
    v4u xv[5], gv[4];
    if ((int)blockIdx.x < BATCH * NBLK * 8) { int lane0; asm volatile("v_mbcnt_lo_u32_b32 %0, -1, 0\n\tv_mbcnt_hi_u32_b32 %0, -1, %0" : "=v"(lane0)); lru_load(U, n, (int)blockIdx.x >> 8, ((int)blockIdx.x >> 3) & 31, wave, lane0, xv, gv); }
    for (int id = blockIdx.x; id < BATCH * NBLK * 8; id += G) {
        const int ck = (id >> 3) & 31, b = id >> 8;
        int lane; asm volatile("v_mbcnt_lo_u32_b32 %0, -1, 0\n\tv_mbcnt_hi_u32_b32 %0, -1, %0" : "=v"(lane));
        __syncthreads();
        float av[32], bv[32];
        lru_stage(tile, lane, xv, gv);
        { const int nid = (id + G < BATCH * NBLK * 8) ? id + G : id; lru_load(U, n, nid >> 8, (nid >> 3) & 31, wave, lane, xv, gv); }
        lru_local(WG, PT, tile, n, b, ck, wave, lane, av, bv);
        lru_put_agg(Aw, Hw, wave, lane, av, bv);
        __syncthreads();
        if (wave == 0) lru_publish(GR, Aw, Hw, b, ck, n, lane);
        if (wave == 7) CAR[lane] = lru_lookback(GR, b, ck, n, lane);
        __syncthreads();
        lru_finish(MIX, Aw, Hw, CAR, tile, n, b, ck, wave, lane, av, bv);
    }
    __syncthreads();
}
__device__ __forceinline__ void kvprep_items(unsigned char* ws, LAS unsigned char* lds, int G, int wave, int lane, int tid) {
    const bf16* U = (const bf16*)(ws + WS_U); bf16* KF = (bf16*)(ws + WS_KF); bf16* VF = (bf16*)(ws + WS_VF); float* KM = (float*)(ws + WS_KMEAN);
    LAS unsigned char* KT = lds + RING_OFF;
    LAS unsigned short* VTl = (LAS unsigned short*)(lds + RING_OFF + 36864);
    LAS float* part = (LAS float*)(lds + RING_OFF + 36864 + 33792);
    for (int id = blockIdx.x; id < BATCH * NBLK * 4; id += G) {
        const int h = id & 3, j = (id >> 2) & 31, b = id >> 7, bh = b * 4 + h;
        __syncthreads();
        { const int key = tid >> 1, half = tid & 1; const bf16* rowp = U + ((size_t)b * SEQ + j * 256 + key) * INW + h * 64 + half * 32;
          const uint4* ks = (const uint4*)(rowp + 1280); const uint4* vs = (const uint4*)(rowp + 1536);
          v4u kw[4], vw[4];
#pragma unroll
          for (int c = 0; c < 4; ++c) { kw[c] = *(const GAS v4u*)(ks + c); vw[c] = *(const GAS v4u*)(vs + c); }
#pragma unroll
          for (int c = 0; c < 4; ++c) { *(LAS v4u*)(KT + key * 144 + half * 64 + c * 16) = kw[c];
              LAS unsigned* dst = (LAS unsigned*)(VTl + key * 66 + half * 32 + c * 8); dst[0] = vw[c].x; dst[1] = vw[c].y; dst[2] = vw[c].z; dst[3] = vw[c].w; } }
        __syncthreads();
        { const int d = tid & 63, pt = tid >> 6; float s = 0.f;
#pragma unroll 8
          for (int r = 0; r < 32; ++r) s += bf2f(*(const LAS unsigned short*)(KT + (pt * 32 + r) * 144 + d * 2));
          part[pt * 64 + d] = s; }
        { const int r32 = lane & 31, hi = lane >> 5;
#pragma unroll
          for (int ks = 0; ks < 4; ++ks) { const v4u w = *(const LAS v4u*)(KT + (wave * 32 + r32) * 144 + ks * 32 + hi * 16);
              wt_st16(KF + (((size_t)(bh * 256 + j * 8 + wave) * 4 + ks) * 64 + lane) * 8, w); }
#pragma unroll
          for (int db = 0; db < 2; ++db)
#pragma unroll
              for (int s = 0; s < 2; ++s) { unsigned short v[8];
#pragma unroll
                  for (int jj = 0; jj < 8; ++jj) v[jj] = VTl[(wave * 32 + 16 * s + 8 * (jj >> 2) + 4 * hi + (jj & 3)) * 66 + 32 * db + r32];
                  uint4 w; w.x = v[0] | ((unsigned)v[1] << 16); w.y = v[2] | ((unsigned)v[3] << 16); w.z = v[4] | ((unsigned)v[5] << 16); w.w = v[6] | ((unsigned)v[7] << 16);
                  wt_st16(VF + ((((size_t)(bh * 256 + j * 8 + wave) * 2 + db) * 2 + s) * 64 + lane) * 8, (v4u){w.x, w.y, w.z, w.w}); } }
        __syncthreads();
        if (tid < 64) { float s = 0.f;
#pragma unroll
            for (int v = 0; v < 8; ++v) s += part[v * 64 + tid];
            wt_st4f(KM + ((size_t)bh * NBLK + j) * 64 + tid, s * (1.0f / 256.0f)); }
    }
    __syncthreads();
}
__device__ __forceinline__ void memkv_items(unsigned char* ws, LAS unsigned char* lds, int vcu, int G, int wave, int lane) {
    const bf16* A = (const bf16*)(ws + WS_MEMB); const bf16* Bt = (const bf16*)(ws + WS_WMKV);
    bf16* MK = (bf16*)(ws + WS_MEMKF); bf16* MV = (bf16*)(ws + WS_MEMVF); const float* gk = (const float*)(ws + WS_GAINS) + 256;
    LAS float* red = (LAS float*)(lds + RING_OFF);
    for (int id = vcu; id < 32 * 8; id += G) {
        const int rt = id >> 3, ct = id & 7, fr = lane & 15, fq = lane >> 4;
        f32x4 acc[4];
#pragma unroll
        for (int nb = 0; nb < 4; ++nb) acc[nb] = (f32x4){0.f, 0.f, 0.f, 0.f};
        const bf16* ap = A + (size_t)(rt * 16 + fr) * D + fq * 8 + wave * 128;
        const bf16* bp = Bt + (size_t)(ct * 64 + fr) * D + fq * 8 + wave * 128;
        bf16x8 af[4], bfr[4][4];
#pragma unroll
        for (int ks = 0; ks < 4; ++ks) { af[ks] = *(const GAS bf16x8*)(ap + ks * 32);
#pragma unroll
            for (int nb = 0; nb < 4; ++nb) bfr[ks][nb] = *(const GAS bf16x8*)(bp + (size_t)nb * 16 * D + ks * 32); }
#pragma unroll
        for (int ks = 0; ks < 4; ++ks)
#pragma unroll
            for (int nb = 0; nb < 4; ++nb) acc[nb] = __builtin_amdgcn_mfma_f32_16x16x32_bf16(af[ks], bfr[ks][nb], acc[nb], 0, 0, 0);
        __syncthreads();
#pragma unroll
        for (int nb = 0; nb < 4; ++nb) *(LAS f32x4*)(red + ((wave * 4 + nb) * 64 + lane) * 4) = acc[nb];
        __syncthreads();
        if (wave == 0) {
            float gkv[4];
#pragma unroll
            for (int nb = 0; nb < 4; ++nb) gkv[nb] = *(const GAS float*)(gk + nb * 16 + fr);
#pragma unroll
            for (int nb = 0; nb < 4; ++nb) { f32x4 s = *(const LAS f32x4*)(red + (nb * 64 + lane) * 4);
#pragma unroll
                for (int w = 1; w < 8; ++w) s += *(const LAS f32x4*)(red + ((w * 4 + nb) * 64 + lane) * 4);
                acc[nb] = s; }
#pragma unroll
            for (int reg = 0; reg < 4; ++reg) { const int row = rt * 16 + 4 * fq + reg, bb = row >> 8, m = row & 255, kb = m >> 5, mm = m & 31;
                if (ct < 4) { float ss = 0.f;
#pragma unroll
                    for (int nb = 0; nb < 4; ++nb) ss += acc[nb][reg] * acc[nb][reg];
                    ss += __shfl_xor(ss, 1); ss += __shfl_xor(ss, 2); ss += __shfl_xor(ss, 4); ss += __shfl_xor(ss, 8);
                    const float rn = __builtin_amdgcn_rsqf(ss * (1.0f / 64.0f) + EPS);
#pragma unroll
                    for (int nb = 0; nb < 4; ++nb) { const int d = nb * 16 + fr;
                        wt_st2(MK + ((((size_t)((bb * 4 + ct) * 8 + kb) * 4 + (d >> 4)) * 64) + ((d >> 3) & 1) * 32 + mm) * 8 + (d & 7), f2bf(acc[nb][reg] * rn * gkv[nb])); }
                } else { const int s = mm >> 4, o = mm & 15, hi2 = (o >> 2) & 1, jj = 4 * (o >> 3) + (o & 3);
#pragma unroll
                    for (int nb = 0; nb < 4; ++nb) { const int d = nb * 16 + fr;
                        wt_st2(MV + (((((size_t)((bb * 4 + (ct - 4)) * 8 + kb) * 2 + (d >> 5)) * 2 + s) * 64) + hi2 * 32 + (d & 31)) * 8 + jj, f2bf(acc[nb][reg])); } } }
        }
    }
    __syncthreads();
}
typedef float f32x16 __attribute__((ext_vector_type(16)));
__device__ __forceinline__ int crow(int r, int hi) { return (r & 3) + 8 * (r >> 2) + 4 * hi; }
__device__ __forceinline__ unsigned cvtpk(float lo, float hi) { typedef float f2 __attribute__((ext_vector_type(2))); typedef __bf16 b2 __attribute__((ext_vector_type(2))); f2 v = {lo, hi}; b2 r = __builtin_convertvector(v, b2); return __builtin_bit_cast(unsigned, r); }
__device__ __forceinline__ void attn_task(f32x16& o0, f32x16& o1, float& lsum, const bf16* qrow, const bf16* KFb, const bf16* VFb, int nkb, float cq, float slopeL, int dist0, int lane) {
    const int r32 = lane & 31, hi = lane >> 5; (void)r32;
    bf16x8 qf[4];
#pragma unroll
    for (int ks = 0; ks < 4; ++ks) qf[ks] = *(const bf16x8*)(qrow + 16 * ks + 8 * hi);
    float base[16];
#pragma unroll
    for (int r = 0; r < 16; ++r) base[r] = slopeL * (float)crow(r, hi) + cq;
#pragma unroll
    for (int r = 0; r < 16; ++r) { o0[r] = 0.f; o1[r] = 0.f; }
    lsum = 0.f;
    const bf16* kp = KFb + lane * 8;
    const bf16* vp = VFb + lane * 8;
    bf16x8 kA[4], vA[4];
#define AT_LOADK(k_, kb_) do { _Pragma("unroll") for (int ks = 0; ks < 4; ++ks) k_[ks] = *(const bf16x8*)(kp + ((kb_) * 4 + ks) * 512); } while (0)
#define AT_LOADV(v_, kb_) do { _Pragma("unroll") for (int f = 0; f < 4; ++f) v_[f] = *(const bf16x8*)(vp + ((kb_) * 4 + f) * 512); } while (0)
    AT_LOADK(kA, 0); AT_LOADV(vA, 0);
#pragma unroll 1
    for (int kb = 0; kb < nkb; ++kb) {
        const float c0 = slopeL * (float)(32 * kb); f32x16 sc;
#pragma unroll
        for (int r = 0; r < 16; ++r) sc[r] = base[r] + c0;
#pragma unroll
        for (int ks = 0; ks < 4; ++ks) sc = __builtin_amdgcn_mfma_f32_32x32x16_bf16(kA[ks], qf[ks], sc, 0, 0, 0);
        if (kb + 1 < nkb) AT_LOADK(kA, kb + 1);
#pragma unroll
        for (int r = 0; r < 16; ++r) { float pr = __builtin_amdgcn_exp2f(sc[r]); if (32 * kb + crow(r, hi) > dist0) pr = 0.f; sc[r] = pr; lsum += pr; }
        v4u w0, w1; w0.x = cvtpk(sc[0], sc[1]); w0.y = cvtpk(sc[2], sc[3]); w0.z = cvtpk(sc[4], sc[5]); w0.w = cvtpk(sc[6], sc[7]); w1.x = cvtpk(sc[8], sc[9]); w1.y = cvtpk(sc[10], sc[11]); w1.z = cvtpk(sc[12], sc[13]); w1.w = cvtpk(sc[14], sc[15]);
        const bf16x8 p0 = __builtin_bit_cast(bf16x8, w0), p1 = __builtin_bit_cast(bf16x8, w1);
        o0 = __builtin_amdgcn_mfma_f32_32x32x16_bf16(vA[0], p0, o0, 0, 0, 0); o0 = __builtin_amdgcn_mfma_f32_32x32x16_bf16(vA[1], p1, o0, 0, 0, 0);
        o1 = __builtin_amdgcn_mfma_f32_32x32x16_bf16(vA[2], p0, o1, 0, 0, 0); o1 = __builtin_amdgcn_mfma_f32_32x32x16_bf16(vA[3], p1, o1, 0, 0, 0);
        if (kb + 1 < nkb) AT_LOADV(vA, kb + 1);
    }
#undef AT_LOADK
#undef AT_LOADV
}
constexpr int AU_KMT = 0;
constexpr int AU_SLOT = 0;
constexpr int AU_CNT = LDSCTL_OFF + 512, AU_TC = AU_CNT + 128, AU_TASKS = AU_TC + 16, AU_LIST = AU_TASKS + 240, AU_LACC = AU_LIST + 32 * 256 * 2, AU_END = AU_LACC + 4 * 256 * 4;
static_assert(AU_END <= LDS_BYTES, "MoBA unit LDS map");
__device__ __forceinline__ void moba_unit(unsigned char* ws, LAS unsigned char* lds, int bh, int qb, int wave, int lane, int tid) {
    const bf16* U = (const bf16*)(ws + WS_U); bf16* MIX = (bf16*)(ws + WS_MIX); const float* KM = (const float*)(ws + WS_KMEAN);
    const float* GT = (const float*)(ws + WS_GAINS);
    LAS unsigned* CNT = (LAS unsigned*)(lds + AU_CNT); LAS unsigned* TC = (LAS unsigned*)(lds + AU_TC);
    LAS unsigned short* TASKS = (LAS unsigned short*)(lds + AU_TASKS); LAS unsigned short* LIST = (LAS unsigned short*)(lds + AU_LIST);
    LAS float* KMT = (LAS float*)(lds + AU_KMT); LAS float* LACC = (LAS float*)(lds + AU_LACC);
    LAS unsigned char* SLOT = lds + AU_SLOT;
    const int b = bh >> 2, h = bh & 3, r32 = lane & 31, hi = lane >> 5;
    const size_t rb = (size_t)b * SEQ;
    const float slopeL = exp2f(-2.0f * (float)(h + 1)) * 1.4426950408889634f;
    const float MB2 = GT[192];
    const bf16* Qh = U + (rb + (size_t)qb * 256) * INW + 1024 + h * 64;
    const bf16* KFh = (const bf16*)(ws + WS_KF) + (size_t)bh * 256 * 2048;
    const bf16* VFh = (const bf16*)(ws + WS_VF) + (size_t)bh * 256 * 2048;
#ifndef REP_MB_SETUP
#define REP_MB_SETUP 1
#endif
    for (int rsu_ = 0; rsu_ < REP_MB_SETUP; ++rsu_) {
    __syncthreads();
    if (tid < 36) CNT[tid] = 0u;
    const int ql = wave * 32 + r32;
    unsigned qw[32];
    { const GAS v4u* p = (const GAS v4u*)(Qh + (size_t)ql * INW);
#pragma unroll
      for (int c = 0; c < 8; ++c) { const v4u w = p[c]; qw[4 * c] = w.x; qw[4 * c + 1] = w.y; qw[4 * c + 2] = w.z; qw[4 * c + 3] = w.w; } }
    for (int i = tid; i < qb * 64; i += 512) KMT[(i >> 6) * 65 + (i & 63)] = *(const GAS float*)(KM + (size_t)bh * NBLK * 64 + i);
    __syncthreads();
    if (qb > 0) {
        f32x16 g;
#pragma unroll
        for (int r = 0; r < 16; ++r) g[r] = 0.f;
#pragma unroll
        for (int ks = 0; ks < 32; ++ks) { const float a = KMT[r32 * 65 + 2 * ks + hi]; const float bq = hi ? bfhi(qw[ks]) : bflo(qw[ks]); g = __builtin_amdgcn_mfma_f32_32x32x2f32(a, bq, g, 0, 0, 0); }
        float g1 = -INFINITY, g2 = -INFINITY, g3 = -INFINITY; int i1 = 0, i2 = 0, i3 = 0;
#pragma unroll
        for (int r = 0; r < 16; ++r) { const int j = crow(r, hi); const float gv = (j < qb) ? g[r] : -INFINITY;
            const bool c1 = gv > g1, c2 = gv > g2, c3 = gv > g3;
            g3 = c2 ? g2 : (c3 ? gv : g3); i3 = c2 ? i2 : (c3 ? j : i3);
            g2 = c1 ? g1 : (c2 ? gv : g2); i2 = c1 ? i1 : (c2 ? j : i2);
            g1 = c1 ? gv : g1; i1 = c1 ? j : i1; }
        float pg[3]; int pi[3];
        pg[0] = __shfl_xor(g1, 32); pg[1] = __shfl_xor(g2, 32); pg[2] = __shfl_xor(g3, 32); pi[0] = __shfl_xor(i1, 32); pi[1] = __shfl_xor(i2, 32); pi[2] = __shfl_xor(i3, 32);
#pragma unroll
        for (int k = 0; k < 3; ++k) { const float gv = pg[k]; const int j = pi[k];
            const bool c1 = gv > g1 || (gv == g1 && j < i1), c2 = gv > g2 || (gv == g2 && j < i2), c3 = gv > g3 || (gv == g3 && j < i3);
            g3 = c2 ? g2 : (c3 ? gv : g3); i3 = c2 ? i2 : (c3 ? j : i3);
            g2 = c1 ? g1 : (c2 ? gv : g2); i2 = c1 ? i1 : (c2 ? j : i2);
            g1 = c1 ? gv : g1; i1 = c1 ? j : i1; }
        if (hi == 0) { const int nok = qb < 3 ? qb : 3;
            if (nok > 0) { const unsigned pos = atomicAdd((unsigned*)&CNT[i1], 1u); LIST[i1 * 256 + pos] = (unsigned short)ql; }
            if (nok > 1) { const unsigned pos = atomicAdd((unsigned*)&CNT[i2], 1u); LIST[i2 * 256 + pos] = (unsigned short)(ql | 0x100); }
            if (nok > 2) { const unsigned pos = atomicAdd((unsigned*)&CNT[i3], 1u); LIST[i3 * 256 + pos] = (unsigned short)(ql | 0x200); } }
    }
    __syncthreads();
    if (wave == 0) {
        const unsigned c = (lane < qb && lane < 32) ? CNT[lane] : 0u; const int ng = (int)((c + 31u) >> 5);
        int incl = ng;
#pragma unroll
        for (int o = 1; o < 64; o <<= 1) { const int t = __shfl_up(incl, o); if (lane >= o) incl += t; }
        const int off = incl - ng, total = __shfl(incl, 63);
#ifdef MB_SHARED_FIRST
        for (int g = 0; g < ng; ++g) TASKS[16 + off + g] = (unsigned short)((lane << 8) | g);
        if (lane < 8) { TASKS[lane] = (unsigned short)(0x4000 | lane); TASKS[8 + lane] = (unsigned short)(0x8000 | lane); }
#else
        for (int g = 0; g < ng; ++g) TASKS[off + g] = (unsigned short)((lane << 8) | g);
        if (lane < 8) { TASKS[total + lane] = (unsigned short)(0x8000 | (7 - lane)); TASKS[total + 8 + lane] = (unsigned short)(0x4000 | lane); }
#endif
        if (lane == 0) TC[0] = (unsigned)(total + 16);
    }
    __syncthreads();
    }
    const int ntasks = (int)TC[0];
#ifndef REP_MB_STREAM
#define REP_MB_STREAM 1
#endif
#ifdef MB_ROT4
    for (int rst_ = 0; rst_ < REP_MB_STREAM; ++rst_)
    if (wave < ntasks) {
        int lane; asm volatile("v_mbcnt_lo_u32_b32 %0, -1, 0\n\tv_mbcnt_hi_u32_b32 %0, -1, %0" : "=v"(lane));
        const int r32 = lane & 31, hi = lane >> 5; unsigned loffB = (unsigned)lane * 16u;
        int t = wave;
        int c_j, c_nkb, c_slot, c_ql, c_dist0; bool c_valid, c_own, c_mem;
#define MB_DECODE(T, J, NKB, SLOT, QL, DIST0, VALID, OWN, MEM) do { const unsigned tk_ = (unsigned)__builtin_amdgcn_readfirstlane((int)TASKS[T]); MEM = (tk_ & 0x4000u) != 0u; OWN = (tk_ & 0x8000u) != 0u; \
        if (MEM) { QL = (int)(tk_ & 7u) * 32 + r32; SLOT = 4; J = 0; NKB = 8; DIST0 = 1 << 20; VALID = true; } \
        else if (OWN) { const int w_ = (int)(tk_ & 7u); QL = w_ * 32 + r32; SLOT = 3; J = qb; NKB = (w_ + 2) & ~1; DIST0 = QL; VALID = true; } \
        else { J = (int)(tk_ >> 8); const int g_ = (int)(tk_ & 0xffu); const int cnt_ = (int)CNT[J]; const int idx_ = 32 * g_ + r32; VALID = idx_ < cnt_; const unsigned e_ = LIST[J * 256 + (VALID ? idx_ : 32 * g_)]; \
               QL = (int)(e_ & 0xffu); SLOT = (int)(e_ >> 8); NKB = 8; DIST0 = 1 << 20; } } while (0)
        MB_DECODE(t, c_j, c_nkb, c_slot, c_ql, c_dist0, c_valid, c_own, c_mem);
        bf16x8 qf[4], qfn[4], kA[4], vA[4], kB[4], vB[4];
        const bf16* MKFh = (const bf16*)(ws + WS_MEMKF) + (size_t)bh * 8 * 2048; const bf16* MVFh = (const bf16*)(ws + WS_MEMVF) + (size_t)bh * 8 * 2048; const float MBM = GT[193];
        { const bf16* qrow = Qh + (size_t)c_ql * INW + 8 * hi + (c_mem ? 768 : 0);
#pragma unroll
          for (int ks = 0; ks < 4; ++ks) qf[ks] = *(const GAS bf16x8*)(qrow + 16 * ks); }
        const bf16* kp = c_mem ? MKFh : KFh + (size_t)c_j * 16384; const bf16* vp = c_mem ? MVFh : VFh + (size_t)c_j * 16384;
#define MB_LOADF(F_, P, KB) do { const GAS char* b_ = (const GAS char*)((P) + (KB) * 2048); _Pragma("unroll") for (int f = 0; f < 4; ++f) F_[f] = *(const GAS bf16x8*)(b_ + f * 1024 + loffB); } while (0)
#define MB_QK(K_, KB) const float c0_ = __builtin_fmaf(c_slope, (float)(32 * (KB)), cqh); f32x16 sc; _Pragma("unroll") for (int r = 0; r < 16; ++r) sc[r] = __builtin_fmaf(c_slope, (float)((r & 3) + 8 * (r >> 2)), c0_); \
        _Pragma("unroll") for (int ks = 0; ks < 4; ++ks) sc = __builtin_amdgcn_mfma_f32_32x32x16_bf16(K_[ks], qf[ks], sc, 0, 0, 0);
#define MB_PV(V_, KB) \
        if (c_own) { _Pragma("unroll") for (int r = 0; r < 16; ++r) { float pr = __builtin_amdgcn_exp2f(sc[r]); if (32 * (KB) + crow(r, hi) > c_dist0) pr = 0.f; sc[r] = pr; ls += pr; } } \
        else { _Pragma("unroll") for (int r = 0; r < 16; ++r) { const float pr = __builtin_amdgcn_exp2f(sc[r]); sc[r] = pr; ls += pr; } } \
        v4u w0_, w1_; w0_.x = cvtpk(sc[0], sc[1]); w0_.y = cvtpk(sc[2], sc[3]); w0_.z = cvtpk(sc[4], sc[5]); w0_.w = cvtpk(sc[6], sc[7]); w1_.x = cvtpk(sc[8], sc[9]); w1_.y = cvtpk(sc[10], sc[11]); w1_.z = cvtpk(sc[12], sc[13]); w1_.w = cvtpk(sc[14], sc[15]); \
        const bf16x8 p0_ = __builtin_bit_cast(bf16x8, w0_), p1_ = __builtin_bit_cast(bf16x8, w1_); \
        o0 = __builtin_amdgcn_mfma_f32_32x32x16_bf16(V_[0], p0_, o0, 0, 0, 0); o0 = __builtin_amdgcn_mfma_f32_32x32x16_bf16(V_[1], p1_, o0, 0, 0, 0); \
        o1 = __builtin_amdgcn_mfma_f32_32x32x16_bf16(V_[2], p0_, o1, 0, 0, 0); o1 = __builtin_amdgcn_mfma_f32_32x32x16_bf16(V_[3], p1_, o1, 0, 0, 0);
#define MB_SB __builtin_amdgcn_sched_barrier(0)
#define MB_PINK asm volatile("" :: "v"(sc) : "memory")
#define MB_PINV asm volatile("" :: "v"(o0), "v"(o1) : "memory")
        MB_LOADF(kA, kp, 0); MB_LOADF(vA, vp, 0); MB_LOADF(kB, kp, 1); MB_LOADF(vB, vp, 1);
#pragma unroll 1
        for (;;) {
            const int tn = t + 8; const bool has_next = tn < ntasks;
            int n_j = 0, n_nkb = 0, n_slot = 0, n_ql = 0, n_dist0 = 0; bool n_valid = false, n_own = false, n_mem = false;
            const bf16* kpn = kp; const bf16* vpn = vp;
            if (has_next) { MB_DECODE(tn, n_j, n_nkb, n_slot, n_ql, n_dist0, n_valid, n_own, n_mem);
                const bf16* qrow = Qh + (size_t)n_ql * INW + 8 * hi + (n_mem ? 768 : 0);
#pragma unroll
                for (int ks = 0; ks < 4; ++ks) qfn[ks] = *(const GAS bf16x8*)(qrow + 16 * ks);
                kpn = n_mem ? MKFh : KFh + (size_t)n_j * 16384; vpn = n_mem ? MVFh : VFh + (size_t)n_j * 16384; }
            const float c_slope = c_mem ? 0.f : slopeL;
            const float cq = c_mem ? -MBM : -MB2 - slopeL * (float)((qb - c_j) * 256 + c_ql);
            const float cqh = __builtin_fmaf(c_slope, (float)(4 * hi), cq);
            f32x16 o0, o1; float ls = 0.f;
#pragma unroll
            for (int r = 0; r < 16; ++r) { o0[r] = 0.f; o1[r] = 0.f; }
#pragma unroll 1
            for (int kb = 0; kb < c_nkb; kb += 2) {
                const bool more = kb + 2 < c_nkb; const bf16* kq = more ? kp : kpn; const bf16* vq = more ? vp : vpn; const int kbq = more ? kb + 2 : 0;
                { MB_QK(kA, kb) MB_PINK; MB_LOADF(kA, kq, kbq); MB_SB; MB_PV(vA, kb) MB_PINV; MB_LOADF(vA, vq, kbq); MB_SB; }
                { MB_QK(kB, kb + 1) MB_PINK; MB_LOADF(kB, kq, kbq + 1); MB_SB; MB_PV(vB, kb + 1) MB_PINV; MB_LOADF(vB, vq, kbq + 1); MB_SB; }
            }
            ls += __shfl_xor(ls, 32);
            if (c_mem) { const float il = 1.0f / ls; bf16* dst = MIX + (rb + (size_t)qb * 256 + c_ql) * D + 768 + h * 64;
#pragma unroll
                for (int q4 = 0; q4 < 4; ++q4) { uint2 w;
                    w.x = cvtpk(o0[4 * q4] * il, o0[4 * q4 + 1] * il); w.y = cvtpk(o0[4 * q4 + 2] * il, o0[4 * q4 + 3] * il); *(uint2*)(dst + 8 * q4 + 4 * hi) = w;
                    w.x = cvtpk(o1[4 * q4] * il, o1[4 * q4 + 1] * il); w.y = cvtpk(o1[4 * q4 + 2] * il, o1[4 * q4 + 3] * il); *(uint2*)(dst + 32 + 8 * q4 + 4 * hi) = w; } }
            else if (c_valid) { LAS unsigned char* rowp = SLOT + (c_slot * 256 + c_ql) * 128; const int sw = c_ql & 15;
                typedef unsigned u2v __attribute__((ext_vector_type(2)));
#pragma unroll
                for (int q4 = 0; q4 < 4; ++q4) { *(LAS u2v*)(rowp + (((2 * q4 + hi) ^ sw) << 3)) = (u2v){cvtpk(o0[4 * q4], o0[4 * q4 + 1]), cvtpk(o0[4 * q4 + 2], o0[4 * q4 + 3])};
                    *(LAS u2v*)(rowp + (((8 + 2 * q4 + hi) ^ sw) << 3)) = (u2v){cvtpk(o1[4 * q4], o1[4 * q4 + 1]), cvtpk(o1[4 * q4 + 2], o1[4 * q4 + 3])}; }
                if (hi == 0) LACC[c_slot * 256 + c_ql] = ls; }
            if (!has_next) break;
            t = tn; c_j = n_j; c_nkb = n_nkb; c_slot = n_slot; c_ql = n_ql; c_dist0 = n_dist0; c_valid = n_valid; c_own = n_own; c_mem = n_mem; kp = kpn; vp = vpn;
#pragma unroll
            for (int ks = 0; ks < 4; ++ks) qf[ks] = qfn[ks];
        }
#undef MB_DECODE
#undef MB_LOADF
#undef MB_QK
#undef MB_PV
#undef MB_SB
#undef MB_PINK
#undef MB_PINV
    }
#else
    for (int rst_ = 0; rst_ < REP_MB_STREAM; ++rst_)
    if (wave < ntasks) {
        int lane; asm volatile("v_mbcnt_lo_u32_b32 %0, -1, 0\n\tv_mbcnt_hi_u32_b32 %0, -1, %0" : "=v"(lane));
        const int r32 = lane & 31, hi = lane >> 5;
        int t = wave;
        int c_j, c_nkb, c_slot, c_ql, c_dist0; bool c_valid, c_own;
#define MB_DECODE(T, J, NKB, SLOT, QL, DIST0, VALID, OWN) do { const unsigned tk_ = TASKS[T]; \
        if (tk_ & 0x4000u) { QL = (int)(tk_ & 7u) * 32 + r32; SLOT = 4; J = 0; NKB = 8; DIST0 = 1 << 20; VALID = true; OWN = false; } \
        else if (tk_ & 0x8000u) { const int w_ = (int)(tk_ & 7u); QL = w_ * 32 + r32; SLOT = 3; J = qb; NKB = (w_ + 2) & ~1; DIST0 = QL; VALID = true; OWN = true; } \
        else { J = (int)(tk_ >> 8); const int g_ = (int)(tk_ & 0xffu); const int cnt_ = (int)CNT[J]; const int idx_ = 32 * g_ + r32; VALID = idx_ < cnt_; const unsigned e_ = LIST[J * 256 + (VALID ? idx_ : 32 * g_)]; \
               QL = (int)(e_ & 0xffu); SLOT = (int)(e_ >> 8); NKB = 8; DIST0 = 1 << 20; OWN = false; } } while (0)
        MB_DECODE(t, c_j, c_nkb, c_slot, c_ql, c_dist0, c_valid, c_own);
        bf16x8 qf[4], qfn[4], kA[4], vA[4], kB[4], vB[4];
        const bf16* MKFh = (const bf16*)(ws + WS_MEMKF) + (size_t)bh * 8 * 2048; const bf16* MVFh = (const bf16*)(ws + WS_MEMVF) + (size_t)bh * 8 * 2048; const float MBM = GT[193];
        { const bf16* qrow = Qh + (size_t)c_ql * INW + 8 * hi + (c_slot == 4 ? 768 : 0);
#pragma unroll
          for (int ks = 0; ks < 4; ++ks) qf[ks] = *(const GAS bf16x8*)(qrow + 16 * ks); }
        const bf16* kp = (c_slot == 4 ? MKFh : KFh + (size_t)c_j * 16384) + lane * 8; const bf16* vp = (c_slot == 4 ? MVFh : VFh + (size_t)c_j * 16384) + lane * 8;
#ifdef MB_PROBE_VAR
        const int pvar_ = (REP_MB_STREAM == 2 && rst_ == 0) ? MB_PROBE_VAR : 0;
#define MB_KBE(KB) (pvar_ == 1 ? 0 : (KB))
#define MB_NOEXP (pvar_ == 2)
#define MB_NOMMA (pvar_ == 3)
#define MB_NKB(n) (pvar_ == 4 ? 0 : (n))
#else
#define MB_NKB(n) (n)
#define MB_KBE(KB) (KB)
#define MB_NOEXP false
#define MB_NOMMA false
#endif
#define MB_LOADK(K_, KP, KB) do { _Pragma("unroll") for (int f = 0; f < 4; ++f) K_[f] = *(const GAS bf16x8*)((KP) + (MB_KBE(KB) * 4 + f) * 512); } while (0)
#define MB_LOADV(V_, VP, KB) do { _Pragma("unroll") for (int f = 0; f < 4; ++f) V_[f] = *(const GAS bf16x8*)((VP) + (MB_KBE(KB) * 4 + f) * 512); } while (0)
#define MB_LOAD(K_, V_, KP, VP, KB) do { MB_LOADK(K_, KP, KB); MB_LOADV(V_, VP, KB); } while (0)
#define MB_QK(K_, KB) const float c0_ = __builtin_fmaf(c_slope, (float)(32 * (KB)), cqh); f32x16 sc; _Pragma("unroll") for (int r = 0; r < 16; ++r) sc[r] = __builtin_fmaf(c_slope, (float)((r & 3) + 8 * (r >> 2)), c0_); \
        if (!MB_NOMMA) { _Pragma("unroll") for (int ks = 0; ks < 4; ++ks) sc = __builtin_amdgcn_mfma_f32_32x32x16_bf16(K_[ks], qf[ks], sc, 0, 0, 0); }
#define MB_PV(V_, KB) \
        if (MB_NOEXP) { _Pragma("unroll") for (int r = 0; r < 16; ++r) ls += sc[r]; } else \
        if (c_own) { _Pragma("unroll") for (int r = 0; r < 16; ++r) { float pr = __builtin_amdgcn_exp2f(sc[r]); if (32 * (KB) + crow(r, hi) > c_dist0) pr = 0.f; sc[r] = pr; ls += pr; } } \
        else { _Pragma("unroll") for (int r = 0; r < 16; ++r) { const float pr = __builtin_amdgcn_exp2f(sc[r]); sc[r] = pr; ls += pr; } } \
        v4u w0_, w1_; w0_.x = cvtpk(sc[0], sc[1]); w0_.y = cvtpk(sc[2], sc[3]); w0_.z = cvtpk(sc[4], sc[5]); w0_.w = cvtpk(sc[6], sc[7]); w1_.x = cvtpk(sc[8], sc[9]); w1_.y = cvtpk(sc[10], sc[11]); w1_.z = cvtpk(sc[12], sc[13]); w1_.w = cvtpk(sc[14], sc[15]); \
        const bf16x8 p0_ = __builtin_bit_cast(bf16x8, w0_), p1_ = __builtin_bit_cast(bf16x8, w1_); \
        if (!MB_NOMMA) { o0 = __builtin_amdgcn_mfma_f32_32x32x16_bf16(V_[0], p0_, o0, 0, 0, 0); o0 = __builtin_amdgcn_mfma_f32_32x32x16_bf16(V_[1], p1_, o0, 0, 0, 0); \
        o1 = __builtin_amdgcn_mfma_f32_32x32x16_bf16(V_[2], p0_, o1, 0, 0, 0); o1 = __builtin_amdgcn_mfma_f32_32x32x16_bf16(V_[3], p1_, o1, 0, 0, 0); } \
        else { _Pragma("unroll") for (int f = 0; f < 4; ++f) asm volatile("" :: "v"(V_[f])); asm volatile("" :: "v"(p0_), "v"(p1_)); }
#define MB_COMP(K_, V_, KB) do { MB_QK(K_, KB) MB_PV(V_, KB) } while (0)
        MB_LOAD(kA, vA, kp, vp, 0);
#pragma unroll 1
        for (;;) {
            const int tn = t + 8; const bool has_next = tn < ntasks;
            int n_j = 0, n_nkb = 0, n_slot = 0, n_ql = 0, n_dist0 = 0; bool n_valid = false, n_own = false;
            const bf16* kpn = kp; const bf16* vpn = vp;
            if (has_next) { MB_DECODE(tn, n_j, n_nkb, n_slot, n_ql, n_dist0, n_valid, n_own);
                const bf16* qrow = Qh + (size_t)n_ql * INW + 8 * hi + (n_slot == 4 ? 768 : 0);
#pragma unroll
                for (int ks = 0; ks < 4; ++ks) qfn[ks] = *(const GAS bf16x8*)(qrow + 16 * ks);
                kpn = (n_slot == 4 ? MKFh : KFh + (size_t)n_j * 16384) + lane * 8; vpn = (n_slot == 4 ? MVFh : VFh + (size_t)n_j * 16384) + lane * 8; }
            const float c_slope = c_slot == 4 ? 0.f : slopeL;
            const float cq = c_slot == 4 ? -MBM : -MB2 - slopeL * (float)((qb - c_j) * 256 + c_ql);
            const float cqh = __builtin_fmaf(c_slope, (float)(4 * hi), cq);
            f32x16 o0, o1; float ls = 0.f;
#pragma unroll
            for (int r = 0; r < 16; ++r) { o0[r] = 0.f; o1[r] = 0.f; }
#pragma unroll 1
            for (int kb = 0; kb < MB_NKB(c_nkb); kb += 2) {
                MB_LOAD(kB, vB, kp, vp, kb + 1);
                MB_COMP(kA, vA, kb);
                { const bool more = kb + 2 < c_nkb; const bf16* kq = more ? kp : kpn; const bf16* vq = more ? vp : vpn; const int kbq = more ? kb + 2 : 0;
                  MB_LOAD(kA, vA, kq, vq, kbq); }
                MB_COMP(kB, vB, kb + 1);
            }
            ls += __shfl_xor(ls, 32);
            if (c_slot == 4) { const float il = 1.0f / ls; bf16* dst = MIX + (rb + (size_t)qb * 256 + c_ql) * D + 768 + h * 64;
#pragma unroll
                for (int q4 = 0; q4 < 4; ++q4) { uint2 w;
                    w.x = cvtpk(o0[4 * q4] * il, o0[4 * q4 + 1] * il); w.y = cvtpk(o0[4 * q4 + 2] * il, o0[4 * q4 + 3] * il); *(uint2*)(dst + 8 * q4 + 4 * hi) = w;
                    w.x = cvtpk(o1[4 * q4] * il, o1[4 * q4 + 1] * il); w.y = cvtpk(o1[4 * q4 + 2] * il, o1[4 * q4 + 3] * il); *(uint2*)(dst + 32 + 8 * q4 + 4 * hi) = w; } }
            else if (c_valid) { LAS unsigned char* rowp = SLOT + (c_slot * 256 + c_ql) * 128; const int sw = c_ql & 15;
                typedef unsigned u2v __attribute__((ext_vector_type(2)));
#pragma unroll
                for (int q4 = 0; q4 < 4; ++q4) { *(LAS u2v*)(rowp + (((2 * q4 + hi) ^ sw) << 3)) = (u2v){cvtpk(o0[4 * q4], o0[4 * q4 + 1]), cvtpk(o0[4 * q4 + 2], o0[4 * q4 + 3])};
                    *(LAS u2v*)(rowp + (((8 + 2 * q4 + hi) ^ sw) << 3)) = (u2v){cvtpk(o1[4 * q4], o1[4 * q4 + 1]), cvtpk(o1[4 * q4 + 2], o1[4 * q4 + 3])}; }
                if (hi == 0) LACC[c_slot * 256 + c_ql] = ls; }
            if (!has_next) break;
            t = tn; c_j = n_j; c_nkb = n_nkb; c_slot = n_slot; c_ql = n_ql; c_dist0 = n_dist0; c_valid = n_valid; c_own = n_own; kp = kpn; vp = vpn;
#pragma unroll
            for (int ks = 0; ks < 4; ++ks) qf[ks] = qfn[ks];
        }
#undef MB_DECODE
#undef MB_LOAD
#undef MB_COMP
#undef MB_QK
#undef MB_PV
#undef MB_LOADK
#undef MB_LOADV
    }
#endif
    __syncthreads();
    { int lane; asm volatile("v_mbcnt_lo_u32_b32 %0, -1, 0\n\tv_mbcnt_hi_u32_b32 %0, -1, %0" : "=v"(lane)); const int tid = wave * 64 + lane;
      const int row = tid >> 1, half = tid & 1; const int nok = qb < 3 ? qb : 3; const int sw = row & 15;
      typedef unsigned u2v __attribute__((ext_vector_type(2)));
      float acc[32]; float l = LACC[3 * 256 + row];
      { const LAS unsigned char* rowp = SLOT + (3 * 256 + row) * 128;
#pragma unroll
        for (int c = 0; c < 8; ++c) { const u2v w = *(const LAS u2v*)(rowp + (((8 * half + c) ^ sw) << 3)); acc[4 * c] = bflo(w.x); acc[4 * c + 1] = bfhi(w.x); acc[4 * c + 2] = bflo(w.y); acc[4 * c + 3] = bfhi(w.y); } }
#pragma unroll
      for (int s = 0; s < 3; ++s) if (s < nok) { const LAS unsigned char* rowp = SLOT + (s * 256 + row) * 128; l += LACC[s * 256 + row];
#pragma unroll
        for (int c = 0; c < 8; ++c) { const u2v w = *(const LAS u2v*)(rowp + (((8 * half + c) ^ sw) << 3)); acc[4 * c] += bflo(w.x); acc[4 * c + 1] += bfhi(w.x); acc[4 * c + 2] += bflo(w.y); acc[4 * c + 3] += bfhi(w.y); } }
      const float il = 1.0f / l;
      uint4* dst = (uint4*)(MIX + (rb + (size_t)qb * 256 + row) * D + 512 + h * 64 + half * 32);
#pragma unroll
      for (int c = 0; c < 4; ++c) { uint4 w; w.x = cvtpk(acc[8 * c] * il, acc[8 * c + 1] * il); w.y = cvtpk(acc[8 * c + 2] * il, acc[8 * c + 3] * il); w.z = cvtpk(acc[8 * c + 4] * il, acc[8 * c + 5] * il); w.w = cvtpk(acc[8 * c + 6] * il, acc[8 * c + 7] * il); dst[c] = w; } }
    __syncthreads();
}
__device__ __forceinline__ void memattn_unit(unsigned char* ws, int bh, int qb, int wave, int lane) {
    const bf16* U = (const bf16*)(ws + WS_U); bf16* MIX = (bf16*)(ws + WS_MIX); const float* GT = (const float*)(ws + WS_GAINS);
    const int b = bh >> 2, h = bh & 3, r32 = lane & 31, hi = lane >> 5;
    const size_t row = (size_t)b * SEQ + qb * 256 + wave * 32 + r32;
    const bf16* KFh = (const bf16*)(ws + WS_MEMKF) + (size_t)bh * 8 * 2048;
    const bf16* VFh = (const bf16*)(ws + WS_MEMVF) + (size_t)bh * 8 * 2048;
    f32x16 o0, o1; float ls;
    attn_task(o0, o1, ls, U + row * INW + 1792 + h * 64, KFh, VFh, 8, -GT[193], 0.f, 1 << 20, lane);
    ls += __shfl_xor(ls, 32);
    const float il = 1.0f / ls;
    bf16* dst = MIX + row * D + 768 + h * 64;
#pragma unroll
    for (int q4 = 0; q4 < 4; ++q4) { uint2 w;
        w.x = cvtpk(o0[4 * q4] * il, o0[4 * q4 + 1] * il); w.y = cvtpk(o0[4 * q4 + 2] * il, o0[4 * q4 + 3] * il); *(uint2*)(dst + 8 * q4 + 4 * hi) = w;
        w.x = cvtpk(o1[4 * q4] * il, o1[4 * q4 + 1] * il); w.y = cvtpk(o1[4 * q4 + 2] * il, o1[4 * q4 + 3] * il); *(uint2*)(dst + 32 + 8 * q4 + 4 * hi) = w; }
}
struct Args { const float* in[24]; float* out; unsigned char* ws; int ph_lo, ph_hi; };
__global__ void __launch_bounds__(NWAVES * 64, 2) hymba_fwd(Args args) {
    extern __shared__ __attribute__((aligned(16))) unsigned char lds[];
    LAS unsigned char* L = (LAS unsigned char*)lds;
    volatile LAS unsigned* MISC = (volatile LAS unsigned*)(L + MISC_OFF);
    const int wave = __builtin_amdgcn_readfirstlane(threadIdx.x >> 6);
#define LANE_TID() int lane; asm volatile("v_mbcnt_lo_u32_b32 %0, -1, 0\n\tv_mbcnt_hi_u32_b32 %0, -1, %0" : "=v"(lane)); const int tid = wave * 64 + lane; (void)tid
    const int G = gridDim.x; const int bx = blockIdx.x; const int vcu = (G % 8 == 0) ? (bx % 8) * (G / 8) + bx / 8 : bx;
    unsigned char* const ws0 = args.ws; const float* const* in = args.in; float* out = args.out;
    gu32* ctl = (gu32*)(ws0 + WS_CTL);
    { LANE_TID(); for (int u = tid; u < (LDS_BYTES - LDSCTL_OFF) / 4; u += NWAVES * 64) ((LAS unsigned*)(L + LDSCTL_OFF))[u] = 0u; }
    __syncthreads();
    XcdBarrier bar; bar.bar = (unsigned*)(ctl + CW_BAR); bar.x = 0; bar.st = nullptr; bar.wave = wave;
    if (N_LAUNCHES == 1) bar = xcd_barrier_post((unsigned*)(ctl + CW_BAR), MISC + 8, wave);
#define GRID_BAR() do { if (N_LAUNCHES == 1) xcd_barrier(bar); } while (0)
#ifdef WT_ALL
#define GRID_BAR_NW() do { if (N_LAUNCHES == 1) xcd_barrier(bar, false); } while (0)
#else
#define GRID_BAR_NW() GRID_BAR()
#endif
#ifdef LABEL_BARS
#define LABEL_BAR(sig, e, need) do { if (N_LAUNCHES == 1) { if (G % 8 == 0) label_barrier((unsigned*)ctl, (unsigned*)(ctl + CW_BAR), bx & 7, (unsigned)(G / 8), wave, (sig), (unsigned*)(ctl + LB_EV(e)), (unsigned)(need)); else xcd_barrier(bar); } } while (0)
#else
#define LABEL_BAR(sig, e, need) GRID_BAR()
#endif
    const int lo = args.ph_lo, hi = args.ph_hi;
#ifndef PH_MASK
#define PH_MASK 0x1ff
#endif
#define IN(k) (((PH_MASK >> (k)) & 1) && lo <= (k) && (k) < hi)
#define BOTH(k) (IN(k) && IN((k) + 1))
#ifndef REP_MASK
#define REP_MASK 0
#endif
#define REPS(k) (((REP_MASK >> (k)) & 1) ? 2 : 1)
#ifndef REP_SUB
#define REP_SUB 0
#endif
#define RSUB(k) for (int rs_ = 0; rs_ < (((REP_SUB >> (k)) & 1) ? 2 : 1); ++rs_)
#define WSP() unsigned char* ws = ws0; asm volatile("" : "+s"(ws)); (void)ws
#define XB ((bf16*)(ws + WS_XB))
#define HB ((bf16*)(ws + WS_H))
#define UB ((bf16*)(ws + WS_U))
#define MIX ((bf16*)(ws + WS_MIX))
#define SSQ0 ((float*)(ws + WS_SSQ0))
#define SSQ1 ((float*)(ws + WS_SSQ1))
#define SSQ2 ((float*)(ws + WS_SSQ2))

    for (int rep = 0; rep < REPS(0); ++rep) if (IN(0)) { WSP(); LANE_TID(); p0_prologue(in, ws, L, vcu, G, wave, lane);
        if (bx == 0 && tid < 192) wt_st4f((float*)(ws + WS_GAINS) + tid, (tid < 64 ? in[15][tid] : tid < 128 ? in[16][tid - 64] : in[18][tid - 128]));
        if (bx == 0 && tid < 64) wt_st4f((float*)(ws + WS_GAINS) + 256 + tid, in[19][tid]);
        if (bx == 1) { float* PTB = (float*)(ws + WS_PTAB);
            for (int i = tid; i < 8 * 512; i += 512) { const int row = i >> 9, gc = i & 511; float v;
                if (row < 4) v = in[8][row * 512 + gc]; else if (row == 4) v = in[9][gc]; else if (row == 5) v = -8.0f * 1.4426950408889634f * log1pf(__expf(-in[14][gc])); else if (row == 6) v = 1.4426950408889634f * in[11][gc]; else v = 1.4426950408889634f * in[13][gc];
                wt_st4f(PTB + i, v); } }
        if (bx == 0 && wave == 3) {
            const float mq = wave_max(fabsf(in[15][lane])), mk = wave_max(fabsf(in[16][lane])), cq = wave_max(fabsf(in[18][lane])), ck = wave_max(fabsf(in[19][lane]));
            if (lane == 0) { wt_st4f((float*)(ws + WS_GAINS) + 192, 8.0f * mq * mk * 1.4426950408889634f); wt_st4f((float*)(ws + WS_GAINS) + 193, 8.0f * cq * ck * 1.4426950408889634f); } } if (BOTH(0)) GRID_BAR_NW(); }
    for (int rep = 0; rep < REPS(1); ++rep) if (IN(1)) { WSP();
        pg8::Gemm g{XB, (const bf16*)(ws + WS_W1I), M, 2 * FF, D}; pg8::StaticOrder S; S.init(M, 2 * FF, G, bx);
#ifdef PROBE_NOMMA
        g.nomma = (REPS(1) == 2 && rep == 0) ? 1 : 0;
#endif
        pg8::EpiSwiGLU E{HB, FF, SSQ0};
        pg8::gemm_phase<pg8::EpiSwiGLU, pg8::StaticOrder, PG8_ALIGN, PG8_SP2>(L + RING_OFF, g, S, E, wave);
        bool tail1 = false; int ntail1 = 0;
        { pg8::Unit u6; const int nwg = (M / 256) * (2 * FF / 256), nshort = (nwg % G) ? G - nwg % G : 0;
          if (nshort > 0 && !S.next(nwg / G, u6)) { __syncthreads(); LANE_TID(); memkv_items(ws, L, bx - (G - nshort), nshort, wave, lane);
              p0_weights<1>(in, ws, L, (bx - (G - nshort)) * NWAVES + wave, nshort * NWAVES, wave, lane); tail1 = true; }
          else if (nshort == 0) { __syncthreads(); LANE_TID(); p0_weights<1>(in, ws, L, vcu * NWAVES + wave, G * NWAVES, wave, lane); tail1 = true; }
          ntail1 = nshort > 0 ? nshort : G; }
        if (BOTH(1)) GRID_BAR_NW();
    }
    for (int rep = 0; rep < REPS(2); ++rep) if (IN(2)) { WSP();
        pg8::Gemm g{HB, (const bf16*)(ws + WS_W1O), M, D, FF}; pg8::StaticOrder S; S.init(M, D, G, bx);
        pg8::EpiResid E{XB, XB, nullptr, SSQ1, 0.5f};
        pg8::gemm_phase<pg8::EpiResid, pg8::StaticOrder, false, PG8_SP2>(L + RING_OFF, g, S, E, wave);
        if (BOTH(2)) GRID_BAR_NW();
    }
    for (int rep = 0; rep < REPS(3); ++rep) if (IN(3)) { WSP();
        pg8::Gemm g{XB, (const bf16*)(ws + WS_WIN), M, INW, D}; pg8::StaticOrder S; S.init(M, INW, G, bx);
        pg8::EpiWin E{UB, SSQ1, (const float*)(ws + WS_GAINS)};
        pg8::gemm_phase<pg8::EpiWin, pg8::StaticOrder, PG8_ALIGN, PG8_SP2>(L + RING_OFF, g, S, E, wave);
        if (BOTH(3)) GRID_BAR_NW();
    }
#ifdef EXTRA_BARS
    for (int eb = 0; eb < EXTRA_BARS; ++eb) GRID_BAR();
#endif
    for (int rep = 0; rep < REPS(4); ++rep) if (IN(4)) {
        RSUB(0) { WSP(); LANE_TID(); lru_items<true>(ws, L, G, wave, tid); }
        RSUB(1) { WSP(); LANE_TID(); kvprep_items(ws, L, G, wave, lane, tid); }
        if ((((M / 256) * (2 * FF / 256)) % G) == 0) RSUB(2) { WSP(); LANE_TID(); memkv_items(ws, L, vcu, G, wave, lane); }
        if (BOTH(4)) GRID_BAR_NW();
    }
    for (int rep = 0; rep < REPS(5); ++rep) if (IN(5)) {
#ifndef NO_MOBA
        RSUB(4) { WSP(); LANE_TID(); for (int id = vcu; id < BATCH * 4 * NBLK; id += G) moba_unit(ws, L, id >> 5, id & 31, wave, lane, tid); }
#endif
        if (BOTH(5)) GRID_BAR();
    }
    if (IN(6)) { WSP();
        pg8::Gemm g{MIX, (const bf16*)(ws + WS_WOUT), M, D, D}; pg8::StaticOrder S; S.init(M, D, G, bx);
        pg8::EpiResid E{XB, XB, nullptr, SSQ2, 1.0f};
        pg8::gemm_phase<pg8::EpiResid, pg8::StaticOrder, false, PG8_SP2>(L + RING_OFF, g, S, E, wave);
        if (BOTH(6)) GRID_BAR_NW();
    }
    for (int rep = 0; rep < REPS(7); ++rep) if (IN(7)) { WSP();
        pg8::Gemm g{XB, (const bf16*)(ws + WS_W2I), M, 2 * FF, D}; pg8::StaticOrder S; S.init(M, 2 * FF, G, bx);
#ifdef PROBE_NOMMA
        g.nomma = (REPS(7) == 2 && rep == 0) ? 1 : 0;
#endif
        pg8::EpiSwiGLU E{HB, FF, SSQ2};
        pg8::gemm_phase<pg8::EpiSwiGLU, pg8::StaticOrder, PG8_ALIGN, PG8_SP2>(L + RING_OFF, g, S, E, wave);
        bool tail7 = false; int ntail7 = 0;
        { pg8::Unit u6; const int nwg = (M / 256) * (2 * FF / 256), nshort = (nwg % G) ? G - nwg % G : 0;
          if (rep == 0) { if (nshort > 0 && !S.next(nwg / G, u6)) { __syncthreads(); LANE_TID(); p0_weights<2>(in, ws, L, (bx - (G - nshort)) * NWAVES + wave, nshort * NWAVES, wave, lane); tail7 = true; }
                          else if (nshort == 0) { __syncthreads(); LANE_TID(); p0_weights<2>(in, ws, L, vcu * NWAVES + wave, G * NWAVES, wave, lane); tail7 = true; } }
          ntail7 = nshort > 0 ? nshort : G; }
        if (BOTH(7)) GRID_BAR_NW();
    }
    for (int rep = 0; rep < REPS(8); ++rep) if (IN(8)) { WSP();
        pg8::Gemm g{HB, (const bf16*)(ws + WS_W2O), M, D, FF}; pg8::StaticOrder S; S.init(M, D, G, bx);
        pg8::EpiResid E{XB, nullptr, out, nullptr, 0.5f};
        pg8::gemm_phase<pg8::EpiResid, pg8::StaticOrder, false, PG8_SP2>(L + RING_OFF, g, S, E, wave);
        if (rep + 1 < REPS(8)) GRID_BAR();
    }
#undef IN
#undef BOTH
}

extern "C" void kernel_launch(void* const* d_in, const int* in_sizes, int n_in, void* d_out, int out_size, void* d_ws, size_t ws_size, hipStream_t stream) {
    static int grid = 0;
    if (grid == 0) {
        if (n_in != 24 || in_sizes[0] != M * D || out_size != M * D || ws_size < WS_END) { fprintf(stderr, "kernel_launch: unexpected shapes (n_in %d, in0 %d, out %d, ws %zu); nothing launched\n", n_in, n_in > 0 ? in_sizes[0] : -1, out_size, ws_size); grid = -1; return; }
        int dev = 0, cus = 0, per_cu = 0;
        if (hipGetDevice(&dev) != hipSuccess || hipDeviceGetAttribute(&cus, hipDeviceAttributeMultiprocessorCount, dev) != hipSuccess) { fprintf(stderr, "kernel_launch: device query failed\n"); grid = -1; return; }
        if (hipFuncSetAttribute((const void*)hymba_fwd, hipFuncAttributeMaxDynamicSharedMemorySize, LDS_BYTES) != hipSuccess) { fprintf(stderr, "kernel_launch: hipFuncSetAttribute failed\n"); grid = -1; return; }
        if (hipOccupancyMaxActiveBlocksPerMultiprocessor(&per_cu, (const void*)hymba_fwd, NWAVES * 64, LDS_BYTES) != hipSuccess) per_cu = 0;
        (void)hipGetLastError();
        if (per_cu < 1 || cus * per_cu < 256) { fprintf(stderr, "kernel_launch: the persistent grid of 256 workgroups is not resident (cus %d, per_cu %d); nothing launched\n", cus, per_cu); grid = -1; return; }
        grid = 256;
    }
    if (grid < 0) return;
    if (hipMemsetAsync((char*)d_ws + WS_CTL, 0, CTL_ZERO_BYTES, stream) != hipSuccess) { fprintf(stderr, "kernel_launch: hipMemsetAsync failed\n"); return; }
    Args a{};
    for (int i = 0; i < 24; ++i) a.in[i] = (const float*)d_in[i];
    a.out = (float*)d_out; a.ws = (unsigned char*)d_ws;
    if (N_LAUNCHES == 1) { a.ph_lo = 0; a.ph_hi = NPHASE; hipLaunchKernelGGL(hymba_fwd, dim3(grid), dim3(NWAVES * 64), LDS_BYTES, stream, a); }
    else for (int p = 0; p < NPHASE; ++p) { a.ph_lo = p; a.ph_hi = p + 1; hipLaunchKernelGGL(hymba_fwd, dim3(grid), dim3(NWAVES * 64), LDS_BYTES, stream, a); }
    const hipError_t le = hipPeekAtLastError();
    if (le != hipSuccess) fprintf(stderr, "kernel_launch: launch failed: %s\n", hipGetErrorName(le));
}
```

```cpp
#define PG8_RSLDS true
#define PG8_RESIDLDS true
#define WT_ALL 1
#define XB_EARLY_INV 1
#include <hip/hip_runtime.h>
#include <cstdio>
#include <cstdint>
typedef unsigned wt_v4u __attribute__((ext_vector_type(4)));
typedef float wt_f4 __attribute__((ext_vector_type(4)));
#ifdef WT_ALL
__device__ __forceinline__ void wt_st16(void* p, wt_v4u v) { asm volatile("global_store_dwordx4 %0, %1, off sc1\n\ts_nop 1" :: "v"(p), "v"(v) : "memory"); }
__device__ __forceinline__ void wt_st16f(void* p, wt_f4 v) { asm volatile("global_store_dwordx4 %0, %1, off sc1\n\ts_nop 1" :: "v"(p), "v"(v) : "memory"); }
__device__ __forceinline__ void wt_st8(void* p, unsigned long long v) { __hip_atomic_store((unsigned long long*)p, v, __ATOMIC_RELAXED, __HIP_MEMORY_SCOPE_AGENT); }
__device__ __forceinline__ void wt_st4(void* p, unsigned v) { __hip_atomic_store((unsigned*)p, v, __ATOMIC_RELAXED, __HIP_MEMORY_SCOPE_AGENT); }
__device__ __forceinline__ void wt_st4f(void* p, float v) { __hip_atomic_store((float*)p, v, __ATOMIC_RELAXED, __HIP_MEMORY_SCOPE_AGENT); }
__device__ __forceinline__ void wt_st2(void* p, unsigned v) { asm volatile("global_store_short %0, %1, off sc1" :: "v"(p), "v"(v) : "memory"); }
#else
__device__ __forceinline__ void wt_st16(void* p, wt_v4u v) { *(__attribute__((address_space(1))) wt_v4u*)p = v; }
__device__ __forceinline__ void wt_st16f(void* p, wt_f4 v) { *(__attribute__((address_space(1))) wt_f4*)p = v; }
__device__ __forceinline__ void wt_st8(void* p, unsigned long long v) { *(__attribute__((address_space(1))) unsigned long long*)p = v; }
__device__ __forceinline__ void wt_st4(void* p, unsigned v) { *(__attribute__((address_space(1))) unsigned*)p = v; }
__device__ __forceinline__ void wt_st4f(void* p, float v) { *(__attribute__((address_space(1))) float*)p = v; }
__device__ __forceinline__ void wt_st2(void* p, unsigned v) { *(__attribute__((address_space(1))) unsigned short*)p = (unsigned short)v; }
#endif
#ifndef PG8_BTILED
#define PG8_BTILED 0
#endif
#ifndef PG8_SPLITEPI
#define PG8_SPLITEPI false
#endif
namespace pg8 {
#define PG8_LAS __attribute__((address_space(3)))
typedef unsigned short bf16_t;
typedef short bf16x8 __attribute__((ext_vector_type(8)));
typedef float f32x4 __attribute__((ext_vector_type(4)));
typedef unsigned u32x4 __attribute__((ext_vector_type(4)));
constexpr int BM = 256, BK = 64, HALF = 128, HTB = HALF * BK * 2  , STAGE_BYTES = 8 * HTB, NXCD = 8, WGM = 4;

__host__ __device__ __forceinline__ int lds_byte(int r, int c) { const int st = (r >> 4) * 2 + (c >> 5), rr = r & 15, cc = c & 31, ob = rr * 64 + cc * 2; return st * 1024 + (ob ^ (((ob >> 9) & 1) << 5)); }
__host__ __device__ __forceinline__ void stage_rc(int b, int& R, int& C) { const int st = b / 1024, sb = b % 1024, swz = sb ^ (((sb >> 9) & 1) << 5); R = (st >> 1) * 16 + swz / 64; C = (st & 1) * 32 + (swz % 64) / 2; }
__host__ __device__ __forceinline__ int perm32(int rho) { const int n = rho >> 4, i = rho & 15; return 8 * (i >> 2) + 4 * n + (i & 3); }

struct Unit { int pm, pn, hm; };
struct Gemm { const bf16_t* A; const bf16_t* Bt; int M, N, K; int nomma = 0; };

struct StaticOrder {
    int nM, nN, nwg, G, c;
    __host__ __device__ void init(int M, int N, int G_, int c_) { nM = M / BM; nN = N / BM; nwg = nM * nN; G = G_; c = c_; }
    __host__ __device__ bool map(long L, Unit& u) const {
        if (L >= nwg) return false;
        int wgid = (int)L; { const int q = nwg / NXCD, r = nwg % NXCD, xcd = wgid % NXCD, off = wgid / NXCD; wgid = (xcd < r ? xcd * (q + 1) : r * (q + 1) + (xcd - r) * q) + off; }
        const int nig = WGM * nN, gid = wgid / nig, fm = gid * WGM, gsz = (nM - fm) < WGM ? (nM - fm) : WGM;
        u.pm = fm + ((wgid % nig) % gsz); u.pn = (wgid % nig) / gsz; u.hm = 0; return true;
    }
    __host__ __device__ bool next(int i, Unit& u) const { return map((long)i * G + c, u); }
    __device__ __forceinline__ void a_ready(const Unit&) const {}
    __device__ __forceinline__ void done(const Unit&) const {}
};

__device__ __forceinline__ unsigned cvt_pk_bf16(float lo, float hi) { unsigned r; asm volatile("v_cvt_pk_bf16_f32 %0, %1, %2" : "=v"(r) : "v"(lo), "v"(hi)); return r; }
typedef float f32x2 __attribute__((ext_vector_type(2)));

template <class Epi, class Sched, bool ALIGN_EPI = false, bool SP2 = false>
__device__ __forceinline__ void gemm_phase(PG8_LAS unsigned char* lds, const Gemm g, const Sched& S, const Epi& E, const int wid) {
    int lane; asm volatile("v_mbcnt_lo_u32_b32 %0, -1, 0\n\tv_mbcnt_hi_u32_b32 %0, -1, %0" : "=v"(lane));
    const int tid = wid * 64 + lane, wr = wid >> 2, wc = wid & 3, fr = lane & 15, fq = lane >> 4;
    const int K = g.K, nt = K / BK;
    static_assert(!PG8_BTILED || SP2, "the tiled weight layout is wired into the SP2 loop only");
    unsigned voffA[2], voffB[2];
#pragma unroll
    for (int i = 0; i < 2; ++i) { int R, C; stage_rc(tid * 16 + i * 8192, R, C); const int Rb = Epi::PERM ? ((R & ~31) + perm32(R & 31)) : R;
        voffA[i] = (unsigned)(R * K + C) * 2u; voffB[i] = PG8_BTILED ? (unsigned)(tid * 16 + i * 8192) : (unsigned)(Rb * K + C) * 2u; }
    const size_t kstep = (size_t)(BK * 2);
    const size_t kstepB = PG8_BTILED ? (size_t)(HALF * BK * 2) : kstep;
    const size_t hstep = (size_t)HALF * K * 2;
    const size_t tstep = 2 * hstep;
    const unsigned ldsw = (unsigned)wid * 1024u;
    const int aoff = lds_byte(wr * 64 + fr, fq * 8), boff = lds_byte(wc * 32 + fr, fq * 8);
#define PG8_SA(b, h) (((b) * 2 + (h)) * HTB)
#define PG8_SB(b, h) ((4 + (b) * 2 + (h)) * HTB)
#define PG8_STAGE(bufoff, gbase, voff) do { _Pragma("unroll") for (int _i = 0; _i < 2; ++_i) \
        __builtin_amdgcn_global_load_lds((const unsigned*)((const char*)(gbase) + (voff)[_i]), (PG8_LAS unsigned*)(lds + (bufoff) + ldsw + _i * 8192), 16, 0, 0); } while (0)
#define PG8_LDA(dst, b, h) do { _Pragma("unroll") for (int m = 0; m < 4; ++m) _Pragma("unroll") for (int k = 0; k < 2; ++k) dst[m][k] = *(const PG8_LAS bf16x8*)(lds + PG8_SA(b, h) + aoff + m * 2048 + k * 1024); } while (0)
#define PG8_LDB(dst, b, h) do { _Pragma("unroll") for (int n = 0; n < 2; ++n) _Pragma("unroll") for (int k = 0; k < 2; ++k) dst[n][k] = *(const PG8_LAS bf16x8*)(lds + PG8_SB(b, h) + boff + n * 2048 + k * 1024); } while (0)
#define PG8_MMA(ai, bj, At, Bt) do { PG8_NOMMA_GUARD __builtin_amdgcn_s_setprio(1); _Pragma("unroll") for (int m = 0; m < 4; ++m) _Pragma("unroll") for (int n = 0; n < 2; ++n) _Pragma("unroll") for (int k = 0; k < 2; ++k) \
        { acc[ai][bj][m][n] = __builtin_amdgcn_mfma_f32_16x16x32_bf16(Bt[n][k], At[m][k], acc[ai][bj][m][n], 0, 0, 0); PG8_EXTRA_MFMA(acc[ai][bj][m][n], At[m][k]); } __builtin_amdgcn_s_setprio(0); } while (0)
#ifndef PG8_DMASPLIT
#define PG8_DMASPLIT 0
#endif
#ifdef PROBE_NOMMA
#define PG8_NOMMA_GUARD if (g.nomma) break;
#else
#define PG8_NOMMA_GUARD
#endif
#ifdef PROBE_DOUBLE_MFMA
#define PG8_EXTRA_MFMA(C, A) do { bf16x8 z_ = {0,0,0,0,0,0,0,0}; asm volatile("" : "+v"(z_)); C = __builtin_amdgcn_mfma_f32_16x16x32_bf16(z_, A, C, 0, 0, 0); } while (0)
#else
#define PG8_EXTRA_MFMA(C, A) do {} while (0)
#endif
#define PG8_WAIT_V(n) asm volatile("s_waitcnt vmcnt(" #n ")" ::: "memory")
#define PG8_WAIT_L(n) asm volatile("s_waitcnt lgkmcnt(" #n ")" ::: "memory")
#define PG8_BAR __builtin_amdgcn_s_barrier()
#define PG8_SCHED __builtin_amdgcn_sched_barrier(0)
    Unit cur, nxt; int ui = 0;
    if (!S.next(0, cur)) return;
    f32x4 acc[2][2][4][2];
#pragma unroll
    for (int a = 0; a < 2; ++a)
#pragma unroll
        for (int b = 0; b < 2; ++b)
#pragma unroll
            for (int m = 0; m < 4; ++m)
#pragma unroll
                for (int n = 0; n < 2; ++n) acc[a][b][m][n] = (f32x4){0.f, 0.f, 0.f, 0.f};
    bf16x8 At[4][2], B0[2][2], B1[2][2];
    PG8_LAS float* const RSL = (PG8_LAS float*)(lds + STAGE_BYTES + 2048);
    unsigned voffR[2] = {0u, 0u};
    if constexpr (Epi::RESID_LDS) {
#pragma unroll
        for (int i = 0; i < 2; ++i) voffR[i] = (unsigned)((16 * i + (lane & 15)) * 2048 + (4 * wid + (lane >> 4)) * 16);
    }
    constexpr size_t RSB = (size_t)32 * 2048;
    const char* cA = (const char*)g.A + (size_t)cur.pm * tstep + (cur.hm == 2 ? hstep : (size_t)0); const char* cB = (const char*)g.Bt + (size_t)cur.pn * tstep;
    size_t hsC = cur.hm ? (size_t)0 : hstep;
    S.a_ready(cur);
    if constexpr (SP2) {
        PG8_STAGE(PG8_SB(0, 0), cB, voffB); PG8_STAGE(PG8_SB(0, 1), cB + hstep, voffB); PG8_STAGE(PG8_SA(0, 0), cA, voffA); PG8_STAGE(PG8_SA(0, 1), cA + hsC, voffA);
        if (wr == 1) PG8_BAR;
        PG8_WAIT_V(2); PG8_BAR;
        PG8_STAGE(PG8_SB(1, 0), cB + kstepB, voffB); PG8_STAGE(PG8_SA(1, 0), cA + kstep, voffA); PG8_STAGE(PG8_SB(1, 1), cB + hstep + kstepB, voffB);
        PG8_WAIT_V(6); PG8_BAR;
    } else {
        PG8_STAGE(PG8_SB(0, 0), cB, voffB); PG8_STAGE(PG8_SA(0, 0), cA, voffA); PG8_STAGE(PG8_SB(0, 1), cB + hstep, voffB); PG8_STAGE(PG8_SA(0, 1), cA + hstep, voffA);
        if (wr == 1) PG8_BAR;
        PG8_WAIT_V(4); PG8_BAR;
        PG8_STAGE(PG8_SB(1, 0), cB + kstep, voffB); PG8_STAGE(PG8_SA(1, 0), cA + kstep, voffA); PG8_STAGE(PG8_SB(1, 1), cB + hstep + kstep, voffB);
        PG8_WAIT_V(6); PG8_BAR;
    }
    for (;;) {
        const bool has_next = S.next(ui + 1, nxt);
        const char* nA = has_next ? (const char*)g.A + (size_t)nxt.pm * tstep + (nxt.hm == 2 ? hstep : (size_t)0) : cA; const char* nB = has_next ? (const char*)g.Bt + (size_t)nxt.pn * tstep : cB;
        const size_t hsN = has_next ? (nxt.hm ? (size_t)0 : hstep) : hsC; const bool halfu = cur.hm != 0;
        for (int t = 0; t < nt; t += 2) {
            const bool last = (t == nt - 2); f32x2 rsE;
            const char* a1 = cA + (size_t)(t + 1) * kstep;
            const char* a2 = last ? nA : cA + (size_t)(t + 2) * kstep; const char* b2 = last ? nB : cB + (size_t)(t + 2) * kstepB;
            const char* a3 = a2 + kstep; const char* b3 = b2 + kstepB;
            if (last && has_next) S.a_ready(nxt);
            bool rl = false; const char* rT = cA;
            if constexpr (Epi::RESID_LDS) { rl = last && !has_next; rT = (const char*)E.base + ((size_t)cur.pm * BM * 1024 + (size_t)cur.pn * BM) * 2; }
            const unsigned vA_[2] = {rl ? voffR[0] : voffA[0], rl ? voffR[1] : voffA[1]}, vB_[2] = {rl ? voffR[0] : voffB[0], rl ? voffR[1] : voffB[1]};
            if constexpr (SP2) {
            if constexpr (Epi::RS_LDS) { if (last) { const float* rp_ = E.ssq + ((size_t)(cur.pm * BM + (tid >> 1)) * 4 + (tid & 1) * 2); asm volatile("global_load_dwordx2 %0, %1, off" : "=v"(rsE) : "v"(rp_) : "memory"); } }
            PG8_LDB(B0, 0, 0); PG8_LDB(B1, 0, 1); PG8_SCHED; PG8_LDA(At, 0, 0); PG8_STAGE(PG8_SA(1, 1), a1 + hsC, voffA);
            PG8_WAIT_V(8); PG8_WAIT_L(0); PG8_BAR; PG8_MMA(0, 0, At, B0); PG8_MMA(0, 1, At, B1); PG8_BAR; PG8_SCHED;
#if PG8_DMASPLIT == 0
            if (!halfu) PG8_LDA(At, 0, 1); PG8_STAGE(PG8_SB(0, 0), rl ? rT + 4 * RSB : b2, vB_); PG8_STAGE(PG8_SB(0, 1), rl ? rT + 5 * RSB : b2 + hstep, vB_); PG8_STAGE(PG8_SA(0, 0), rl ? rT : a2, vA_);
            PG8_WAIT_V(8); PG8_WAIT_L(0); PG8_BAR; if (!halfu) { PG8_MMA(1, 0, At, B0); PG8_MMA(1, 1, At, B1); } PG8_BAR; PG8_SCHED;
#elif PG8_DMASPLIT == 1
            if (!halfu) PG8_LDA(At, 0, 1); PG8_STAGE(PG8_SB(0, 0), rl ? rT + 4 * RSB : b2, vB_); PG8_STAGE(PG8_SB(0, 1), rl ? rT + 5 * RSB : b2 + hstep, vB_);
            PG8_WAIT_V(6); PG8_WAIT_L(0); PG8_BAR; if (!halfu) PG8_MMA(1, 0, At, B0); PG8_SCHED; PG8_STAGE(PG8_SA(0, 0), rl ? rT : a2, vA_); PG8_SCHED; if (!halfu) PG8_MMA(1, 1, At, B1); PG8_BAR; PG8_SCHED;
#else
            if (!halfu) PG8_LDA(At, 0, 1); PG8_STAGE(PG8_SB(0, 0), rl ? rT + 4 * RSB : b2, vB_);
            PG8_WAIT_V(4); PG8_WAIT_L(0); PG8_BAR; if (!halfu) PG8_MMA(1, 0, At, B0); PG8_SCHED; PG8_STAGE(PG8_SB(0, 1), rl ? rT + 5 * RSB : b2 + hstep, vB_); PG8_STAGE(PG8_SA(0, 0), rl ? rT : a2, vA_); PG8_SCHED; if (!halfu) PG8_MMA(1, 1, At, B1); PG8_BAR; PG8_SCHED;
#endif
            if constexpr (Epi::RS_LDS) { if (last) { asm volatile("" : "+v"(rsE)); float s_ = rsE[0] + rsE[1]; s_ += __shfl_xor(s_, 1); RSL[tid >> 1] = __builtin_amdgcn_rsqf(s_ * (1.0f / 1024.0f) + 1e-6f); } }
            PG8_LDB(B0, 1, 0); PG8_LDB(B1, 1, 1); PG8_SCHED; PG8_LDA(At, 1, 0); PG8_STAGE(PG8_SA(0, 1), rl ? rT + RSB : a2 + (last ? hsN : hsC), vA_);
            PG8_WAIT_V(8); PG8_WAIT_L(0); PG8_BAR; PG8_MMA(0, 0, At, B0); PG8_MMA(0, 1, At, B1); PG8_BAR; PG8_SCHED;
#if PG8_DMASPLIT == 0
            if (!halfu) PG8_LDA(At, 1, 1); PG8_STAGE(PG8_SB(1, 0), rl ? rT + 6 * RSB : b3, vB_); PG8_STAGE(PG8_SB(1, 1), rl ? rT + 7 * RSB : b3 + hstep, vB_); PG8_STAGE(PG8_SA(1, 0), rl ? rT + 2 * RSB : a3, vA_);
            PG8_WAIT_V(8); PG8_WAIT_L(0);
            if constexpr (PG8_SPLITEPI && !Epi::AFTER_DRAIN) { if (last) { PG8_SCHED; E.template operator()<0, 1>(acc, cur, wr, wc, fr, fq, RSL); PG8_SCHED; } }
            PG8_BAR; if (!halfu) { PG8_MMA(1, 0, At, B0); PG8_MMA(1, 1, At, B1); } PG8_BAR; PG8_SCHED;
#elif PG8_DMASPLIT == 1
            if (!halfu) PG8_LDA(At, 1, 1); PG8_STAGE(PG8_SB(1, 0), rl ? rT + 6 * RSB : b3, vB_); PG8_STAGE(PG8_SB(1, 1), rl ? rT + 7 * RSB : b3 + hstep, vB_);
            PG8_WAIT_V(6); PG8_WAIT_L(0); PG8_BAR; if (!halfu) PG8_MMA(1, 0, At, B0); PG8_SCHED; PG8_STAGE(PG8_SA(1, 0), rl ? rT + 2 * RSB : a3, vA_); PG8_SCHED; if (!halfu) PG8_MMA(1, 1, At, B1); PG8_BAR; PG8_SCHED;
#else
            if (!halfu) PG8_LDA(At, 1, 1); PG8_STAGE(PG8_SB(1, 0), rl ? rT + 6 * RSB : b3, vB_);
            PG8_WAIT_V(4); PG8_WAIT_L(0); PG8_BAR; if (!halfu) PG8_MMA(1, 0, At, B0); PG8_SCHED; PG8_STAGE(PG8_SB(1, 1), rl ? rT + 7 * RSB : b3 + hstep, vB_); PG8_STAGE(PG8_SA(1, 0), rl ? rT + 2 * RSB : a3, vA_); PG8_SCHED; if (!halfu) PG8_MMA(1, 1, At, B1); PG8_BAR; PG8_SCHED;
#endif
            } else {
            PG8_LDB(B0, 0, 0); PG8_SCHED; PG8_LDA(At, 0, 0); PG8_STAGE(PG8_SA(1, 1), a1 + hstep, voffA);
            PG8_WAIT_L(8); PG8_BAR; PG8_WAIT_L(0); PG8_MMA(0, 0, At, B0); PG8_BAR; PG8_SCHED;
            PG8_LDB(B1, 0, 1); PG8_STAGE(PG8_SB(0, 0), b2, voffB);
            PG8_BAR; PG8_WAIT_L(0); PG8_MMA(0, 1, At, B1); PG8_BAR;
            PG8_LDA(At, 0, 1); PG8_STAGE(PG8_SA(0, 0), a2, voffA);
            PG8_BAR; PG8_WAIT_L(0); PG8_MMA(1, 0, At, B0); PG8_BAR; PG8_SCHED;
            PG8_STAGE(PG8_SB(0, 1), b2 + hstep, voffB);
            PG8_WAIT_V(6); PG8_BAR; PG8_MMA(1, 1, At, B1); PG8_BAR;
            PG8_LDB(B0, 1, 0); PG8_SCHED; PG8_LDA(At, 1, 0); PG8_STAGE(PG8_SA(0, 1), a2 + hstep, voffA);
            PG8_WAIT_L(8); PG8_BAR; PG8_WAIT_L(0); PG8_MMA(0, 0, At, B0); PG8_BAR; PG8_SCHED;
            PG8_LDB(B1, 1, 1); PG8_STAGE(PG8_SB(1, 0), b3, voffB);
            PG8_BAR; PG8_WAIT_L(0); PG8_MMA(0, 1, At, B1); PG8_BAR;
            PG8_LDA(At, 1, 1); PG8_STAGE(PG8_SA(1, 0), a3, voffA);
            PG8_BAR; PG8_WAIT_L(0); PG8_MMA(1, 0, At, B0); PG8_BAR; PG8_SCHED;
            PG8_STAGE(PG8_SB(1, 1), b3 + hstep, voffB);
            PG8_WAIT_V(6); PG8_BAR; PG8_MMA(1, 1, At, B1); PG8_BAR;
            }
        }
        if constexpr (ALIGN_EPI) { if (wr == 0) PG8_BAR; }
        if constexpr (!Epi::AFTER_DRAIN) { if constexpr (PG8_SPLITEPI) E.template operator()<1, 2>(acc, cur, wr, wc, fr, fq, RSL); else E(acc, cur, wr, wc, fr, fq, RSL);
#ifdef PROBE_EPI2
            asm volatile("" ::: "memory"); E(acc, cur, wr, wc, fr, fq, RSL);
#endif
            S.done(cur); }
        if (!has_next) break;
#pragma unroll
        for (int a = 0; a < 2; ++a)
#pragma unroll
            for (int b = 0; b < 2; ++b)
#pragma unroll
                for (int m = 0; m < 4; ++m)
#pragma unroll
                    for (int n = 0; n < 2; ++n) acc[a][b][m][n] = (f32x4){0.f, 0.f, 0.f, 0.f};
        cur = nxt; cA = nA; cB = nB; hsC = hsN; ++ui;
        if constexpr (ALIGN_EPI) { if (wr == 1) PG8_BAR; }
    }
    PG8_WAIT_V(0);
    if constexpr (!ALIGN_EPI) { if (wr == 0) PG8_BAR; }
    PG8_BAR;
    if constexpr (Epi::AFTER_DRAIN) { E.fused(acc, cur, wr, wc, fr, fq, lds, wid, lane); S.done(cur); }
#undef PG8_SA
#undef PG8_SB
#undef PG8_STAGE
#undef PG8_LDA
#undef PG8_LDB
#undef PG8_MMA
#undef PG8_WAIT_V
#undef PG8_WAIT_L
#undef PG8_BAR
#undef PG8_SCHED
}
}
namespace pg8 {
#ifndef PG8_RSLDS
#define PG8_RSLDS false
#endif
#ifndef PG8_RESIDLDS
#define PG8_RESIDLDS false
#endif
constexpr float NORM_EPS_F = 1e-6f;
__device__ __forceinline__ float row_rs(const float* ssq4, int row) {
    const f32x4 s = *(const __attribute__((address_space(1))) f32x4*)(ssq4 + (size_t)row * 4);
    return __builtin_amdgcn_rsqf(((s[0] + s[1]) + (s[2] + s[3])) * (1.0f / 1024.0f) + NORM_EPS_F);
}
__device__ __forceinline__ float silu_mul(float a, float b) { return a * __builtin_amdgcn_rcpf(1.0f + __expf(-a)) * b; }
struct TailHalfOrder : StaticOrder {
    __host__ __device__ bool next(int i, Unit& u) const {
        const int rem = nwg % G, nfull = nwg / G;
        if (rem == 0 || 2 * rem != G || (G % 16) != 0 || (nwg % NXCD) != 0) return StaticOrder::next(i, u);
        if (i < nfull) return StaticOrder::next(i, u);
        if (i > nfull) return false;
        const int x = c % NXCD, q = c / NXCD;
        if (!map((long)nfull * G + x + NXCD * (q >> 1), u)) return false;
        u.hm = 1 + (q & 1); return true;
    }
};
struct EpiSwiGLU {
    static constexpr bool PERM = true, AFTER_DRAIN = false, RS_LDS = PG8_RSLDS, RESID_LDS = false;
    bf16_t* H; int ldh; const float* ssq;
    static __device__ __forceinline__ f32x4 swiglu4(f32x4 a, f32x4 b, float rs) {
        const f32x4 t = a * rs, u = t * (-1.4426950408889634f);
        f32x4 e; e[0] = __builtin_amdgcn_exp2f(u[0]); e[1] = __builtin_amdgcn_exp2f(u[1]); e[2] = __builtin_amdgcn_exp2f(u[2]); e[3] = __builtin_amdgcn_exp2f(u[3]);
        const f32x4 d = e + 1.0f;
        f32x4 s; s[0] = __builtin_amdgcn_rcpf(d[0]); s[1] = __builtin_amdgcn_rcpf(d[1]); s[2] = __builtin_amdgcn_rcpf(d[2]); s[3] = __builtin_amdgcn_rcpf(d[3]);
        return (t * s) * (b * rs);
    }
    template <int AI_LO = 0, int AI_HI = 2>
    __device__ __forceinline__ void operator()(const f32x4 (&acc)[2][2][4][2], const Unit& u, int wr, int wc, int fr, int fq, const PG8_LAS float* rsl) const {
        const int row0 = u.pm * BM + wr * 64 + fr + (u.hm == 2 ? HALF : 0), col0 = u.pn * HALF + wc * 32 + 8 * fq;
        float rsv[2][4];
#pragma unroll
        for (int ai = AI_LO; ai < AI_HI; ++ai)
#pragma unroll
            for (int m = 0; m < 4; ++m) rsv[ai][m] = RS_LDS ? rsl[wr * 64 + fr + ai * HALF + m * 16] : row_rs(ssq, row0 + ai * HALF + m * 16);
#pragma unroll
        for (int ai = AI_LO; ai < AI_HI; ++ai) if (ai == 0 || u.hm == 0)
#pragma unroll
            for (int m = 0; m < 4; ++m) { const int row = row0 + ai * HALF + m * 16; const float rs = rsv[ai][m];
                const f32x4 h0 = swiglu4(acc[ai][0][m][0], acc[ai][1][m][0], rs), h1 = swiglu4(acc[ai][0][m][1], acc[ai][1][m][1], rs);
                u32x4 w; w.x = cvt_pk_bf16(h0[0], h0[1]); w.y = cvt_pk_bf16(h0[2], h0[3]); w.z = cvt_pk_bf16(h1[0], h1[1]); w.w = cvt_pk_bf16(h1[2], h1[3]);
                wt_st16(H + (size_t)row * ldh + col0, w); }
    }
};
__device__ __forceinline__ float bflo_(unsigned w) { return __uint_as_float(w << 16); }
__device__ __forceinline__ float bfhi_(unsigned w) { return __uint_as_float(w & 0xffff0000u); }
struct EpiResid {
    static constexpr bool PERM = true, AFTER_DRAIN = true, RS_LDS = false, RESID_LDS = PG8_RESIDLDS;
    const bf16_t* base; bf16_t* ob; float* outf; float* ssq_out; float alpha;
    __device__ __forceinline__ void fused(f32x4 (&acc)[2][2][4][2], const Unit& u, int wr, int wc, int fr, int fq, PG8_LAS unsigned char* lds, int wid, int lane) const {
        PG8_LAS float* P = (PG8_LAS float*)(lds + (RESID_LDS ? STAGE_BYTES + 4096 : 0));
        const int col0 = u.pn * BM + wc * 32 + 8 * fq;
        u32x4 bw[2][4][2];
        if constexpr (RESID_LDS) {
            if (wr == 1) {
#pragma unroll
                for (int m = 2; m < 4; ++m) { const size_t off = (size_t)(u.pm * BM + wr * 64 + m * 16 + fr) * 1024 + col0;
#pragma unroll
                    for (int bj = 0; bj < 2; ++bj) bw[0][m][bj] = *(const __attribute__((address_space(1))) u32x4*)(base + off + bj * HALF); } }
#pragma unroll
            for (int ai = 0; ai < 2; ++ai)
#pragma unroll
                for (int m = 0; m < 4; ++m) { const int s = ai * 4 + wr * 2 + (m >> 1);
                    if (!(ai == 0 && m >= 2 && wr == 1)) {
#pragma unroll
                        for (int bj = 0; bj < 2; ++bj) bw[ai][m][bj] = *(const PG8_LAS u32x4*)(lds + s * 16384 + (m & 1) * 8192 + (bj * 4 + wc) * 1024 + lane * 16); } }
        } else {
#pragma unroll
        for (int ai = 0; ai < 2; ++ai)
#pragma unroll
            for (int m = 0; m < 4; ++m) { const size_t off = (size_t)(u.pm * BM + ai * HALF + wr * 64 + m * 16 + fr) * 1024 + col0;
#pragma unroll
                for (int bj = 0; bj < 2; ++bj) bw[ai][m][bj] = *(const __attribute__((address_space(1))) u32x4*)(base + off + bj * HALF); }
        }
#pragma unroll
        for (int ai = 0; ai < 2; ++ai)
#pragma unroll
            for (int m = 0; m < 4; ++m) { const int r = ai * HALF + wr * 64 + m * 16 + fr; const size_t off = (size_t)(u.pm * BM + r) * 1024 + col0; float q = 0.f;
#pragma unroll
                for (int bj = 0; bj < 2; ++bj) { const u32x4 w = bw[ai][m][bj];
                    const f32x4 b0 = (f32x4){bflo_(w.x), bfhi_(w.x), bflo_(w.y), bfhi_(w.y)}, b1 = (f32x4){bflo_(w.z), bfhi_(w.z), bflo_(w.w), bfhi_(w.w)};
                    const f32x4 o0 = b0 + acc[ai][bj][m][0] * alpha, o1 = b1 + acc[ai][bj][m][1] * alpha;
                    q += ((o0[0] * o0[0] + o0[1] * o0[1]) + (o0[2] * o0[2] + o0[3] * o0[3])) + ((o1[0] * o1[0] + o1[1] * o1[1]) + (o1[2] * o1[2] + o1[3] * o1[3]));
                    if (ob) { u32x4 v; v.x = cvt_pk_bf16(o0[0], o0[1]); v.y = cvt_pk_bf16(o0[2], o0[3]); v.z = cvt_pk_bf16(o1[0], o1[1]); v.w = cvt_pk_bf16(o1[2], o1[3]); wt_st16(ob + off + bj * HALF, v); }
                    if (outf) { *(__attribute__((address_space(1))) f32x4*)(outf + off + bj * HALF) = o0; *(__attribute__((address_space(1))) f32x4*)(outf + off + bj * HALF + 4) = o1; } }
                q += __shfl_xor(q, 16); q += __shfl_xor(q, 32);
                if (fq == 0) P[r * 4 + wc] = q; }
        asm volatile("s_waitcnt lgkmcnt(0)" ::: "memory"); __builtin_amdgcn_s_barrier(); asm volatile("" ::: "memory");
        if (ssq_out) { const int t = wid * 64 + lane; if (t < 256) { const PG8_LAS f32x4* P4 = (const PG8_LAS f32x4*)P; const f32x4 p = P4[t]; wt_st4f(ssq_out + (size_t)(u.pm * BM + t) * 4 + u.pn, (p[0] + p[1]) + (p[2] + p[3])); } }
    }
};
struct EpiWin {
    static constexpr bool PERM = true, AFTER_DRAIN = false, RS_LDS = PG8_RSLDS, RESID_LDS = false;
    bf16_t* U; const float* ssq; const float* gains;
    template <int AI_LO = 0, int AI_HI = 2>
    __device__ __forceinline__ void operator()(const f32x4 (&acc)[2][2][4][2], const Unit& u, int wr, int wc, int fr, int fq, const PG8_LAS float* rsl) const {
        const int row0 = u.pm * BM + wr * 64 + fr, colL = u.pn * BM + wc * 64 + 8 * fq;
        const bool nrm = (u.pn == 4) || (u.pn == 5) || (u.pn == 7);
        const float* g = gains + ((u.pn == 4) ? 0 : (u.pn == 5) ? 64 : 128);
        f32x4 gv[2][2];
#pragma unroll
        for (int bj = 0; bj < 2; ++bj)
#pragma unroll
            for (int n = 0; n < 2; ++n) gv[bj][n] = nrm ? *(const __attribute__((address_space(1))) f32x4*)(g + 32 * bj + 8 * fq + 4 * n) : (f32x4){1.f, 1.f, 1.f, 1.f};
        float rsv[2][4];
#pragma unroll
        for (int ai = AI_LO; ai < AI_HI; ++ai)
#pragma unroll
            for (int m = 0; m < 4; ++m) rsv[ai][m] = RS_LDS ? rsl[wr * 64 + fr + ai * HALF + m * 16] : row_rs(ssq, row0 + ai * HALF + m * 16);
#pragma unroll
        for (int ai = AI_LO; ai < AI_HI; ++ai)
#pragma unroll
            for (int m = 0; m < 4; ++m) { const int row = row0 + ai * HALF + m * 16; const float rs = rsv[ai][m];
                f32x4 v[2][2]; float ss = 0.f;
#pragma unroll
                for (int bj = 0; bj < 2; ++bj)
#pragma unroll
                    for (int n = 0; n < 2; ++n) { v[bj][n] = acc[ai][bj][m][n] * rs; ss += (v[bj][n][0] * v[bj][n][0] + v[bj][n][1] * v[bj][n][1]) + (v[bj][n][2] * v[bj][n][2] + v[bj][n][3] * v[bj][n][3]); }
                ss += __shfl_xor(ss, 16); ss += __shfl_xor(ss, 32);
                const float rn = nrm ? __builtin_amdgcn_rsqf(ss * (1.0f / 64.0f) + NORM_EPS_F) * ((u.pn == 5) ? 1.0f : 0.18033688011112042f) : 1.0f;
#pragma unroll
                for (int bj = 0; bj < 2; ++bj) { const f32x4 x0 = v[bj][0] * rn * gv[bj][0], x1 = v[bj][1] * rn * gv[bj][1];
                    u32x4 w; w.x = cvt_pk_bf16(x0[0], x0[1]); w.y = cvt_pk_bf16(x0[2], x0[3]); w.z = cvt_pk_bf16(x1[0], x1[1]); w.w = cvt_pk_bf16(x1[2], x1[3]);
                    wt_st16(U + (size_t)row * 2048 + colL + 32 * bj, w); } }
    }
};
}
#ifndef PG8_SP2
#define PG8_SP2 true
#endif
#ifndef PG8_ALIGN
#define PG8_ALIGN true
#endif
#ifndef MK_N_LAUNCHES
#define MK_N_LAUNCHES 1
#endif
constexpr int NWAVES = 8;
constexpr int NPHASE = 9;
constexpr int N_LAUNCHES = MK_N_LAUNCHES;

constexpr int BATCH = 2, SEQ = 8192, D = 1024, FF = 2816, M = BATCH * SEQ;
constexpr int MEMLEN = 256, HD = 64, LRUW = 512, INW = 2048, NBLK = SEQ / 256;
constexpr float EPS = 1e-6f;

constexpr size_t MiB = 1u << 20;
constexpr size_t WS_CTL = 0, CTL_ZERO_BYTES = 64 * 1024;
constexpr size_t WS_SSQ0 = 1 * MiB, WS_SSQ1 = WS_SSQ0 + 256 * 1024, WS_SSQ2 = WS_SSQ1 + 256 * 1024;
constexpr size_t WS_KMEAN = 2 * MiB;
constexpr size_t WS_AGGA = WS_KMEAN + 64 * 1024;
constexpr size_t WS_AGGH = WS_AGGA + 128 * 1024;
constexpr size_t WS_GAINS = WS_AGGH + 128 * 1024;
constexpr size_t WS_PTAB = WS_GAINS + 4096;
constexpr size_t WS_MEMB = 3 * MiB;
constexpr size_t WS_MEMKF = 4 * MiB, WS_MEMVF = WS_MEMKF + 256 * 1024;
constexpr size_t WS_GR = 5 * MiB;
constexpr size_t WS_W1I = 8 * MiB, WS_W1O = 19 * MiB, WS_WIN = 25 * MiB, WS_WOUT = 29 * MiB, WS_WMKV = 31 * MiB, WS_W2I = 32 * MiB, WS_W2O = 43 * MiB;
constexpr size_t WS_WG = 49 * MiB;
constexpr size_t WS_XB = 50 * MiB;
constexpr size_t WS_MIX = 82 * MiB;
constexpr size_t WS_H = 114 * MiB;
constexpr size_t WS_U = WS_H;
constexpr size_t WS_KF = 202 * MiB, WS_VF = 210 * MiB;
constexpr size_t WS_PART2 = 218 * MiB;
constexpr size_t WS_END = 256 * MiB;
static_assert(WS_H + (size_t)M * FF * 2 <= WS_END, "d_ws map");
constexpr int CW_BAR = 1024;

constexpr int RING_OFF = 0, RING_BYTES = 131072;
constexpr int LDSCTL_OFF = RING_BYTES, MISC_OFF = LDSCTL_OFF + 320;
constexpr int LDS_BYTES = 163840;

#define GAS __attribute__((address_space(1)))
#define LAS __attribute__((address_space(3)))
typedef unsigned short bf16;
typedef unsigned v4u __attribute__((ext_vector_type(4)));
typedef float f32x4 __attribute__((ext_vector_type(4)));
typedef short bf16x8 __attribute__((ext_vector_type(8)));
typedef GAS unsigned gu32;
typedef GAS unsigned long long gu64;
#define RLX_AGENT __ATOMIC_RELAXED, __HIP_MEMORY_SCOPE_AGENT
#define LDS_WAIT() asm volatile("s_waitcnt lgkmcnt(0)" ::: "memory")
#define VM_WAIT() asm volatile("s_waitcnt vmcnt(0)" ::: "memory")
__device__ __forceinline__ unsigned long long rt() { return __builtin_amdgcn_s_memrealtime(); }
__device__ __forceinline__ unsigned f2bf(float f) { unsigned u = __builtin_bit_cast(unsigned, f); return (u + 0x7fffu + ((u >> 16) & 1u)) >> 16; }
__device__ __forceinline__ unsigned pk2(float lo, float hi) { return f2bf(lo) | (f2bf(hi) << 16); }

#define XB_TMO      128
#define XB_XCNT(j)  (256  + 64 * (j))
#define XB_XSUB(j)  (1280 + 64 * (j))
#define XB_XGEN(j)  (2304 + 64 * (j))
#define XB_TOP      3328
#define XB_TOPGEN   3392
#define XCD_BAR_WORDS 3456
#define XB_SPIN_CAP (1u << 18)

__device__ __forceinline__ unsigned xb_ld(unsigned* p)              { return __hip_atomic_load(p, __ATOMIC_RELAXED, __HIP_MEMORY_SCOPE_AGENT); }
__device__ __forceinline__ unsigned xb_add(unsigned* p, unsigned v) { return __hip_atomic_fetch_add(p, v, __ATOMIC_RELAXED, __HIP_MEMORY_SCOPE_AGENT); }
__device__ __forceinline__ unsigned xb_xcc_id() { return (unsigned)__builtin_amdgcn_s_getreg((3 << 11) | 20) & 0xFu; }
#define XB_SPIN(cond, bar) do { unsigned _sp = 0; while (cond) { __builtin_amdgcn_s_sleep(1); \
    if ((++_sp & 255u) == 0u) { if (xb_ld(&(bar)[XB_TMO])) break; if (_sp > XB_SPIN_CAP) { atomicAdd(&(bar)[XB_TMO], 1u); break; } } } } while (0)

struct XcdBarrier {
    unsigned* bar; unsigned x;
    volatile LAS unsigned* st;
    int wave;
};
__device__ __forceinline__ bool xb_thread0(int wave) { int ln; asm volatile("v_mbcnt_lo_u32_b32 %0, -1, 0\n\tv_mbcnt_hi_u32_b32 %0, -1, %0" : "=v"(ln)); return wave == 0 && ln == 0; }

__device__ __forceinline__ XcdBarrier xcd_barrier_post(unsigned* bar, volatile LAS unsigned* st, int wave) {
    XcdBarrier b; b.bar = bar; b.x = xb_xcc_id(); b.st = st; b.wave = wave;
    if (xb_thread0(wave)) (void)xb_add(&bar[XB_XCNT(b.x)], 1u);
    return b;
}
__device__ __forceinline__ void xcd_barrier_complete(unsigned* bar, unsigned x, unsigned& nloc, unsigned& nx) {
    const unsigned G = gridDim.x * gridDim.y * gridDim.z;
    unsigned sum, cnt, mine, sp = 0u;
    for (;;) {
        sum = 0u; cnt = 0u; mine = 0u;
#pragma unroll
        for (unsigned j = 0; j < 16; ++j) { const unsigned c = xb_ld(&bar[XB_XCNT(j)]); sum += c; cnt += (c > 0u) ? 1u : 0u; mine = (j == x) ? c : mine; }
        if (sum == G) break;
        __builtin_amdgcn_s_sleep(1);
        if ((++sp & 255u) == 0u) { if (xb_ld(&bar[XB_TMO])) break; if (sp > XB_SPIN_CAP) { atomicAdd(&bar[XB_TMO], 1u); break; } }
    }
    nloc = mine > 0u ? mine : 1u; nx = cnt > 0u ? cnt : 1u;
}

__device__ __forceinline__ void xcd_barrier(const XcdBarrier& b, const bool writeback = true) {
    asm volatile("s_waitcnt vmcnt(0)" ::: "memory");
    __syncthreads();
    if (xb_thread0(b.wave)) {
        unsigned* bar = b.bar;
        __builtin_amdgcn_s_waitcnt(0);
        unsigned nloc = b.st[0], nx = b.st[1];
        if (nloc == 0u) { xcd_barrier_complete(bar, b.x, nloc, nx); b.st[0] = nloc; b.st[1] = nx; }
        const unsigned old = xb_add(&bar[XB_XSUB(b.x)], 1u);
        const unsigned gen = old / nloc;
        if (old + 1u == (gen + 1u) * nloc) {
            if (writeback) __builtin_amdgcn_fence(__ATOMIC_RELEASE, "agent");
            asm volatile("s_waitcnt vmcnt(0)" ::: "memory");
            const unsigned og = xb_add(&bar[XB_TOP], 1u);
            const unsigned tg = og / nx;
#ifdef XB_EARLY_INV
            __builtin_amdgcn_fence(__ATOMIC_ACQUIRE, "agent");
            if (og + 1u == (tg + 1u) * nx) xb_add(&bar[XB_TOPGEN], 1u);
            else XB_SPIN(xb_ld(&bar[XB_TOPGEN]) == tg, bar);
#else
            if (og + 1u == (tg + 1u) * nx) xb_add(&bar[XB_TOPGEN], 1u);
            else XB_SPIN(xb_ld(&bar[XB_TOPGEN]) == tg, bar);
            __builtin_amdgcn_fence(__ATOMIC_ACQUIRE, "agent");
#endif
#ifndef XB_DIRECT
            xb_add(&bar[XB_XGEN(b.x)], 1u);
#endif
            asm volatile("s_waitcnt vmcnt(0)" ::: "memory");
        } else {
#ifdef XB_EARLY_INV
            __builtin_amdgcn_fence(__ATOMIC_ACQUIRE, "agent");
            XB_SPIN(xb_ld(&bar[XB_XGEN(b.x)]) == gen, bar);
#elif defined(XB_DIRECT)
            XB_SPIN(xb_ld(&bar[XB_TOPGEN]) == gen, bar);
            __builtin_amdgcn_fence(__ATOMIC_ACQUIRE, "agent");
#else
            XB_SPIN(xb_ld(&bar[XB_XGEN(b.x)]) == gen, bar);
            __builtin_amdgcn_fence(__ATOMIC_ACQUIRE, "agent");
#endif
            asm volatile("s_waitcnt vmcnt(0)" ::: "memory");
        }
    }
    __syncthreads();
}

#define LB_CNT(l)  (8192 + 64 * (l))
#define LB_EV(e)   (8192 + 64 * (8 + (e)))
__device__ __forceinline__ void label_barrier(unsigned* ctl, unsigned* bar, int label, unsigned members, int wave, bool ev_sig, unsigned* ev, unsigned ev_need) {
    asm volatile("s_waitcnt vmcnt(0)" ::: "memory");
    __syncthreads();
    if (xb_thread0(wave)) {
        __builtin_amdgcn_s_waitcnt(0);
        unsigned* cnt = ctl + LB_CNT(label);
        __builtin_amdgcn_fence(__ATOMIC_RELEASE, "agent");
        asm volatile("s_waitcnt vmcnt(0)" ::: "memory");
        if (ev_sig) (void)xb_add(ev, 1u);
        const unsigned old = xb_add(cnt, 1u);
        const unsigned target = (old / members + 1u) * members;
        XB_SPIN(xb_ld(cnt) < target, bar);
        if (ev_need) XB_SPIN(xb_ld(ev) < ev_need, bar);
        __builtin_amdgcn_fence(__ATOMIC_ACQUIRE, "agent");
        asm volatile("s_waitcnt vmcnt(0)" ::: "memory");
    }
    __syncthreads();
}
__device__ __forceinline__ float bf2f(unsigned short h) { return __uint_as_float((unsigned)h << 16); }
__device__ __forceinline__ float bflo(unsigned w) { return __uint_as_float(w << 16); }
__device__ __forceinline__ float bfhi(unsigned w) { return __uint_as_float(w & 0xffff0000u); }
__device__ __forceinline__ float wave_sum(float v) {
#pragma unroll
    for (int o = 1; o < 64; o <<= 1) v += __shfl_xor(v, o);
    return v;
}
__device__ __forceinline__ float wave_max(float v) {
#pragma unroll
    for (int o = 1; o < 64; o <<= 1) v = fmaxf(v, __shfl_xor(v, o));
    return v;
}
__device__ __forceinline__ float sigmoidf_(float x) { return 1.0f / (1.0f + __expf(-x)); }
__device__ __forceinline__ float gelu_tanh(float x) { const float u = x * __builtin_fmaf(x * x, 0.10294324f, 2.3022082f); return x * __builtin_amdgcn_rcpf(1.0f + __builtin_amdgcn_exp2f(-u)); }
template <int CTRL, int ROWMASK> __device__ __forceinline__ float dppf(float old, float src) { return __builtin_bit_cast(float, __builtin_amdgcn_update_dpp(__builtin_bit_cast(int, old), __builtin_bit_cast(int, src), CTRL, ROWMASK, 0xF, false)); }

__device__ __forceinline__ int kperm16(int o) { return 8 * ((o >> 2) & 1) + 4 * (o >> 3) + (o & 3); }
__device__ __forceinline__ void p0_transpose_item(const float* W, int K, int N, const float* gain, bf16* WT, int dest_row0, LAS float* scr, int k0, int n0, int lane) {
#pragma unroll
    for (int i = 0; i < 32; ++i) { const int kk = 2 * i + (lane >> 5); const float g = gain ? gain[k0 + kk] : 1.0f; scr[kk * 33 + (lane & 31)] = W[(size_t)(k0 + kk) * N + n0 + (lane & 31)] * g; }
    LDS_WAIT(); asm volatile("" ::: "memory");
    const int c = lane & 7;
#pragma unroll
    for (int j = 0; j < 4; ++j) { const int n = (lane >> 3) + 8 * j; const LAS float* s = scr + (8 * c) * 33 + n;
        v4u o; o.x = pk2(s[0 * 33], s[1 * 33]); o.y = pk2(s[2 * 33], s[3 * 33]); o.z = pk2(s[4 * 33], s[5 * 33]); o.w = pk2(s[6 * 33], s[7 * 33]);
        *(GAS v4u*)(WT + (size_t)(dest_row0 + n) * K + k0 + 8 * c) = o; }
    LDS_WAIT(); asm volatile("" ::: "memory");
}
__device__ __forceinline__ int map_swiglu(int n0) { return n0 < FF ? 256 * (n0 / 128) + (n0 % 128) : 256 * ((n0 - FF) / 128) + 128 + ((n0 - FF) % 128); }
__device__ __forceinline__ int map_heads(int n0) { const int rem = n0 % 256; return 256 * (n0 / 256) + 128 * ((rem / 32) & 1) + 32 * (rem / 64); }
__device__ __forceinline__ void row_to_bf16(const float* xrow, bf16* orow, float* ssq4, bool scale, int lane) {
    const GAS f32x4* xr = (const GAS f32x4*)xrow + lane;
    f32x4 v[4]; float s = 0.f;
#pragma unroll
    for (int j = 0; j < 4; ++j) { v[j] = xr[64 * j]; s += (v[j].x * v[j].x + v[j].y * v[j].y) + (v[j].z * v[j].z + v[j].w * v[j].w); }
    s = wave_sum(s);
    const float rs = scale ? __builtin_amdgcn_rsqf(s * (1.0f / 1024.0f) + EPS) : 1.0f;
    GAS unsigned long long* o8 = (GAS unsigned long long*)orow + lane;
#pragma unroll
    for (int j = 0; j < 4; ++j) wt_st8((void*)(o8 + 64 * j), (unsigned long long)pk2(v[j].x * rs, v[j].y * rs) | ((unsigned long long)pk2(v[j].z * rs, v[j].w * rs) << 32));
    if (ssq4 && lane == 0) { wt_st16f(ssq4, (f32x4){s, 0.f, 0.f, 0.f}); }
}
struct P0Item { const float* src; const float* gain; bf16* dst; int K, N; float useg; int grp; };
template <int SET>
__device__ __forceinline__ bool p0_decode(const float* const* in, unsigned char* ws, int it, P0Item& d) {
    constexpr int I_FI = (D / 64) * (2 * FF / 32), I_FO = (FF / 64) * (D / 32), I_WI = (D / 64) * (INW / 32), I_WO = (D / 64) * (D / 32), I_MK = (D / 64) * (512 / 32);
    constexpr int NITEMS = SET == 0 ? 2 * I_FI + I_MK : SET == 1 ? I_FO + I_WO + I_WI : I_FO;
    if (it >= NITEMS) return false;
    int r = it; const float* W; const float* gain; bf16* WT; int K, N, map;
    if (SET == 0) {
        if (r < I_FI) { W = in[3]; K = D; N = 2 * FF; gain = in[2]; WT = (bf16*)(ws + WS_W1I); map = 1; }
        else if ((r -= I_FI) < I_MK) { W = in[17]; K = D; N = 512; gain = in[6]; WT = (bf16*)(ws + WS_WMKV); map = 0; }
        else { r -= I_MK; W = in[22]; K = D; N = 2 * FF; gain = in[21]; WT = (bf16*)(ws + WS_W2I); map = 1; }
    } else if (SET == 1) {
        if (r < I_FO) { W = in[4]; K = FF; N = D; gain = nullptr; WT = (bf16*)(ws + WS_W1O); map = 0; }
        else if ((r -= I_FO) < I_WI) { W = in[7]; K = D; N = INW; gain = in[5]; WT = (bf16*)(ws + WS_WIN); map = 2; }
        else { r -= I_WI; W = in[20]; K = D; N = D; gain = nullptr; WT = (bf16*)(ws + WS_WOUT); map = 0; }
    } else { W = in[23]; K = FF; N = D; gain = nullptr; WT = (bf16*)(ws + WS_W2O); map = 0; }
    const int nblk = N / 32, kb = r / nblk, nb = r % nblk, k0 = 64 * kb, n0 = 32 * nb;
    const int dr = map == 1 ? map_swiglu(n0) : map == 2 ? map_heads(n0) : n0;
    d.src = W + (size_t)k0 * N + n0; d.gain = gain ? gain + k0 : W; d.useg = gain ? 1.0f : 0.0f; d.K = K; d.N = N;
#if PG8_BTILED
    if (WT != (bf16*)(ws + WS_WMKV)) { d.dst = WT + ((size_t)(dr >> 7) * (K >> 6) + (k0 >> 6)) * 8192; d.grp = dr & 96; return true; }
#endif
    d.dst = WT + (size_t)dr * K + k0; d.grp = -1; return true;
}
__device__ __forceinline__ void p0_item_load(const P0Item& d, f32x4 (&v)[8], float (&gv)[8], int lane) {
#pragma unroll
    for (int i = 0; i < 8; ++i) { v[i] = *(const GAS f32x4*)(d.src + (size_t)((lane >> 3) + 8 * i) * d.N + 4 * (lane & 7)); gv[i] = *(const GAS float*)(d.gain + (lane >> 3) + 8 * i); }
}
__device__ __forceinline__ void p0_item_finish(const P0Item& d, const f32x4 (&v)[8], const float (&gv)[8], LAS float* scr, int lane) {
#pragma unroll
    for (int i = 0; i < 8; ++i) { const int kk = (lane >> 3) + 8 * i; const float g = d.useg != 0.0f ? gv[i] : 1.0f; LAS float* s = scr + kk * 33 + 4 * (lane & 7);
        s[0] = v[i].x * g; s[1] = v[i].y * g; s[2] = v[i].z * g; s[3] = v[i].w * g; }
    LDS_WAIT(); asm volatile("" ::: "memory");
    const int c = lane & 7;
#pragma unroll
    for (int j = 0; j < 4; ++j) { const int n = (lane >> 3) + 8 * j; const LAS float* s = scr + (8 * c) * 33 + n;
        v4u o; o.x = pk2(s[0 * 33], s[1 * 33]); o.y = pk2(s[2 * 33], s[3 * 33]); o.z = pk2(s[4 * 33], s[5 * 33]); o.w = pk2(s[6 * 33], s[7 * 33]);
        const size_t eo = d.grp >= 0 ? (size_t)(pg8::lds_byte(d.grp + 16 * ((n >> 2) & 1) + 4 * (n >> 3) + (n & 3), 8 * c) >> 1) : (size_t)n * d.K + 8 * c;
        wt_st16(d.dst + eo, o); }
    LDS_WAIT(); asm volatile("" ::: "memory");
}
template <int SET>
__device__ __forceinline__ void p0_weights(const float* const* in, unsigned char* ws, LAS unsigned char* lds, int widx, int nw, int wave, int lane) {
    LAS float* scr = (LAS float*)(lds + RING_OFF + wave * 16384);
    P0Item d0, d1; f32x4 v0[8], v1[8]; float g0[8], g1[8];
    int it = widx; bool have = p0_decode<SET>(in, ws, it, d0);
    if (have) p0_item_load(d0, v0, g0, lane);
    while (have) {
        const bool have1 = p0_decode<SET>(in, ws, it + nw, d1);
        if (!have1) d1 = d0;
        p0_item_load(d1, v1, g1, lane);
        p0_item_finish(d0, v0, g0, scr, lane);
        it += nw; have = have1; d0 = d1;
#pragma unroll
        for (int i = 0; i < 8; ++i) { v0[i] = v1[i]; g0[i] = g1[i]; }
    }
}
struct P0Mat { const float* W; int K, N; const float* gain; bf16* WT; int map; };
__device__ __forceinline__ void p0_prologue(const float* const* in, unsigned char* ws, LAS unsigned char* lds, int vcu, int G, int wave, int lane) {
    LAS float* scr = (LAS float*)(lds + RING_OFF + wave * 16384);
    const int gw = vcu * NWAVES + wave, NGW = G * NWAVES;
    for (int m = gw; m < M; m += 4 * NGW) {
        f32x4 v[4][4];
#pragma unroll
        for (int r = 0; r < 4; ++r) { const GAS f32x4* xr = (const GAS f32x4*)(in[0] + (size_t)(m + r * NGW) * D) + 2 * lane;
            v[r][0] = xr[0]; v[r][1] = xr[1]; v[r][2] = xr[128]; v[r][3] = xr[129]; }
#pragma unroll
        for (int r = 0; r < 4; ++r) { float sa = 0.f;
#pragma unroll
            for (int j = 0; j < 4; ++j) sa += (v[r][j].x * v[r][j].x + v[r][j].y * v[r][j].y) + (v[r][j].z * v[r][j].z + v[r][j].w * v[r][j].w);
            sa = wave_sum(sa);
            GAS v4u* o16 = (GAS v4u*)((bf16*)(ws + WS_XB) + (size_t)(m + r * NGW) * D) + lane;
            wt_st16((void*)(o16), (v4u){pk2(v[r][0].x, v[r][0].y), pk2(v[r][0].z, v[r][0].w), pk2(v[r][1].x, v[r][1].y), pk2(v[r][1].z, v[r][1].w)});
            wt_st16((void*)(o16 + 64), (v4u){pk2(v[r][2].x, v[r][2].y), pk2(v[r][2].z, v[r][2].w), pk2(v[r][3].x, v[r][3].y), pk2(v[r][3].z, v[r][3].w)});
            if (lane == 0) wt_st16f((float*)(ws + WS_SSQ0) + (size_t)(m + r * NGW) * 4, (f32x4){sa, 0.f, 0.f, 0.f}); }
    }
    for (int m = gw; m < BATCH * MEMLEN; m += NGW) row_to_bf16(in[1] + (size_t)m * D, (bf16*)(ws + WS_MEMB) + (size_t)m * D, nullptr, true, lane);
    for (int f = gw * 64 + lane; f < 8 * 2 * 2 * 4 * 64; f += NGW * 64) {
        const int ln = f & 63, ks = (f >> 6) & 3, blk = (f >> 8) & 1, gate = (f >> 9) & 1, n = f >> 10, r = ln & 31, h = ln >> 5;
        const float* Wg = (gate ? in[12] : in[10]) + (size_t)n * 4096 + 32 * blk + r; float v[8];
#pragma unroll
        for (int j = 0; j < 8; ++j) v[j] = 1.4426950408889634f * Wg[(8 * (2 * ks + (j >> 2)) + 4 * h + (j & 3)) * 64];
        v4u o; o.x = pk2(v[0], v[1]); o.y = pk2(v[2], v[3]); o.z = pk2(v[4], v[5]); o.w = pk2(v[6], v[7]);
        wt_st16((bf16*)(ws + WS_WG) + (size_t)f * 8, o); }
    p0_weights<0>(in, ws, lds, gw, NGW, wave, lane);
    for (int i = gw * 64 + lane; i < BATCH * NBLK * LRUW * 2; i += NGW * 64) wt_st8((unsigned long long*)(ws + WS_GR) + i, 0ull);
}
__device__ __forceinline__ unsigned pkbf(float lo, float hi) { typedef float f2 __attribute__((ext_vector_type(2))); typedef __bf16 b2 __attribute__((ext_vector_type(2))); f2 v = {lo, hi}; b2 r = __builtin_convertvector(v, b2); return __builtin_bit_cast(unsigned, r); }
typedef float f32x16_ __attribute__((ext_vector_type(16)));
constexpr int LRU_ROWB = 136, LRU_XT = 40 * LRU_ROWB, LRU_TILE = LRU_XT + 32 * LRU_ROWB;
__device__ __forceinline__ void lru_load(const bf16* U, int n, int b, int ck, int wave, int lane, v4u (&xv)[5], v4u (&gv)[4]) {
    const int t0 = ck * 256 + wave * 32;
    const int rr = lane >> 3, c16 = lane & 7; const bf16* src = U + ((size_t)b * SEQ + t0 - 3 + rr) * INW + n * 64 + c16 * 8;
#pragma unroll
    for (int i = 0; i < 5; ++i) { const int row = rr + 8 * i; const bool ok = (row < 35) && (t0 - 3 + row >= 0); const int rowc = ok ? row : 3;
        const v4u ld = *(const GAS v4u*)(src + (size_t)(rowc - rr) * INW); xv[i] = ok ? ld : (v4u){0u, 0u, 0u, 0u}; }
#pragma unroll
    for (int i = 0; i < 4; ++i) gv[i] = *(const GAS v4u*)(src + (size_t)(3 + 8 * i) * INW + LRUW);
}
__device__ __forceinline__ void lru_stage(LAS unsigned char* tile, int lane, const v4u (&xv)[5], const v4u (&gv)[4]) {
    typedef unsigned u2v __attribute__((ext_vector_type(2)));
    const int rr = lane >> 3, c16 = lane & 7;
#pragma unroll
    for (int i = 0; i < 5; ++i) { LAS unsigned char* d = tile + (rr + 8 * i) * LRU_ROWB + c16 * 16; *(LAS u2v*)d = (u2v){xv[i].x, xv[i].y}; *(LAS u2v*)(d + 8) = (u2v){xv[i].z, xv[i].w}; }
#pragma unroll
    for (int i = 0; i < 4; ++i) { LAS unsigned char* d = tile + LRU_XT + (rr + 8 * i) * LRU_ROWB + c16 * 16; *(LAS u2v*)d = (u2v){gv[i].x, gv[i].y}; *(LAS u2v*)(d + 8) = (u2v){gv[i].z, gv[i].w}; }
}
__device__ __forceinline__ void lru_local(const bf16* WG, const LAS float* PT, LAS unsigned char* tile, int n, int b, int ck, int wave, int lane, float (&av)[32], float (&bv)[32]) {
    typedef unsigned u2v __attribute__((ext_vector_type(2)));
    const int r32 = lane & 31, hi = lane >> 5;
    const int t0 = ck * 256 + wave * 32, t = t0 + r32;
    const LAS unsigned char* xrow = tile + r32 * LRU_ROWB + 8 * hi;
    unsigned xpk[16];
#pragma unroll
    for (int g = 0; g < 8; ++g) {
        f32x4 acc = *(const LAS f32x4*)(PT + 4 * 64 + 8 * g + 4 * hi);
#pragma unroll
        for (int jj = 0; jj < 4; ++jj) { const u2v w = *(const LAS u2v*)(xrow + jj * LRU_ROWB + 16 * g);
            const f32x4 cw = *(const LAS f32x4*)(PT + jj * 64 + 8 * g + 4 * hi);
            acc[0] += cw[0] * bflo(w.x); acc[1] += cw[1] * bfhi(w.x); acc[2] += cw[2] * bflo(w.y); acc[3] += cw[3] * bfhi(w.y); }
        xpk[2 * g] = pkbf(acc[0], acc[1]); xpk[2 * g + 1] = pkbf(acc[2], acc[3]);
    }
    bf16x8 xf[4];
#pragma unroll
    for (int ks = 0; ks < 4; ++ks) { v4u w; w.x = xpk[4 * ks]; w.y = xpk[4 * ks + 1]; w.z = xpk[4 * ks + 2]; w.w = xpk[4 * ks + 3]; xf[ks] = __builtin_bit_cast(bf16x8, w); }
    f32x16_ aR[2], aI[2];
#pragma unroll
    for (int blk = 0; blk < 2; ++blk)
#pragma unroll
        for (int q4 = 0; q4 < 4; ++q4) { const f32x4 ba = *(const LAS f32x4*)(PT + 6 * 64 + 32 * blk + 8 * q4 + 4 * hi), bx = *(const LAS f32x4*)(PT + 7 * 64 + 32 * blk + 8 * q4 + 4 * hi);
#pragma unroll
            for (int i = 0; i < 4; ++i) { aR[blk][4 * q4 + i] = ba[i]; aI[blk][4 * q4 + i] = bx[i]; } }
#pragma unroll
    for (int blk = 0; blk < 2; ++blk)
#pragma unroll
        for (int ks = 0; ks < 4; ++ks) {
            const bf16x8 wa = *(const GAS bf16x8*)(WG + ((size_t)(((n * 2 + 0) * 2 + blk) * 4 + ks) * 64 + lane) * 8);
            const bf16x8 wx = *(const GAS bf16x8*)(WG + ((size_t)(((n * 2 + 1) * 2 + blk) * 4 + ks) * 64 + lane) * 8);
            aR[blk] = __builtin_amdgcn_mfma_f32_32x32x16_bf16(wa, xf[ks], aR[blk], 0, 0, 0);
            aI[blk] = __builtin_amdgcn_mfma_f32_32x32x16_bf16(wx, xf[ks], aI[blk], 0, 0, 0); }
#pragma unroll
    for (int blk = 0; blk < 2; ++blk)
#pragma unroll
        for (int q4 = 0; q4 < 4; ++q4) { const f32x4 sp4 = *(const LAS f32x4*)(PT + 5 * 64 + 32 * blk + 8 * q4 + 4 * hi);
#pragma unroll
            for (int i = 0; i < 4; ++i) { const int idx = 16 * blk + 4 * q4 + i;
                const float r = __builtin_amdgcn_rcpf(1.0f + __builtin_amdgcn_exp2f(-aR[blk][4 * q4 + i])), ii = __builtin_amdgcn_rcpf(1.0f + __builtin_amdgcn_exp2f(-aI[blk][4 * q4 + i]));
                const float a = __builtin_amdgcn_exp2f(r * sp4[i]);
                float mult = __builtin_amdgcn_sqrtf(__builtin_fmaf(-a, a, 1.0f)); if (t == 0) mult = 1.0f;
                const unsigned xw_ = xpk[idx >> 1]; av[idx] = a; bv[idx] = mult * ii * ((idx & 1) ? bfhi(xw_) : bflo(xw_)); } }
#define LRU_E(i, C) "v_fmac_f32_dpp %" #i ", %" #i ", %" #C " " CTRL "\n\tv_mul_f32_dpp %" #C ", %" #C ", %" #C " " CTRL "\n\t"
#define LRU_STEP4(g) asm volatile("s_nop 1\n\t" LRU_E(0, 4) LRU_E(1, 5) LRU_E(2, 6) LRU_E(3, 7) : "+v"(bv[g]), "+v"(bv[g + 1]), "+v"(bv[g + 2]), "+v"(bv[g + 3]), "+v"(av[g]), "+v"(av[g + 1]), "+v"(av[g + 2]), "+v"(av[g + 3]))
#define LRU_STEP() do { LRU_STEP4(0); LRU_STEP4(4); LRU_STEP4(8); LRU_STEP4(12); LRU_STEP4(16); LRU_STEP4(20); LRU_STEP4(24); LRU_STEP4(28); } while (0)
#define CTRL "row_shr:1 row_mask:0xf bank_mask:0xf"
    LRU_STEP();
#undef CTRL
#define CTRL "row_shr:2 row_mask:0xf bank_mask:0xf"
    LRU_STEP();
#undef CTRL
#define CTRL "row_shr:4 row_mask:0xf bank_mask:0xf"
    LRU_STEP();
#undef CTRL
#define CTRL "row_shr:8 row_mask:0xf bank_mask:0xf"
    LRU_STEP();
#undef CTRL
#define CTRL "row_bcast:15 row_mask:0xa bank_mask:0xf"
    LRU_STEP();
#undef CTRL
#undef LRU_E
#undef LRU_STEP4
#undef LRU_STEP
}
__device__ __forceinline__ void lru_put_agg(LAS float* Aw, LAS float* Hw, int wave, int lane, const float (&av)[32], const float (&bv)[32]) {
    const int r32 = lane & 31, hi = lane >> 5;
    if (r32 == 31) {
#pragma unroll
        for (int k = 0; k < 8; ++k) { const int d = 8 * k + 4 * hi; const int idx = 4 * k;
            *(LAS f32x4*)(Aw + wave * 64 + d) = (f32x4){av[idx], av[idx + 1], av[idx + 2], av[idx + 3]}; *(LAS f32x4*)(Hw + wave * 64 + d) = (f32x4){bv[idx], bv[idx + 1], bv[idx + 2], bv[idx + 3]}; } }
}
__device__ __forceinline__ void lru_publish(gu64* GR, const LAS float* Aw, const LAS float* Hw, int b, int ck, int n, int lane) {
    float cA = 1.f, cH = 0.f; const int gc = n * 64 + lane;
#pragma unroll
    for (int v = 0; v < 8; ++v) { const float a1 = Aw[v * 64 + lane], h1 = Hw[v * 64 + lane]; cH = a1 * cH + h1; cA *= a1; }
    gu64* g = GR + ((size_t)(b * NBLK + ck) * LRUW + gc) * 2;
    __hip_atomic_store(g, (1ull << 32) | (unsigned long long)__float_as_uint(cA), __ATOMIC_RELAXED, __HIP_MEMORY_SCOPE_AGENT);
    __hip_atomic_store(g + 1, (1ull << 32) | (unsigned long long)__float_as_uint(cH), __ATOMIC_RELAXED, __HIP_MEMORY_SCOPE_AGENT);
}
__device__ __forceinline__ float lru_lookback(const gu64* GR, int b, int ck, int n, int lane) {
    const int gc = n * 64 + lane; float h = 0.f;
    if (ck > 0) {
        const gu64* g0 = GR + ((size_t)(b * NBLK) * LRUW + gc) * 2;
#pragma unroll
        for (int half = 0; half < 2; ++half) {
            if (half * 16 < ck) {
                float ca[16], ch[16];
                for (unsigned spins = 0;; ++spins) { bool ok = true;
#pragma unroll
                    for (int cc = 0; cc < 16; ++cc) { const int c1 = half * 16 + cc, c2 = c1 < ck ? c1 : 0;
                        const unsigned long long x = __hip_atomic_load(g0 + (size_t)c2 * LRUW * 2, __ATOMIC_RELAXED, __HIP_MEMORY_SCOPE_AGENT), y = __hip_atomic_load(g0 + (size_t)c2 * LRUW * 2 + 1, __ATOMIC_RELAXED, __HIP_MEMORY_SCOPE_AGENT);
                        ok = ok && ((x >> 32) == 1ull) && ((y >> 32) == 1ull); ca[cc] = __uint_as_float((unsigned)x); ch[cc] = __uint_as_float((unsigned)y); }
                    if (__all(ok) || spins > (1u << 14)) break;
                    __builtin_amdgcn_s_sleep(2); }
#pragma unroll
                for (int cc = 0; cc < 16; ++cc) h = (half * 16 + cc) < ck ? ca[cc] * h + ch[cc] : h;
            }
        }
    }
    return h;
}
__device__ __forceinline__ void lru_finish(bf16* MIX, const LAS float* Aw, const LAS float* Hw, const LAS float* CAR, LAS unsigned char* tile, int n, int b, int ck, int wave, int lane, const float (&av)[32], const float (&bv)[32]) {
    typedef unsigned u2v __attribute__((ext_vector_type(2)));
    const int r32 = lane & 31, hi = lane >> 5;
    LAS unsigned char* grow = tile + LRU_XT + r32 * LRU_ROWB + 8 * hi;
    f32x4 c[8];
#pragma unroll
    for (int k = 0; k < 8; ++k) c[k] = *(const LAS f32x4*)(CAR + 8 * k + 4 * hi);
    for (int v = 0; v < wave; ++v) { const LAS float* ap = Aw + v * 64 + 4 * hi; const LAS float* hp = Hw + v * 64 + 4 * hi;
#pragma unroll
        for (int k = 0; k < 8; ++k) { const f32x4 a1 = *(const LAS f32x4*)(ap + 8 * k), h1 = *(const LAS f32x4*)(hp + 8 * k); c[k] = a1 * c[k] + h1; } }
#pragma unroll
    for (int k = 0; k < 8; ++k) { const int idx = 4 * k;
        const u2v gw = *(const LAS u2v*)(grow + 16 * k);
        const float h0 = bv[idx] + av[idx] * c[k][0], h1_ = bv[idx + 1] + av[idx + 1] * c[k][1], h2 = bv[idx + 2] + av[idx + 2] * c[k][2], h3 = bv[idx + 3] + av[idx + 3] * c[k][3];
        u2v o; o.x = pkbf(h0 * gelu_tanh(bflo(gw.x)), h1_ * gelu_tanh(bfhi(gw.x))); o.y = pkbf(h2 * gelu_tanh(bflo(gw.y)), h3 * gelu_tanh(bfhi(gw.y)));
        *(LAS u2v*)(grow + 16 * k) = o; }
    { const int rr = lane >> 3, c16 = lane & 7; bf16* dst = MIX + ((size_t)b * SEQ + ck * 256 + wave * 32 + rr) * D + n * 64 + c16 * 8;
#pragma unroll
      for (int i = 0; i < 4; ++i) { const LAS unsigned char* s = tile + LRU_XT + (rr + 8 * i) * LRU_ROWB + c16 * 16; const u2v lo = *(const LAS u2v*)s, hi2 = *(const LAS u2v*)(s + 8);
          *(GAS v4u*)(dst + (size_t)(8 * i) * D) = (v4u){lo.x, lo.y, hi2.x, hi2.y}; } }
}
template <bool FINAL>
__device__ __forceinline__ void lru_items(unsigned char* ws, LAS unsigned char* lds, int G, int wave, int tid) {
    const bf16* U = (const bf16*)(ws + WS_U); bf16* MIX = (bf16*)(ws + WS_MIX); const bf16* WG = (const bf16*)(ws + WS_WG);
    gu64* GR = (gu64*)(ws + WS_GR);
    LAS float* PT = (LAS float*)(lds + RING_OFF);
    LAS float* Aw = PT + 512; LAS float* Hw = Aw + 512; LAS float* CAR = Hw + 512;
    LAS unsigned char* tile = lds + RING_OFF + 8192 + wave * 10240;
    static_assert(LRU_TILE <= 10240 && 8192 + 8 * 10240 <= RING_BYTES, "LRU LDS map");
    const int n = blockIdx.x & 7;
    __syncthreads();
    { const int row = tid >> 6, c = tid & 63; PT[row * 64 + c] = ((const float*)(ws + WS_PTAB))[row * 512 + n * 64 + c]; }
    v4u xv[5], gv[4];
    if ((int)blockIdx.x < BATCH * NBLK * 8) { int lane0; asm volatile("v_mbcnt_lo_u32_b32 %0, -1, 0\n\tv_mbcnt_hi_u32_b32 %0, -1, %0" : "=v"(lane0)); lru_load(U, n, (int)blockIdx.x >> 8, ((int)blockIdx.x >> 3) & 31, wave, lane0, xv, gv); }
    for (int id = blockIdx.x; id < BATCH * NBLK * 8; id += G) {
        const int ck = (id >> 3) & 31, b = id >> 8;
        int lane; asm volatile("v_mbcnt_lo_u32_b32 %0, -1, 0\n\tv_mbcnt_hi_u32_b32 %0, -1, %0" : "=v"(lane));
        __syncthreads();
        float av[32], bv[32];
        lru_stage(tile, lane, xv, gv);
        { const int nid = (id + G < BATCH * NBLK * 8) ? id + G : id; lru_load(U, n, nid >> 8, (nid >> 3) & 31, wave, lane, xv, gv); }
        lru_local(WG, PT, tile, n, b, ck, wave, lane, av, bv);
        lru_put_agg(Aw, Hw, wave, lane, av, bv);
        __syncthreads();
        if (wave == 0) lru_publish(GR, Aw, Hw, b, ck, n, lane);
        if (wave == 7) CAR[lane] = lru_lookback(GR, b, ck, n, lane);
        __syncthreads();
        lru_finish(MIX, Aw, Hw, CAR, tile, n, b, ck, wave, lane, av, bv);
    }
    __syncthreads();
}
__device__ __forceinline__ void kvprep_items(unsigned char* ws, LAS unsigned char* lds, int G, int wave, int lane, int tid) {
    const bf16* U = (const bf16*)(ws + WS_U); bf16* KF = (bf16*)(ws + WS_KF); bf16* VF = (bf16*)(ws + WS_VF); float* KM = (float*)(ws + WS_KMEAN);
    LAS unsigned char* KT = lds + RING_OFF;
    LAS unsigned short* VTl = (LAS unsigned short*)(lds + RING_OFF + 36864);
    LAS float* part = (LAS float*)(lds + RING_OFF + 36864 + 33792);
    for (int id = blockIdx.x; id < BATCH * NBLK * 4; id += G) {
        const int h = id & 3, j = (id >> 2) & 31, b = id >> 7, bh = b * 4 + h;
        __syncthreads();
        { const int key = tid >> 1, half = tid & 1; const bf16* rowp = U + ((size_t)b * SEQ + j * 256 + key) * INW + h * 64 + half * 32;
          const uint4* ks = (const uint4*)(rowp + 1280); const uint4* vs = (const uint4*)(rowp + 1536);
          v4u kw[4], vw[4];
#pragma unroll
          for (int c = 0; c < 4; ++c) { kw[c] = *(const GAS v4u*)(ks + c); vw[c] = *(const GAS v4u*)(vs + c); }
#pragma unroll
          for (int c = 0; c < 4; ++c) { *(LAS v4u*)(KT + key * 144 + half * 64 + c * 16) = kw[c];
              LAS unsigned* dst = (LAS unsigned*)(VTl + key * 66 + half * 32 + c * 8); dst[0] = vw[c].x; dst[1] = vw[c].y; dst[2] = vw[c].z; dst[3] = vw[c].w; } }
        __syncthreads();
        { const int d = tid & 63, pt = tid >> 6; float s = 0.f;
#pragma unroll 8
          for (int r = 0; r < 32; ++r) s += bf2f(*(const LAS unsigned short*)(KT + (pt * 32 + r) * 144 + d * 2));
          part[pt * 64 + d] = s; }
        { const int r32 = lane & 31, hi = lane >> 5;
#pragma unroll
          for (int ks = 0; ks < 4; ++ks) { const v4u w = *(const LAS v4u*)(KT + (wave * 32 + r32) * 144 + ks * 32 + hi * 16);
              *(GAS v4u*)(KF + (((size_t)(bh * 256 + j * 8 + wave) * 4 + ks) * 64 + lane) * 8) = w; }
#pragma unroll
          for (int db = 0; db < 2; ++db)
#pragma unroll
              for (int s = 0; s < 2; ++s) { unsigned short v[8];
#pragma unroll
                  for (int jj = 0; jj < 8; ++jj) v[jj] = VTl[(wave * 32 + 16 * s + 8 * (jj >> 2) + 4 * hi + (jj & 3)) * 66 + 32 * db + r32];
                  uint4 w; w.x = v[0] | ((unsigned)v[1] << 16); w.y = v[2] | ((unsigned)v[3] << 16); w.z = v[4] | ((unsigned)v[5] << 16); w.w = v[6] | ((unsigned)v[7] << 16);
                  *(GAS v4u*)(VF + ((((size_t)(bh * 256 + j * 8 + wave) * 2 + db) * 2 + s) * 64 + lane) * 8) = (v4u){w.x, w.y, w.z, w.w}; } }
        __syncthreads();
        if (tid < 64) { float s = 0.f;
#pragma unroll
            for (int v = 0; v < 8; ++v) s += part[v * 64 + tid];
            KM[((size_t)bh * NBLK + j) * 64 + tid] = s * (1.0f / 256.0f); }
    }
    __syncthreads();
}
__device__ __forceinline__ void memkv_items(unsigned char* ws, LAS unsigned char* lds, int vcu, int G, int wave, int lane) {
    const bf16* A = (const bf16*)(ws + WS_MEMB); const bf16* Bt = (const bf16*)(ws + WS_WMKV);
    bf16* MK = (bf16*)(ws + WS_MEMKF); bf16* MV = (bf16*)(ws + WS_MEMVF); const float* gk = (const float*)(ws + WS_GAINS) + 256;
    LAS float* red = (LAS float*)(lds + RING_OFF);
    for (int id = vcu; id < 32 * 8; id += G) {
        const int rt = id >> 3, ct = id & 7, fr = lane & 15, fq = lane >> 4;
        f32x4 acc[4];
#pragma unroll
        for (int nb = 0; nb < 4; ++nb) acc[nb] = (f32x4){0.f, 0.f, 0.f, 0.f};
        const bf16* ap = A + (size_t)(rt * 16 + fr) * D + fq * 8 + wave * 128;
        const bf16* bp = Bt + (size_t)(ct * 64 + fr) * D + fq * 8 + wave * 128;
        bf16x8 af[4], bfr[4][4];
#pragma unroll
        for (int ks = 0; ks < 4; ++ks) { af[ks] = *(const GAS bf16x8*)(ap + ks * 32);
#pragma unroll
            for (int nb = 0; nb < 4; ++nb) bfr[ks][nb] = *(const GAS bf16x8*)(bp + (size_t)nb * 16 * D + ks * 32); }
#pragma unroll
        for (int ks = 0; ks < 4; ++ks)
#pragma unroll
            for (int nb = 0; nb < 4; ++nb) acc[nb] = __builtin_amdgcn_mfma_f32_16x16x32_bf16(af[ks], bfr[ks][nb], acc[nb], 0, 0, 0);
        __syncthreads();
#pragma unroll
        for (int nb = 0; nb < 4; ++nb) *(LAS f32x4*)(red + ((wave * 4 + nb) * 64 + lane) * 4) = acc[nb];
        __syncthreads();
        if (wave == 0) {
            float gkv[4];
#pragma unroll
            for (int nb = 0; nb < 4; ++nb) gkv[nb] = *(const GAS float*)(gk + nb * 16 + fr);
#pragma unroll
            for (int nb = 0; nb < 4; ++nb) { f32x4 s = *(const LAS f32x4*)(red + (nb * 64 + lane) * 4);
#pragma unroll
                for (int w = 1; w < 8; ++w) s += *(const LAS f32x4*)(red + ((w * 4 + nb) * 64 + lane) * 4);
                acc[nb] = s; }
#pragma unroll
            for (int reg = 0; reg < 4; ++reg) { const int row = rt * 16 + 4 * fq + reg, bb = row >> 8, m = row & 255, kb = m >> 5, mm = m & 31;
                if (ct < 4) { float ss = 0.f;
#pragma unroll
                    for (int nb = 0; nb < 4; ++nb) ss += acc[nb][reg] * acc[nb][reg];
                    ss += __shfl_xor(ss, 1); ss += __shfl_xor(ss, 2); ss += __shfl_xor(ss, 4); ss += __shfl_xor(ss, 8);
                    const float rn = __builtin_amdgcn_rsqf(ss * (1.0f / 64.0f) + EPS);
#pragma unroll
                    for (int nb = 0; nb < 4; ++nb) { const int d = nb * 16 + fr;
                        MK[((((size_t)((bb * 4 + ct) * 8 + kb) * 4 + (d >> 4)) * 64) + ((d >> 3) & 1) * 32 + mm) * 8 + (d & 7)] = (bf16)f2bf(acc[nb][reg] * rn * gkv[nb]); }
                } else { const int s = mm >> 4, o = mm & 15, hi2 = (o >> 2) & 1, jj = 4 * (o >> 3) + (o & 3);
#pragma unroll
                    for (int nb = 0; nb < 4; ++nb) { const int d = nb * 16 + fr;
                        MV[(((((size_t)((bb * 4 + (ct - 4)) * 8 + kb) * 2 + (d >> 5)) * 2 + s) * 64) + hi2 * 32 + (d & 31)) * 8 + jj] = (bf16)f2bf(acc[nb][reg]); } } }
        }
    }
    __syncthreads();
}
typedef float f32x16 __attribute__((ext_vector_type(16)));
__device__ __forceinline__ int crow(int r, int hi) { return (r & 3) + 8 * (r >> 2) + 4 * hi; }
__device__ __forceinline__ unsigned cvtpk(float lo, float hi) { typedef float f2 __attribute__((ext_vector_type(2))); typedef __bf16 b2 __attribute__((ext_vector_type(2))); f2 v = {lo, hi}; b2 r = __builtin_convertvector(v, b2); return __builtin_bit_cast(unsigned, r); }
__device__ __forceinline__ void attn_task(f32x16& o0, f32x16& o1, float& lsum, const bf16* qrow, const bf16* KFb, const bf16* VFb, int nkb, float cq, float slopeL, int dist0, int lane) {
    const int r32 = lane & 31, hi = lane >> 5; (void)r32;
    bf16x8 qf[4];
#pragma unroll
    for (int ks = 0; ks < 4; ++ks) qf[ks] = *(const bf16x8*)(qrow + 16 * ks + 8 * hi);
    float base[16];
#pragma unroll
    for (int r = 0; r < 16; ++r) base[r] = slopeL * (float)crow(r, hi) + cq;
#pragma unroll
    for (int r = 0; r < 16; ++r) { o0[r] = 0.f; o1[r] = 0.f; }
    lsum = 0.f;
    const bf16* kp = KFb + lane * 8;
    const bf16* vp = VFb + lane * 8;
    bf16x8 kA[4], vA[4];
#define AT_LOADK(k_, kb_) do { _Pragma("unroll") for (int ks = 0; ks < 4; ++ks) k_[ks] = *(const bf16x8*)(kp + ((kb_) * 4 + ks) * 512); } while (0)
#define AT_LOADV(v_, kb_) do { _Pragma("unroll") for (int f = 0; f < 4; ++f) v_[f] = *(const bf16x8*)(vp + ((kb_) * 4 + f) * 512); } while (0)
    AT_LOADK(kA, 0); AT_LOADV(vA, 0);
#pragma unroll 1
    for (int kb = 0; kb < nkb; ++kb) {
        const float c0 = slopeL * (float)(32 * kb); f32x16 sc;
#pragma unroll
        for (int r = 0; r < 16; ++r) sc[r] = base[r] + c0;
#pragma unroll
        for (int ks = 0; ks < 4; ++ks) sc = __builtin_amdgcn_mfma_f32_32x32x16_bf16(kA[ks], qf[ks], sc, 0, 0, 0);
        if (kb + 1 < nkb) AT_LOADK(kA, kb + 1);
#pragma unroll
        for (int r = 0; r < 16; ++r) { float pr = __builtin_amdgcn_exp2f(sc[r]); if (32 * kb + crow(r, hi) > dist0) pr = 0.f; sc[r] = pr; lsum += pr; }
        v4u w0, w1; w0.x = cvtpk(sc[0], sc[1]); w0.y = cvtpk(sc[2], sc[3]); w0.z = cvtpk(sc[4], sc[5]); w0.w = cvtpk(sc[6], sc[7]); w1.x = cvtpk(sc[8], sc[9]); w1.y = cvtpk(sc[10], sc[11]); w1.z = cvtpk(sc[12], sc[13]); w1.w = cvtpk(sc[14], sc[15]);
        const bf16x8 p0 = __builtin_bit_cast(bf16x8, w0), p1 = __builtin_bit_cast(bf16x8, w1);
        o0 = __builtin_amdgcn_mfma_f32_32x32x16_bf16(vA[0], p0, o0, 0, 0, 0); o0 = __builtin_amdgcn_mfma_f32_32x32x16_bf16(vA[1], p1, o0, 0, 0, 0);
        o1 = __builtin_amdgcn_mfma_f32_32x32x16_bf16(vA[2], p0, o1, 0, 0, 0); o1 = __builtin_amdgcn_mfma_f32_32x32x16_bf16(vA[3], p1, o1, 0, 0, 0);
        if (kb + 1 < nkb) AT_LOADV(vA, kb + 1);
    }
#undef AT_LOADK
#undef AT_LOADV
}
constexpr int AU_KMT = 0;
constexpr int AU_SLOT = 0;
constexpr int AU_CNT = LDSCTL_OFF + 512, AU_TC = AU_CNT + 128, AU_TASKS = AU_TC + 16, AU_LIST = AU_TASKS + 240, AU_LACC = AU_LIST + 32 * 256 * 2, AU_END = AU_LACC + 4 * 256 * 4;
static_assert(AU_END <= LDS_BYTES, "MoBA unit LDS map");
__device__ __forceinline__ void moba_unit(unsigned char* ws, LAS unsigned char* lds, int bh, int qb, int wave, int lane, int tid) {
    const bf16* U = (const bf16*)(ws + WS_U); bf16* MIX = (bf16*)(ws + WS_MIX); const float* KM = (const float*)(ws + WS_KMEAN);
    const float* GT = (const float*)(ws + WS_GAINS);
    LAS unsigned* CNT = (LAS unsigned*)(lds + AU_CNT); LAS unsigned* TC = (LAS unsigned*)(lds + AU_TC);
    LAS unsigned short* TASKS = (LAS unsigned short*)(lds + AU_TASKS); LAS unsigned short* LIST = (LAS unsigned short*)(lds + AU_LIST);
    LAS float* KMT = (LAS float*)(lds + AU_KMT); LAS float* LACC = (LAS float*)(lds + AU_LACC);
    LAS unsigned char* SLOT = lds + AU_SLOT;
    const int b = bh >> 2, h = bh & 3, r32 = lane & 31, hi = lane >> 5;
    const size_t rb = (size_t)b * SEQ;
    const float slopeL = exp2f(-2.0f * (float)(h + 1)) * 1.4426950408889634f;
    const float MB2 = GT[192];
    const bf16* Qh = U + (rb + (size_t)qb * 256) * INW + 1024 + h * 64;
    const bf16* KFh = (const bf16*)(ws + WS_KF) + (size_t)bh * 256 * 2048;
    const bf16* VFh = (const bf16*)(ws + WS_VF) + (size_t)bh * 256 * 2048;
#ifndef REP_MB_SETUP
#define REP_MB_SETUP 1
#endif
    for (int rsu_ = 0; rsu_ < REP_MB_SETUP; ++rsu_) {
    __syncthreads();
    if (tid < 36) CNT[tid] = 0u;
    const int ql = wave * 32 + r32;
    unsigned qw[32];
    { const GAS v4u* p = (const GAS v4u*)(Qh + (size_t)ql * INW);
#pragma unroll
      for (int c = 0; c < 8; ++c) { const v4u w = p[c]; qw[4 * c] = w.x; qw[4 * c + 1] = w.y; qw[4 * c + 2] = w.z; qw[4 * c + 3] = w.w; } }
    for (int i = tid; i < qb * 64; i += 512) KMT[(i >> 6) * 65 + (i & 63)] = *(const GAS float*)(KM + (size_t)bh * NBLK * 64 + i);
    __syncthreads();
    if (qb > 0) {
        f32x16 g;
#pragma unroll
        for (int r = 0; r < 16; ++r) g[r] = 0.f;
#pragma unroll
        for (int ks = 0; ks < 32; ++ks) { const float a = KMT[r32 * 65 + 2 * ks + hi]; const float bq = hi ? bfhi(qw[ks]) : bflo(qw[ks]); g = __builtin_amdgcn_mfma_f32_32x32x2f32(a, bq, g, 0, 0, 0); }
        float g1 = -INFINITY, g2 = -INFINITY, g3 = -INFINITY; int i1 = 0, i2 = 0, i3 = 0;
#pragma unroll
        for (int r = 0; r < 16; ++r) { const int j = crow(r, hi); const float gv = (j < qb) ? g[r] : -INFINITY;
            const bool c1 = gv > g1, c2 = gv > g2, c3 = gv > g3;
            g3 = c2 ? g2 : (c3 ? gv : g3); i3 = c2 ? i2 : (c3 ? j : i3);
            g2 = c1 ? g1 : (c2 ? gv : g2); i2 = c1 ? i1 : (c2 ? j : i2);
            g1 = c1 ? gv : g1; i1 = c1 ? j : i1; }
        float pg[3]; int pi[3];
        pg[0] = __shfl_xor(g1, 32); pg[1] = __shfl_xor(g2, 32); pg[2] = __shfl_xor(g3, 32); pi[0] = __shfl_xor(i1, 32); pi[1] = __shfl_xor(i2, 32); pi[2] = __shfl_xor(i3, 32);
#pragma unroll
        for (int k = 0; k < 3; ++k) { const float gv = pg[k]; const int j = pi[k];
            const bool c1 = gv > g1 || (gv == g1 && j < i1), c2 = gv > g2 || (gv == g2 && j < i2), c3 = gv > g3 || (gv == g3 && j < i3);
            g3 = c2 ? g2 : (c3 ? gv : g3); i3 = c2 ? i2 : (c3 ? j : i3);
            g2 = c1 ? g1 : (c2 ? gv : g2); i2 = c1 ? i1 : (c2 ? j : i2);
            g1 = c1 ? gv : g1; i1 = c1 ? j : i1; }
        if (hi == 0) { const int nok = qb < 3 ? qb : 3;
            if (nok > 0) { const unsigned pos = atomicAdd((unsigned*)&CNT[i1], 1u); LIST[i1 * 256 + pos] = (unsigned short)ql; }
            if (nok > 1) { const unsigned pos = atomicAdd((unsigned*)&CNT[i2], 1u); LIST[i2 * 256 + pos] = (unsigned short)(ql | 0x100); }
            if (nok > 2) { const unsigned pos = atomicAdd((unsigned*)&CNT[i3], 1u); LIST[i3 * 256 + pos] = (unsigned short)(ql | 0x200); } }
    }
    __syncthreads();
    if (wave == 0) {
        const unsigned c = (lane < qb && lane < 32) ? CNT[lane] : 0u; const int ng = (int)((c + 31u) >> 5);
        int incl = ng;
#pragma unroll
        for (int o = 1; o < 64; o <<= 1) { const int t = __shfl_up(incl, o); if (lane >= o) incl += t; }
        const int off = incl - ng, total = __shfl(incl, 63);
#ifdef MB_SHARED_FIRST
        for (int g = 0; g < ng; ++g) TASKS[16 + off + g] = (unsigned short)((lane << 8) | g);
        if (lane < 8) { TASKS[lane] = (unsigned short)(0x4000 | lane); TASKS[8 + lane] = (unsigned short)(0x8000 | lane); }
#else
        for (int g = 0; g < ng; ++g) TASKS[off + g] = (unsigned short)((lane << 8) | g);
        if (lane < 8) { TASKS[total + lane] = (unsigned short)(0x8000 | (7 - lane)); TASKS[total + 8 + lane] = (unsigned short)(0x4000 | lane); }
#endif
        if (lane == 0) TC[0] = (unsigned)(total + 16);
    }
    __syncthreads();
    }
    const int ntasks = (int)TC[0];
#ifndef REP_MB_STREAM
#define REP_MB_STREAM 1
#endif
#ifdef MB_ROT4
    for (int rst_ = 0; rst_ < REP_MB_STREAM; ++rst_)
    if (wave < ntasks) {
        int lane; asm volatile("v_mbcnt_lo_u32_b32 %0, -1, 0\n\tv_mbcnt_hi_u32_b32 %0, -1, %0" : "=v"(lane));
        const int r32 = lane & 31, hi = lane >> 5; unsigned loffB = (unsigned)lane * 16u;
        int t = wave;
        int c_j, c_nkb, c_slot, c_ql, c_dist0; bool c_valid, c_own, c_mem;
#define MB_DECODE(T, J, NKB, SLOT, QL, DIST0, VALID, OWN, MEM) do { const unsigned tk_ = (unsigned)__builtin_amdgcn_readfirstlane((int)TASKS[T]); MEM = (tk_ & 0x4000u) != 0u; OWN = (tk_ & 0x8000u) != 0u; \
        if (MEM) { QL = (int)(tk_ & 7u) * 32 + r32; SLOT = 4; J = 0; NKB = 8; DIST0 = 1 << 20; VALID = true; } \
        else if (OWN) { const int w_ = (int)(tk_ & 7u); QL = w_ * 32 + r32; SLOT = 3; J = qb; NKB = (w_ + 2) & ~1; DIST0 = QL; VALID = true; } \
        else { J = (int)(tk_ >> 8); const int g_ = (int)(tk_ & 0xffu); const int cnt_ = (int)CNT[J]; const int idx_ = 32 * g_ + r32; VALID = idx_ < cnt_; const unsigned e_ = LIST[J * 256 + (VALID ? idx_ : 32 * g_)]; \
               QL = (int)(e_ & 0xffu); SLOT = (int)(e_ >> 8); NKB = 8; DIST0 = 1 << 20; } } while (0)
        MB_DECODE(t, c_j, c_nkb, c_slot, c_ql, c_dist0, c_valid, c_own, c_mem);
        bf16x8 qf[4], qfn[4], kA[4], vA[4], kB[4], vB[4];
        const bf16* MKFh = (const bf16*)(ws + WS_MEMKF) + (size_t)bh * 8 * 2048; const bf16* MVFh = (const bf16*)(ws + WS_MEMVF) + (size_t)bh * 8 * 2048; const float MBM = GT[193];
        { const bf16* qrow = Qh + (size_t)c_ql * INW + 8 * hi + (c_mem ? 768 : 0);
#pragma unroll
          for (int ks = 0; ks < 4; ++ks) qf[ks] = *(const GAS bf16x8*)(qrow + 16 * ks); }
        const bf16* kp = c_mem ? MKFh : KFh + (size_t)c_j * 16384; const bf16* vp = c_mem ? MVFh : VFh + (size_t)c_j * 16384;
#define MB_LOADF(F_, P, KB) do { const GAS char* b_ = (const GAS char*)((P) + (KB) * 2048); _Pragma("unroll") for (int f = 0; f < 4; ++f) F_[f] = *(const GAS bf16x8*)(b_ + f * 1024 + loffB); } while (0)
#define MB_QK(K_, KB) const float c0_ = __builtin_fmaf(c_slope, (float)(32 * (KB)), cqh); f32x16 sc; _Pragma("unroll") for (int r = 0; r < 16; ++r) sc[r] = __builtin_fmaf(c_slope, (float)((r & 3) + 8 * (r >> 2)), c0_); \
        _Pragma("unroll") for (int ks = 0; ks < 4; ++ks) sc = __builtin_amdgcn_mfma_f32_32x32x16_bf16(K_[ks], qf[ks], sc, 0, 0, 0);
#define MB_PV(V_, KB) \
        if (c_own) { _Pragma("unroll") for (int r = 0; r < 16; ++r) { float pr = __builtin_amdgcn_exp2f(sc[r]); if (32 * (KB) + crow(r, hi) > c_dist0) pr = 0.f; sc[r] = pr; ls += pr; } } \
        else { _Pragma("unroll") for (int r = 0; r < 16; ++r) { const float pr = __builtin_amdgcn_exp2f(sc[r]); sc[r] = pr; ls += pr; } } \
        v4u w0_, w1_; w0_.x = cvtpk(sc[0], sc[1]); w0_.y = cvtpk(sc[2], sc[3]); w0_.z = cvtpk(sc[4], sc[5]); w0_.w = cvtpk(sc[6], sc[7]); w1_.x = cvtpk(sc[8], sc[9]); w1_.y = cvtpk(sc[10], sc[11]); w1_.z = cvtpk(sc[12], sc[13]); w1_.w = cvtpk(sc[14], sc[15]); \
        const bf16x8 p0_ = __builtin_bit_cast(bf16x8, w0_), p1_ = __builtin_bit_cast(bf16x8, w1_); \
        o0 = __builtin_amdgcn_mfma_f32_32x32x16_bf16(V_[0], p0_, o0, 0, 0, 0); o0 = __builtin_amdgcn_mfma_f32_32x32x16_bf16(V_[1], p1_, o0, 0, 0, 0); \
        o1 = __builtin_amdgcn_mfma_f32_32x32x16_bf16(V_[2], p0_, o1, 0, 0, 0); o1 = __builtin_amdgcn_mfma_f32_32x32x16_bf16(V_[3], p1_, o1, 0, 0, 0);
#define MB_SB __builtin_amdgcn_sched_barrier(0)
#define MB_PINK asm volatile("" :: "v"(sc) : "memory")
#define MB_PINV asm volatile("" :: "v"(o0), "v"(o1) : "memory")
        MB_LOADF(kA, kp, 0); MB_LOADF(vA, vp, 0); MB_LOADF(kB, kp, 1); MB_LOADF(vB, vp, 1);
#pragma unroll 1
        for (;;) {
            const int tn = t + 8; const bool has_next = tn < ntasks;
            int n_j = 0, n_nkb = 0, n_slot = 0, n_ql = 0, n_dist0 = 0; bool n_valid = false, n_own = false, n_mem = false;
            const bf16* kpn = kp; const bf16* vpn = vp;
            if (has_next) { MB_DECODE(tn, n_j, n_nkb, n_slot, n_ql, n_dist0, n_valid, n_own, n_mem);
                const bf16* qrow = Qh + (size_t)n_ql * INW + 8 * hi + (n_mem ? 768 : 0);
#pragma unroll
                for (int ks = 0; ks < 4; ++ks) qfn[ks] = *(const GAS bf16x8*)(qrow + 16 * ks);
                kpn = n_mem ? MKFh : KFh + (size_t)n_j * 16384; vpn = n_mem ? MVFh : VFh + (size_t)n_j * 16384; }
            const float c_slope = c_mem ? 0.f : slopeL;
            const float cq = c_mem ? -MBM : -MB2 - slopeL * (float)((qb - c_j) * 256 + c_ql);
            const float cqh = __builtin_fmaf(c_slope, (float)(4 * hi), cq);
            f32x16 o0, o1; float ls = 0.f;
#pragma unroll
            for (int r = 0; r < 16; ++r) { o0[r] = 0.f; o1[r] = 0.f; }
#pragma unroll 1
            for (int kb = 0; kb < c_nkb; kb += 2) {
                const bool more = kb + 2 < c_nkb; const bf16* kq = more ? kp : kpn; const bf16* vq = more ? vp : vpn; const int kbq = more ? kb + 2 : 0;
                { MB_QK(kA, kb) MB_PINK; MB_LOADF(kA, kq, kbq); MB_SB; MB_PV(vA, kb) MB_PINV; MB_LOADF(vA, vq, kbq); MB_SB; }
                { MB_QK(kB, kb + 1) MB_PINK; MB_LOADF(kB, kq, kbq + 1); MB_SB; MB_PV(vB, kb + 1) MB_PINV; MB_LOADF(vB, vq, kbq + 1); MB_SB; }
            }
            ls += __shfl_xor(ls, 32);
            if (c_mem) { const float il = 1.0f / ls; bf16* dst = MIX + (rb + (size_t)qb * 256 + c_ql) * D + 768 + h * 64;
#pragma unroll
                for (int q4 = 0; q4 < 4; ++q4) { uint2 w;
                    w.x = cvtpk(o0[4 * q4] * il, o0[4 * q4 + 1] * il); w.y = cvtpk(o0[4 * q4 + 2] * il, o0[4 * q4 + 3] * il); *(uint2*)(dst + 8 * q4 + 4 * hi) = w;
                    w.x = cvtpk(o1[4 * q4] * il, o1[4 * q4 + 1] * il); w.y = cvtpk(o1[4 * q4 + 2] * il, o1[4 * q4 + 3] * il); *(uint2*)(dst + 32 + 8 * q4 + 4 * hi) = w; } }
            else if (c_valid) { LAS unsigned char* rowp = SLOT + (c_slot * 256 + c_ql) * 128; const int sw = c_ql & 15;
                typedef unsigned u2v __attribute__((ext_vector_type(2)));
#pragma unroll
                for (int q4 = 0; q4 < 4; ++q4) { *(LAS u2v*)(rowp + (((2 * q4 + hi) ^ sw) << 3)) = (u2v){cvtpk(o0[4 * q4], o0[4 * q4 + 1]), cvtpk(o0[4 * q4 + 2], o0[4 * q4 + 3])};
                    *(LAS u2v*)(rowp + (((8 + 2 * q4 + hi) ^ sw) << 3)) = (u2v){cvtpk(o1[4 * q4], o1[4 * q4 + 1]), cvtpk(o1[4 * q4 + 2], o1[4 * q4 + 3])}; }
                if (hi == 0) LACC[c_slot * 256 + c_ql] = ls; }
            if (!has_next) break;
            t = tn; c_j = n_j; c_nkb = n_nkb; c_slot = n_slot; c_ql = n_ql; c_dist0 = n_dist0; c_valid = n_valid; c_own = n_own; c_mem = n_mem; kp = kpn; vp = vpn;
#pragma unroll
            for (int ks = 0; ks < 4; ++ks) qf[ks] = qfn[ks];
        }
#undef MB_DECODE
#undef MB_LOADF
#undef MB_QK
#undef MB_PV
#undef MB_SB
#undef MB_PINK
#undef MB_PINV
    }
#else
    for (int rst_ = 0; rst_ < REP_MB_STREAM; ++rst_)
    if (wave < ntasks) {
        int lane; asm volatile("v_mbcnt_lo_u32_b32 %0, -1, 0\n\tv_mbcnt_hi_u32_b32 %0, -1, %0" : "=v"(lane));
        const int r32 = lane & 31, hi = lane >> 5;
        int t = wave;
        int c_j, c_nkb, c_slot, c_ql, c_dist0; bool c_valid, c_own;
#define MB_DECODE(T, J, NKB, SLOT, QL, DIST0, VALID, OWN) do { const unsigned tk_ = TASKS[T]; \
        if (tk_ & 0x4000u) { QL = (int)(tk_ & 7u) * 32 + r32; SLOT = 4; J = 0; NKB = 8; DIST0 = 1 << 20; VALID = true; OWN = false; } \
        else if (tk_ & 0x8000u) { const int w_ = (int)(tk_ & 7u); QL = w_ * 32 + r32; SLOT = 3; J = qb; NKB = (w_ + 2) & ~1; DIST0 = QL; VALID = true; OWN = true; } \
        else { J = (int)(tk_ >> 8); const int g_ = (int)(tk_ & 0xffu); const int cnt_ = (int)CNT[J]; const int idx_ = 32 * g_ + r32; VALID = idx_ < cnt_; const unsigned e_ = LIST[J * 256 + (VALID ? idx_ : 32 * g_)]; \
               QL = (int)(e_ & 0xffu); SLOT = (int)(e_ >> 8); NKB = 8; DIST0 = 1 << 20; OWN = false; } } while (0)
        MB_DECODE(t, c_j, c_nkb, c_slot, c_ql, c_dist0, c_valid, c_own);
        bf16x8 qf[4], qfn[4], kA[4], vA[4], kB[4], vB[4];
        const bf16* MKFh = (const bf16*)(ws + WS_MEMKF) + (size_t)bh * 8 * 2048; const bf16* MVFh = (const bf16*)(ws + WS_MEMVF) + (size_t)bh * 8 * 2048; const float MBM = GT[193];
        { const bf16* qrow = Qh + (size_t)c_ql * INW + 8 * hi + (c_slot == 4 ? 768 : 0);
#pragma unroll
          for (int ks = 0; ks < 4; ++ks) qf[ks] = *(const GAS bf16x8*)(qrow + 16 * ks); }
        const bf16* kp = (c_slot == 4 ? MKFh : KFh + (size_t)c_j * 16384) + lane * 8; const bf16* vp = (c_slot == 4 ? MVFh : VFh + (size_t)c_j * 16384) + lane * 8;
#ifdef MB_PROBE_VAR
        const int pvar_ = (REP_MB_STREAM == 2 && rst_ == 0) ? MB_PROBE_VAR : 0;
#define MB_KBE(KB) (pvar_ == 1 ? 0 : (KB))
#define MB_NOEXP (pvar_ == 2)
#define MB_NOMMA (pvar_ == 3)
#define MB_NKB(n) (pvar_ == 4 ? 0 : (n))
#else
#define MB_NKB(n) (n)
#define MB_KBE(KB) (KB)
#define MB_NOEXP false
#define MB_NOMMA false
#endif
#define MB_LOADK(K_, KP, KB) do { _Pragma("unroll") for (int f = 0; f < 4; ++f) K_[f] = *(const GAS bf16x8*)((KP) + (MB_KBE(KB) * 4 + f) * 512); } while (0)
#define MB_LOADV(V_, VP, KB) do { _Pragma("unroll") for (int f = 0; f < 4; ++f) V_[f] = *(const GAS bf16x8*)((VP) + (MB_KBE(KB) * 4 + f) * 512); } while (0)
#define MB_LOAD(K_, V_, KP, VP, KB) do { MB_LOADK(K_, KP, KB); MB_LOADV(V_, VP, KB); } while (0)
#define MB_QK(K_, KB) const float c0_ = __builtin_fmaf(c_slope, (float)(32 * (KB)), cqh); f32x16 sc; _Pragma("unroll") for (int r = 0; r < 16; ++r) sc[r] = __builtin_fmaf(c_slope, (float)((r & 3) + 8 * (r >> 2)), c0_); \
        if (!MB_NOMMA) { _Pragma("unroll") for (int ks = 0; ks < 4; ++ks) sc = __builtin_amdgcn_mfma_f32_32x32x16_bf16(K_[ks], qf[ks], sc, 0, 0, 0); }
#define MB_PV(V_, KB) \
        if (MB_NOEXP) { _Pragma("unroll") for (int r = 0; r < 16; ++r) ls += sc[r]; } else \
        if (c_own) { _Pragma("unroll") for (int r = 0; r < 16; ++r) { float pr = __builtin_amdgcn_exp2f(sc[r]); if (32 * (KB) + crow(r, hi) > c_dist0) pr = 0.f; sc[r] = pr; ls += pr; } } \
        else { _Pragma("unroll") for (int r = 0; r < 16; ++r) { const float pr = __builtin_amdgcn_exp2f(sc[r]); sc[r] = pr; ls += pr; } } \
        v4u w0_, w1_; w0_.x = cvtpk(sc[0], sc[1]); w0_.y = cvtpk(sc[2], sc[3]); w0_.z = cvtpk(sc[4], sc[5]); w0_.w = cvtpk(sc[6], sc[7]); w1_.x = cvtpk(sc[8], sc[9]); w1_.y = cvtpk(sc[10], sc[11]); w1_.z = cvtpk(sc[12], sc[13]); w1_.w = cvtpk(sc[14], sc[15]); \
        const bf16x8 p0_ = __builtin_bit_cast(bf16x8, w0_), p1_ = __builtin_bit_cast(bf16x8, w1_); \
        if (!MB_NOMMA) { o0 = __builtin_amdgcn_mfma_f32_32x32x16_bf16(V_[0], p0_, o0, 0, 0, 0); o0 = __builtin_amdgcn_mfma_f32_32x32x16_bf16(V_[1], p1_, o0, 0, 0, 0); \
        o1 = __builtin_amdgcn_mfma_f32_32x32x16_bf16(V_[2], p0_, o1, 0, 0, 0); o1 = __builtin_amdgcn_mfma_f32_32x32x16_bf16(V_[3], p1_, o1, 0, 0, 0); } \
        else { _Pragma("unroll") for (int f = 0; f < 4; ++f) asm volatile("" :: "v"(V_[f])); asm volatile("" :: "v"(p0_), "v"(p1_)); }
#define MB_COMP(K_, V_, KB) do { MB_QK(K_, KB) MB_PV(V_, KB) } while (0)
        MB_LOAD(kA, vA, kp, vp, 0);
#pragma unroll 1
        for (;;) {
            const int tn = t + 8; const bool has_next = tn < ntasks;
            int n_j = 0, n_nkb = 0, n_slot = 0, n_ql = 0, n_dist0 = 0; bool n_valid = false, n_own = false;
            const bf16* kpn = kp; const bf16* vpn = vp;
            if (has_next) { MB_DECODE(tn, n_j, n_nkb, n_slot, n_ql, n_dist0, n_valid, n_own);
                const bf16* qrow = Qh + (size_t)n_ql * INW + 8 * hi + (n_slot == 4 ? 768 : 0);
#pragma unroll
                for (int ks = 0; ks < 4; ++ks) qfn[ks] = *(const GAS bf16x8*)(qrow + 16 * ks);
                kpn = (n_slot == 4 ? MKFh : KFh + (size_t)n_j * 16384) + lane * 8; vpn = (n_slot == 4 ? MVFh : VFh + (size_t)n_j * 16384) + lane * 8; }
            const float c_slope = c_slot == 4 ? 0.f : slopeL;
            const float cq = c_slot == 4 ? -MBM : -MB2 - slopeL * (float)((qb - c_j) * 256 + c_ql);
            const float cqh = __builtin_fmaf(c_slope, (float)(4 * hi), cq);
            f32x16 o0, o1; float ls = 0.f;
#pragma unroll
            for (int r = 0; r < 16; ++r) { o0[r] = 0.f; o1[r] = 0.f; }
#pragma unroll 1
            for (int kb = 0; kb < MB_NKB(c_nkb); kb += 2) {
                MB_LOAD(kB, vB, kp, vp, kb + 1);
                MB_COMP(kA, vA, kb);
                { const bool more = kb + 2 < c_nkb; const bf16* kq = more ? kp : kpn; const bf16* vq = more ? vp : vpn; const int kbq = more ? kb + 2 : 0;
                  MB_LOAD(kA, vA, kq, vq, kbq); }
                MB_COMP(kB, vB, kb + 1);
            }
            ls += __shfl_xor(ls, 32);
            if (c_slot == 4) { const float il = 1.0f / ls; bf16* dst = MIX + (rb + (size_t)qb * 256 + c_ql) * D + 768 + h * 64;
#pragma unroll
                for (int q4 = 0; q4 < 4; ++q4) { uint2 w;
                    w.x = cvtpk(o0[4 * q4] * il, o0[4 * q4 + 1] * il); w.y = cvtpk(o0[4 * q4 + 2] * il, o0[4 * q4 + 3] * il); *(uint2*)(dst + 8 * q4 + 4 * hi) = w;
                    w.x = cvtpk(o1[4 * q4] * il, o1[4 * q4 + 1] * il); w.y = cvtpk(o1[4 * q4 + 2] * il, o1[4 * q4 + 3] * il); *(uint2*)(dst + 32 + 8 * q4 + 4 * hi) = w; } }
            else if (c_valid) { LAS unsigned char* rowp = SLOT + (c_slot * 256 + c_ql) * 128; const int sw = c_ql & 15;
                typedef unsigned u2v __attribute__((ext_vector_type(2)));
#pragma unroll
                for (int q4 = 0; q4 < 4; ++q4) { *(LAS u2v*)(rowp + (((2 * q4 + hi) ^ sw) << 3)) = (u2v){cvtpk(o0[4 * q4], o0[4 * q4 + 1]), cvtpk(o0[4 * q4 + 2], o0[4 * q4 + 3])};
                    *(LAS u2v*)(rowp + (((8 + 2 * q4 + hi) ^ sw) << 3)) = (u2v){cvtpk(o1[4 * q4], o1[4 * q4 + 1]), cvtpk(o1[4 * q4 + 2], o1[4 * q4 + 3])}; }
                if (hi == 0) LACC[c_slot * 256 + c_ql] = ls; }
            if (!has_next) break;
            t = tn; c_j = n_j; c_nkb = n_nkb; c_slot = n_slot; c_ql = n_ql; c_dist0 = n_dist0; c_valid = n_valid; c_own = n_own; kp = kpn; vp = vpn;
#pragma unroll
            for (int ks = 0; ks < 4; ++ks) qf[ks] = qfn[ks];
        }
#undef MB_DECODE
#undef MB_LOAD
#undef MB_COMP
#undef MB_QK
#undef MB_PV
#undef MB_LOADK
#undef MB_LOADV
    }
#endif
    __syncthreads();
    { int lane; asm volatile("v_mbcnt_lo_u32_b32 %0, -1, 0\n\tv_mbcnt_hi_u32_b32 %0, -1, %0" : "=v"(lane)); const int tid = wave * 64 + lane;
      const int row = tid >> 1, half = tid & 1; const int nok = qb < 3 ? qb : 3; const int sw = row & 15;
      typedef unsigned u2v __attribute__((ext_vector_type(2)));
      float acc[32]; float l = LACC[3 * 256 + row];
      { const LAS unsigned char* rowp = SLOT + (3 * 256 + row) * 128;
#pragma unroll
        for (int c = 0; c < 8; ++c) { const u2v w = *(const LAS u2v*)(rowp + (((8 * half + c) ^ sw) << 3)); acc[4 * c] = bflo(w.x); acc[4 * c + 1] = bfhi(w.x); acc[4 * c + 2] = bflo(w.y); acc[4 * c + 3] = bfhi(w.y); } }
#pragma unroll
      for (int s = 0; s < 3; ++s) if (s < nok) { const LAS unsigned char* rowp = SLOT + (s * 256 + row) * 128; l += LACC[s * 256 + row];
#pragma unroll
        for (int c = 0; c < 8; ++c) { const u2v w = *(const LAS u2v*)(rowp + (((8 * half + c) ^ sw) << 3)); acc[4 * c] += bflo(w.x); acc[4 * c + 1] += bfhi(w.x); acc[4 * c + 2] += bflo(w.y); acc[4 * c + 3] += bfhi(w.y); } }
      const float il = 1.0f / l;
      uint4* dst = (uint4*)(MIX + (rb + (size_t)qb * 256 + row) * D + 512 + h * 64 + half * 32);
#pragma unroll
      for (int c = 0; c < 4; ++c) { uint4 w; w.x = cvtpk(acc[8 * c] * il, acc[8 * c + 1] * il); w.y = cvtpk(acc[8 * c + 2] * il, acc[8 * c + 3] * il); w.z = cvtpk(acc[8 * c + 4] * il, acc[8 * c + 5] * il); w.w = cvtpk(acc[8 * c + 6] * il, acc[8 * c + 7] * il); dst[c] = w; } }
    __syncthreads();
}
__device__ __forceinline__ void memattn_unit(unsigned char* ws, int bh, int qb, int wave, int lane) {
    const bf16* U = (const bf16*)(ws + WS_U); bf16* MIX = (bf16*)(ws + WS_MIX); const float* GT = (const float*)(ws + WS_GAINS);
    const int b = bh >> 2, h = bh & 3, r32 = lane & 31, hi = lane >> 5;
    const size_t row = (size_t)b * SEQ + qb * 256 + wave * 32 + r32;
    const bf16* KFh = (const bf16*)(ws + WS_MEMKF) + (size_t)bh * 8 * 2048;
    const bf16* VFh = (const bf16*)(ws + WS_MEMVF) + (size_t)bh * 8 * 2048;
    f32x16 o0, o1; float ls;
    attn_task(o0, o1, ls, U + row * INW + 1792 + h * 64, KFh, VFh, 8, -GT[193], 0.f, 1 << 20, lane);
    ls += __shfl_xor(ls, 32);
    const float il = 1.0f / ls;
    bf16* dst = MIX + row * D + 768 + h * 64;
#pragma unroll
    for (int q4 = 0; q4 < 4; ++q4) { uint2 w;
        w.x = cvtpk(o0[4 * q4] * il, o0[4 * q4 + 1] * il); w.y = cvtpk(o0[4 * q4 + 2] * il, o0[4 * q4 + 3] * il); *(uint2*)(dst + 8 * q4 + 4 * hi) = w;
        w.x = cvtpk(o1[4 * q4] * il, o1[4 * q4 + 1] * il); w.y = cvtpk(o1[4 * q4 + 2] * il, o1[4 * q4 + 3] * il); *(uint2*)(dst + 32 + 8 * q4 + 4 * hi) = w; }
}
struct Args { const float* in[24]; float* out; unsigned char* ws; int ph_lo, ph_hi; };
__global__ void __launch_bounds__(NWAVES * 64, 2) hymba_fwd(Args args) {
    extern __shared__ __attribute__((aligned(16))) unsigned char lds[];
    LAS unsigned char* L = (LAS unsigned char*)lds;
    volatile LAS unsigned* MISC = (volatile LAS unsigned*)(L + MISC_OFF);
    const int wave = __builtin_amdgcn_readfirstlane(threadIdx.x >> 6);
#define LANE_TID() int lane; asm volatile("v_mbcnt_lo_u32_b32 %0, -1, 0\n\tv_mbcnt_hi_u32_b32 %0, -1, %0" : "=v"(lane)); const int tid = wave * 64 + lane; (void)tid
    const int G = gridDim.x; const int bx = blockIdx.x; const int vcu = (G % 8 == 0) ? (bx % 8) * (G / 8) + bx / 8 : bx;
    unsigned char* const ws0 = args.ws; const float* const* in = args.in; float* out = args.out;
    gu32* ctl = (gu32*)(ws0 + WS_CTL);
    { LANE_TID(); for (int u = tid; u < (LDS_BYTES - LDSCTL_OFF) / 4; u += NWAVES * 64) ((LAS unsigned*)(L + LDSCTL_OFF))[u] = 0u; }
    __syncthreads();
    XcdBarrier bar; bar.bar = (unsigned*)(ctl + CW_BAR); bar.x = 0; bar.st = nullptr; bar.wave = wave;
    if (N_LAUNCHES == 1) bar = xcd_barrier_post((unsigned*)(ctl + CW_BAR), MISC + 8, wave);
#define GRID_BAR() do { if (N_LAUNCHES == 1) xcd_barrier(bar); } while (0)
#ifdef WT_ALL
#define GRID_BAR_NW() do { if (N_LAUNCHES == 1) xcd_barrier(bar, false); } while (0)
#else
#define GRID_BAR_NW() GRID_BAR()
#endif
#ifdef LABEL_BARS
#define LABEL_BAR(sig, e, need) do { if (N_LAUNCHES == 1) { if (G % 8 == 0) label_barrier((unsigned*)ctl, (unsigned*)(ctl + CW_BAR), bx & 7, (unsigned)(G / 8), wave, (sig), (unsigned*)(ctl + LB_EV(e)), (unsigned)(need)); else xcd_barrier(bar); } } while (0)
#else
#define LABEL_BAR(sig, e, need) GRID_BAR()
#endif
    const int lo = args.ph_lo, hi = args.ph_hi;
#ifndef PH_MASK
#define PH_MASK 0x1ff
#endif
#define IN(k) (((PH_MASK >> (k)) & 1) && lo <= (k) && (k) < hi)
#define BOTH(k) (IN(k) && IN((k) + 1))
#ifndef REP_MASK
#define REP_MASK 0
#endif
#define REPS(k) (((REP_MASK >> (k)) & 1) ? 2 : 1)
#ifndef REP_SUB
#define REP_SUB 0
#endif
#define RSUB(k) for (int rs_ = 0; rs_ < (((REP_SUB >> (k)) & 1) ? 2 : 1); ++rs_)
#define WSP() unsigned char* ws = ws0; asm volatile("" : "+s"(ws)); (void)ws
#define XB ((bf16*)(ws + WS_XB))
#define HB ((bf16*)(ws + WS_H))
#define UB ((bf16*)(ws + WS_U))
#define MIX ((bf16*)(ws + WS_MIX))
#define SSQ0 ((float*)(ws + WS_SSQ0))
#define SSQ1 ((float*)(ws + WS_SSQ1))
#define SSQ2 ((float*)(ws + WS_SSQ2))

    for (int rep = 0; rep < REPS(0); ++rep) if (IN(0)) { WSP(); LANE_TID(); p0_prologue(in, ws, L, vcu, G, wave, lane);
        if (bx == 0 && tid < 192) wt_st4f((float*)(ws + WS_GAINS) + tid, (tid < 64 ? in[15][tid] : tid < 128 ? in[16][tid - 64] : in[18][tid - 128]));
        if (bx == 0 && tid < 64) wt_st4f((float*)(ws + WS_GAINS) + 256 + tid, in[19][tid]);
        if (bx == 1) { float* PTB = (float*)(ws + WS_PTAB);
            for (int i = tid; i < 8 * 512; i += 512) { const int row = i >> 9, gc = i & 511; float v;
                if (row < 4) v = in[8][row * 512 + gc]; else if (row == 4) v = in[9][gc]; else if (row == 5) v = -8.0f * 1.4426950408889634f * log1pf(__expf(-in[14][gc])); else if (row == 6) v = 1.4426950408889634f * in[11][gc]; else v = 1.4426950408889634f * in[13][gc];
                wt_st4f(PTB + i, v); } }
        if (bx == 0 && wave == 3) {
            const float mq = wave_max(fabsf(in[15][lane])), mk = wave_max(fabsf(in[16][lane])), cq = wave_max(fabsf(in[18][lane])), ck = wave_max(fabsf(in[19][lane]));
            if (lane == 0) { wt_st4f((float*)(ws + WS_GAINS) + 192, 8.0f * mq * mk * 1.4426950408889634f); wt_st4f((float*)(ws + WS_GAINS) + 193, 8.0f * cq * ck * 1.4426950408889634f); } } if (BOTH(0)) GRID_BAR_NW(); }
    for (int rep = 0; rep < REPS(1); ++rep) if (IN(1)) { WSP();
        pg8::Gemm g{XB, (const bf16*)(ws + WS_W1I), M, 2 * FF, D}; pg8::StaticOrder S; S.init(M, 2 * FF, G, bx);
#ifdef PROBE_NOMMA
        g.nomma = (REPS(1) == 2 && rep == 0) ? 1 : 0;
#endif
        pg8::EpiSwiGLU E{HB, FF, SSQ0};
        pg8::gemm_phase<pg8::EpiSwiGLU, pg8::StaticOrder, PG8_ALIGN, PG8_SP2>(L + RING_OFF, g, S, E, wave);
        bool tail1 = false; int ntail1 = 0;
        { pg8::Unit u6; const int nwg = (M / 256) * (2 * FF / 256), nshort = (nwg % G) ? G - nwg % G : 0;
          if (nshort > 0 && !S.next(nwg / G, u6)) { __syncthreads(); LANE_TID(); memkv_items(ws, L, bx - (G - nshort), nshort, wave, lane);
              p0_weights<1>(in, ws, L, (bx - (G - nshort)) * NWAVES + wave, nshort * NWAVES, wave, lane); tail1 = true; }
          else if (nshort == 0) { __syncthreads(); LANE_TID(); p0_weights<1>(in, ws, L, vcu * NWAVES + wave, G * NWAVES, wave, lane); tail1 = true; }
          ntail1 = nshort > 0 ? nshort : G; }
        if (BOTH(1)) GRID_BAR_NW();
    }
    for (int rep = 0; rep < REPS(2); ++rep) if (IN(2)) { WSP();
        pg8::Gemm g{HB, (const bf16*)(ws + WS_W1O), M, D, FF}; pg8::StaticOrder S; S.init(M, D, G, bx);
        pg8::EpiResid E{XB, XB, nullptr, SSQ1, 0.5f};
        pg8::gemm_phase<pg8::EpiResid, pg8::StaticOrder, false, PG8_SP2>(L + RING_OFF, g, S, E, wave);
        if (BOTH(2)) GRID_BAR_NW();
    }
    for (int rep = 0; rep < REPS(3); ++rep) if (IN(3)) { WSP();
        pg8::Gemm g{XB, (const bf16*)(ws + WS_WIN), M, INW, D}; pg8::StaticOrder S; S.init(M, INW, G, bx);
        pg8::EpiWin E{UB, SSQ1, (const float*)(ws + WS_GAINS)};
        pg8::gemm_phase<pg8::EpiWin, pg8::StaticOrder, PG8_ALIGN, PG8_SP2>(L + RING_OFF, g, S, E, wave);
        if (BOTH(3)) GRID_BAR_NW();
    }
#ifdef EXTRA_BARS
    for (int eb = 0; eb < EXTRA_BARS; ++eb) GRID_BAR();
#endif
    for (int rep = 0; rep < REPS(4); ++rep) if (IN(4)) {
        RSUB(0) { WSP(); LANE_TID(); lru_items<true>(ws, L, G, wave, tid); }
        RSUB(1) { WSP(); LANE_TID(); kvprep_items(ws, L, G, wave, lane, tid); }
        if ((((M / 256) * (2 * FF / 256)) % G) == 0) RSUB(2) { WSP(); LANE_TID(); memkv_items(ws, L, vcu, G, wave, lane); }
        if (BOTH(4)) GRID_BAR();
    }
    for (int rep = 0; rep < REPS(5); ++rep) if (IN(5)) {
#ifndef NO_MOBA
        RSUB(4) { WSP(); LANE_TID(); for (int id = vcu; id < BATCH * 4 * NBLK; id += G) moba_unit(ws, L, id >> 5, id & 31, wave, lane, tid); }
#endif
        if (BOTH(5)) GRID_BAR();
    }
    if (IN(6)) { WSP();
        pg8::Gemm g{MIX, (const bf16*)(ws + WS_WOUT), M, D, D}; pg8::StaticOrder S; S.init(M, D, G, bx);
        pg8::EpiResid E{XB, XB, nullptr, SSQ2, 1.0f};
        pg8::gemm_phase<pg8::EpiResid, pg8::StaticOrder, false, PG8_SP2>(L + RING_OFF, g, S, E, wave);
        if (BOTH(6)) GRID_BAR_NW();
    }
    for (int rep = 0; rep < REPS(7); ++rep) if (IN(7)) { WSP();
        pg8::Gemm g{XB, (const bf16*)(ws + WS_W2I), M, 2 * FF, D}; pg8::StaticOrder S; S.init(M, 2 * FF, G, bx);
#ifdef PROBE_NOMMA
        g.nomma = (REPS(7) == 2 && rep == 0) ? 1 : 0;
#endif
        pg8::EpiSwiGLU E{HB, FF, SSQ2};
        pg8::gemm_phase<pg8::EpiSwiGLU, pg8::StaticOrder, PG8_ALIGN, PG8_SP2>(L + RING_OFF, g, S, E, wave);
        bool tail7 = false; int ntail7 = 0;
        { pg8::Unit u6; const int nwg = (M / 256) * (2 * FF / 256), nshort = (nwg % G) ? G - nwg % G : 0;
          if (rep == 0) { if (nshort > 0 && !S.next(nwg / G, u6)) { __syncthreads(); LANE_TID(); p0_weights<2>(in, ws, L, (bx - (G - nshort)) * NWAVES + wave, nshort * NWAVES, wave, lane); tail7 = true; }
                          else if (nshort == 0) { __syncthreads(); LANE_TID(); p0_weights<2>(in, ws, L, vcu * NWAVES + wave, G * NWAVES, wave, lane); tail7 = true; } }
          ntail7 = nshort > 0 ? nshort : G; }
        if (BOTH(7)) GRID_BAR_NW();
    }
    for (int rep = 0; rep < REPS(8); ++rep) if (IN(8)) { WSP();
        pg8::Gemm g{HB, (const bf16*)(ws + WS_W2O), M, D, FF}; pg8::StaticOrder S; S.init(M, D, G, bx);
        pg8::EpiResid E{XB, nullptr, out, nullptr, 0.5f};
        pg8::gemm_phase<pg8::EpiResid, pg8::StaticOrder, false, PG8_SP2>(L + RING_OFF, g, S, E, wave);
        if (rep + 1 < REPS(8)) GRID_BAR();
    }
#undef IN
#undef BOTH
}

extern "C" void kernel_launch(void* const* d_in, const int* in_sizes, int n_in, void* d_out, int out_size, void* d_ws, size_t ws_size, hipStream_t stream) {
    static int grid = 0;
    if (grid == 0) {
        if (n_in != 24 || in_sizes[0] != M * D || out_size != M * D || ws_size < WS_END) { fprintf(stderr, "kernel_launch: unexpected shapes (n_in %d, in0 %d, out %d, ws %zu); nothing launched\n", n_in, n_in > 0 ? in_sizes[0] : -1, out_size, ws_size); grid = -1; return; }
        int dev = 0, cus = 0, per_cu = 0;
        if (hipGetDevice(&dev) != hipSuccess || hipDeviceGetAttribute(&cus, hipDeviceAttributeMultiprocessorCount, dev) != hipSuccess) { fprintf(stderr, "kernel_launch: device query failed\n"); grid = -1; return; }
        if (hipFuncSetAttribute((const void*)hymba_fwd, hipFuncAttributeMaxDynamicSharedMemorySize, LDS_BYTES) != hipSuccess) { fprintf(stderr, "kernel_launch: hipFuncSetAttribute failed\n"); grid = -1; return; }
        if (hipOccupancyMaxActiveBlocksPerMultiprocessor(&per_cu, (const void*)hymba_fwd, NWAVES * 64, LDS_BYTES) != hipSuccess) per_cu = 0;
        (void)hipGetLastError();
        if (per_cu < 1 || cus * per_cu < 256) { fprintf(stderr, "kernel_launch: the persistent grid of 256 workgroups is not resident (cus %d, per_cu %d); nothing launched\n", cus, per_cu); grid = -1; return; }
        grid = 256;
    }
    if (grid < 0) return;
    if (hipMemsetAsync((char*)d_ws + WS_CTL, 0, CTL_ZERO_BYTES, stream) != hipSuccess) { fprintf(stderr, "kernel_launch: hipMemsetAsync failed\n"); return; }
    Args a{};
    for (int i = 0; i < 24; ++i) a.in[i] = (const float*)d_in[i];
    a.out = (float*)d_out; a.ws = (unsigned char*)d_ws;
    if (N_LAUNCHES == 1) { a.ph_lo = 0; a.ph_hi = NPHASE; hipLaunchKernelGGL(hymba_fwd, dim3(grid), dim3(NWAVES * 64), LDS_BYTES, stream, a); }
    else for (int p = 0; p < NPHASE; ++p) { a.ph_lo = p; a.ph_hi = p + 1; hipLaunchKernelGGL(hymba_fwd, dim3(grid), dim3(NWAVES * 64), LDS_BYTES, stream, a); }
    const hipError_t le = hipPeekAtLastError();
    if (le != hipSuccess) fprintf(stderr, "kernel_launch: launch failed: %s\n", hipGetErrorName(le));
}
```

```cpp
#define PG8_RSLDS true
#define PG8_RESIDLDS true
#define WT_ALL 1
#define XB_EARLY_INV 1
#define LABEL_BARS 1
#include <hip/hip_runtime.h>
#include <cstdio>
#include <cstdint>
typedef unsigned wt_v4u __attribute__((ext_vector_type(4)));
typedef float wt_f4 __attribute__((ext_vector_type(4)));
#ifdef WT_ALL
__device__ __forceinline__ void wt_st16(void* p, wt_v4u v) { asm volatile("global_store_dwordx4 %0, %1, off sc1\n\ts_nop 1" :: "v"(p), "v"(v) : "memory"); }
__device__ __forceinline__ void wt_st16f(void* p, wt_f4 v) { asm volatile("global_store_dwordx4 %0, %1, off sc1\n\ts_nop 1" :: "v"(p), "v"(v) : "memory"); }
__device__ __forceinline__ void wt_st8(void* p, unsigned long long v) { __hip_atomic_store((unsigned long long*)p, v, __ATOMIC_RELAXED, __HIP_MEMORY_SCOPE_AGENT); }
__device__ __forceinline__ void wt_st4(void* p, unsigned v) { __hip_atomic_store((unsigned*)p, v, __ATOMIC_RELAXED, __HIP_MEMORY_SCOPE_AGENT); }
__device__ __forceinline__ void wt_st4f(void* p, float v) { __hip_atomic_store((float*)p, v, __ATOMIC_RELAXED, __HIP_MEMORY_SCOPE_AGENT); }
__device__ __forceinline__ void wt_st2(void* p, unsigned v) { asm volatile("global_store_short %0, %1, off sc1" :: "v"(p), "v"(v) : "memory"); }
#else
__device__ __forceinline__ void wt_st16(void* p, wt_v4u v) { *(__attribute__((address_space(1))) wt_v4u*)p = v; }
__device__ __forceinline__ void wt_st16f(void* p, wt_f4 v) { *(__attribute__((address_space(1))) wt_f4*)p = v; }
__device__ __forceinline__ void wt_st8(void* p, unsigned long long v) { *(__attribute__((address_space(1))) unsigned long long*)p = v; }
__device__ __forceinline__ void wt_st4(void* p, unsigned v) { *(__attribute__((address_space(1))) unsigned*)p = v; }
__device__ __forceinline__ void wt_st4f(void* p, float v) { *(__attribute__((address_space(1))) float*)p = v; }
__device__ __forceinline__ void wt_st2(void* p, unsigned v) { *(__attribute__((address_space(1))) unsigned short*)p = (unsigned short)v; }
#endif
#ifndef PG8_BTILED
#define PG8_BTILED 0
#endif
#ifndef PG8_SPLITEPI
#define PG8_SPLITEPI false
#endif
namespace pg8 {
#define PG8_LAS __attribute__((address_space(3)))
typedef unsigned short bf16_t;
typedef short bf16x8 __attribute__((ext_vector_type(8)));
typedef float f32x4 __attribute__((ext_vector_type(4)));
typedef unsigned u32x4 __attribute__((ext_vector_type(4)));
constexpr int BM = 256, BK = 64, HALF = 128, HTB = HALF * BK * 2  , STAGE_BYTES = 8 * HTB, NXCD = 8, WGM = 4;

__host__ __device__ __forceinline__ int lds_byte(int r, int c) { const int st = (r >> 4) * 2 + (c >> 5), rr = r & 15, cc = c & 31, ob = rr * 64 + cc * 2; return st * 1024 + (ob ^ (((ob >> 9) & 1) << 5)); }
__host__ __device__ __forceinline__ void stage_rc(int b, int& R, int& C) { const int st = b / 1024, sb = b % 1024, swz = sb ^ (((sb >> 9) & 1) << 5); R = (st >> 1) * 16 + swz / 64; C = (st & 1) * 32 + (swz % 64) / 2; }
__host__ __device__ __forceinline__ int perm32(int rho) { const int n = rho >> 4, i = rho & 15; return 8 * (i >> 2) + 4 * n + (i & 3); }

struct Unit { int pm, pn, hm; };
struct Gemm { const bf16_t* A; const bf16_t* Bt; int M, N, K; int nomma = 0; };

struct StaticOrder {
    int nM, nN, nwg, G, c;
    __host__ __device__ void init(int M, int N, int G_, int c_) { nM = M / BM; nN = N / BM; nwg = nM * nN; G = G_; c = c_; }
    __host__ __device__ bool map(long L, Unit& u) const {
        if (L >= nwg) return false;
        int wgid = (int)L; { const int q = nwg / NXCD, r = nwg % NXCD, xcd = wgid % NXCD, off = wgid / NXCD; wgid = (xcd < r ? xcd * (q + 1) : r * (q + 1) + (xcd - r) * q) + off; }
        const int nig = WGM * nN, gid = wgid / nig, fm = gid * WGM, gsz = (nM - fm) < WGM ? (nM - fm) : WGM;
        u.pm = fm + ((wgid % nig) % gsz); u.pn = (wgid % nig) / gsz; u.hm = 0; return true;
    }
    __host__ __device__ bool next(int i, Unit& u) const { return map((long)i * G + c, u); }
    __device__ __forceinline__ void a_ready(const Unit&) const {}
    __device__ __forceinline__ void done(const Unit&) const {}
};

__device__ __forceinline__ unsigned cvt_pk_bf16(float lo, float hi) { unsigned r; asm volatile("v_cvt_pk_bf16_f32 %0, %1, %2" : "=v"(r) : "v"(lo), "v"(hi)); return r; }
typedef float f32x2 __attribute__((ext_vector_type(2)));

template <class Epi, class Sched, bool ALIGN_EPI = false, bool SP2 = false>
__device__ __forceinline__ void gemm_phase(PG8_LAS unsigned char* lds, const Gemm g, const Sched& S, const Epi& E, const int wid) {
    int lane; asm volatile("v_mbcnt_lo_u32_b32 %0, -1, 0\n\tv_mbcnt_hi_u32_b32 %0, -1, %0" : "=v"(lane));
    const int tid = wid * 64 + lane, wr = wid >> 2, wc = wid & 3, fr = lane & 15, fq = lane >> 4;
    const int K = g.K, nt = K / BK;
    static_assert(!PG8_BTILED || SP2, "the tiled weight layout is wired into the SP2 loop only");
    unsigned voffA[2], voffB[2];
#pragma unroll
    for (int i = 0; i < 2; ++i) { int R, C; stage_rc(tid * 16 + i * 8192, R, C); const int Rb = Epi::PERM ? ((R & ~31) + perm32(R & 31)) : R;
        voffA[i] = (unsigned)(R * K + C) * 2u; voffB[i] = PG8_BTILED ? (unsigned)(tid * 16 + i * 8192) : (unsigned)(Rb * K + C) * 2u; }
    const size_t kstep = (size_t)(BK * 2);
    const size_t kstepB = PG8_BTILED ? (size_t)(HALF * BK * 2) : kstep;
    const size_t hstep = (size_t)HALF * K * 2;
    const size_t tstep = 2 * hstep;
    const unsigned ldsw = (unsigned)wid * 1024u;
    const int aoff = lds_byte(wr * 64 + fr, fq * 8), boff = lds_byte(wc * 32 + fr, fq * 8);
#define PG8_SA(b, h) (((b) * 2 + (h)) * HTB)
#define PG8_SB(b, h) ((4 + (b) * 2 + (h)) * HTB)
#define PG8_STAGE(bufoff, gbase, voff) do { _Pragma("unroll") for (int _i = 0; _i < 2; ++_i) \
        __builtin_amdgcn_global_load_lds((const unsigned*)((const char*)(gbase) + (voff)[_i]), (PG8_LAS unsigned*)(lds + (bufoff) + ldsw + _i * 8192), 16, 0, 0); } while (0)
#define PG8_LDA(dst, b, h) do { _Pragma("unroll") for (int m = 0; m < 4; ++m) _Pragma("unroll") for (int k = 0; k < 2; ++k) dst[m][k] = *(const PG8_LAS bf16x8*)(lds + PG8_SA(b, h) + aoff + m * 2048 + k * 1024); } while (0)
#define PG8_LDB(dst, b, h) do { _Pragma("unroll") for (int n = 0; n < 2; ++n) _Pragma("unroll") for (int k = 0; k < 2; ++k) dst[n][k] = *(const PG8_LAS bf16x8*)(lds + PG8_SB(b, h) + boff + n * 2048 + k * 1024); } while (0)
#define PG8_MMA(ai, bj, At, Bt) do { PG8_NOMMA_GUARD __builtin_amdgcn_s_setprio(1); _Pragma("unroll") for (int m = 0; m < 4; ++m) _Pragma("unroll") for (int n = 0; n < 2; ++n) _Pragma("unroll") for (int k = 0; k < 2; ++k) \
        { acc[ai][bj][m][n] = __builtin_amdgcn_mfma_f32_16x16x32_bf16(Bt[n][k], At[m][k], acc[ai][bj][m][n], 0, 0, 0); PG8_EXTRA_MFMA(acc[ai][bj][m][n], At[m][k]); } __builtin_amdgcn_s_setprio(0); } while (0)
#ifndef PG8_DMASPLIT
#define PG8_DMASPLIT 0
#endif
#ifdef PROBE_NOMMA
#define PG8_NOMMA_GUARD if (g.nomma) break;
#else
#define PG8_NOMMA_GUARD
#endif
#ifdef PROBE_DOUBLE_MFMA
#define PG8_EXTRA_MFMA(C, A) do { bf16x8 z_ = {0,0,0,0,0,0,0,0}; asm volatile("" : "+v"(z_)); C = __builtin_amdgcn_mfma_f32_16x16x32_bf16(z_, A, C, 0, 0, 0); } while (0)
#else
#define PG8_EXTRA_MFMA(C, A) do {} while (0)
#endif
#define PG8_WAIT_V(n) asm volatile("s_waitcnt vmcnt(" #n ")" ::: "memory")
#define PG8_WAIT_L(n) asm volatile("s_waitcnt lgkmcnt(" #n ")" ::: "memory")
#define PG8_BAR __builtin_amdgcn_s_barrier()
#define PG8_SCHED __builtin_amdgcn_sched_barrier(0)
    Unit cur, nxt; int ui = 0;
    if (!S.next(0, cur)) return;
    f32x4 acc[2][2][4][2];
#pragma unroll
    for (int a = 0; a < 2; ++a)
#pragma unroll
        for (int b = 0; b < 2; ++b)
#pragma unroll
            for (int m = 0; m < 4; ++m)
#pragma unroll
                for (int n = 0; n < 2; ++n) acc[a][b][m][n] = (f32x4){0.f, 0.f, 0.f, 0.f};
    bf16x8 At[4][2], B0[2][2], B1[2][2];
    PG8_LAS float* const RSL = (PG8_LAS float*)(lds + STAGE_BYTES + 2048);
    unsigned voffR[2] = {0u, 0u};
    if constexpr (Epi::RESID_LDS) {
#pragma unroll
        for (int i = 0; i < 2; ++i) voffR[i] = (unsigned)((16 * i + (lane & 15)) * 2048 + (4 * wid + (lane >> 4)) * 16);
    }
    constexpr size_t RSB = (size_t)32 * 2048;
    const char* cA = (const char*)g.A + (size_t)cur.pm * tstep + (cur.hm == 2 ? hstep : (size_t)0); const char* cB = (const char*)g.Bt + (size_t)cur.pn * tstep;
    size_t hsC = cur.hm ? (size_t)0 : hstep;
    S.a_ready(cur);
    if constexpr (SP2) {
        PG8_STAGE(PG8_SB(0, 0), cB, voffB); PG8_STAGE(PG8_SB(0, 1), cB + hstep, voffB); PG8_STAGE(PG8_SA(0, 0), cA, voffA); PG8_STAGE(PG8_SA(0, 1), cA + hsC, voffA);
        if (wr == 1) PG8_BAR;
        PG8_WAIT_V(2); PG8_BAR;
        PG8_STAGE(PG8_SB(1, 0), cB + kstepB, voffB); PG8_STAGE(PG8_SA(1, 0), cA + kstep, voffA); PG8_STAGE(PG8_SB(1, 1), cB + hstep + kstepB, voffB);
        PG8_WAIT_V(6); PG8_BAR;
    } else {
        PG8_STAGE(PG8_SB(0, 0), cB, voffB); PG8_STAGE(PG8_SA(0, 0), cA, voffA); PG8_STAGE(PG8_SB(0, 1), cB + hstep, voffB); PG8_STAGE(PG8_SA(0, 1), cA + hstep, voffA);
        if (wr == 1) PG8_BAR;
        PG8_WAIT_V(4); PG8_BAR;
        PG8_STAGE(PG8_SB(1, 0), cB + kstep, voffB); PG8_STAGE(PG8_SA(1, 0), cA + kstep, voffA); PG8_STAGE(PG8_SB(1, 1), cB + hstep + kstep, voffB);
        PG8_WAIT_V(6); PG8_BAR;
    }
    for (;;) {
        const bool has_next = S.next(ui + 1, nxt);
        const char* nA = has_next ? (const char*)g.A + (size_t)nxt.pm * tstep + (nxt.hm == 2 ? hstep : (size_t)0) : cA; const char* nB = has_next ? (const char*)g.Bt + (size_t)nxt.pn * tstep : cB;
        const size_t hsN = has_next ? (nxt.hm ? (size_t)0 : hstep) : hsC; const bool halfu = cur.hm != 0;
        for (int t = 0; t < nt; t += 2) {
            const bool last = (t == nt - 2); f32x2 rsE;
            const char* a1 = cA + (size_t)(t + 1) * kstep;
            const char* a2 = last ? nA : cA + (size_t)(t + 2) * kstep; const char* b2 = last ? nB : cB + (size_t)(t + 2) * kstepB;
            const char* a3 = a2 + kstep; const char* b3 = b2 + kstepB;
            if (last && has_next) S.a_ready(nxt);
            bool rl = false; const char* rT = cA;
            if constexpr (Epi::RESID_LDS) { rl = last && !has_next; rT = (const char*)E.base + ((size_t)cur.pm * BM * 1024 + (size_t)cur.pn * BM) * 2; }
            const unsigned vA_[2] = {rl ? voffR[0] : voffA[0], rl ? voffR[1] : voffA[1]}, vB_[2] = {rl ? voffR[0] : voffB[0], rl ? voffR[1] : voffB[1]};
            if constexpr (SP2) {
            if constexpr (Epi::RS_LDS) { if (last) { const float* rp_ = E.ssq + ((size_t)(cur.pm * BM + (tid >> 1)) * 4 + (tid & 1) * 2); asm volatile("global_load_dwordx2 %0, %1, off" : "=v"(rsE) : "v"(rp_) : "memory"); } }
            PG8_LDB(B0, 0, 0); PG8_LDB(B1, 0, 1); PG8_SCHED; PG8_LDA(At, 0, 0); PG8_STAGE(PG8_SA(1, 1), a1 + hsC, voffA);
            PG8_WAIT_V(8); PG8_WAIT_L(0); PG8_BAR; PG8_MMA(0, 0, At, B0); PG8_MMA(0, 1, At, B1); PG8_BAR; PG8_SCHED;
#if PG8_DMASPLIT == 0
            if (!halfu) PG8_LDA(At, 0, 1); PG8_STAGE(PG8_SB(0, 0), rl ? rT + 4 * RSB : b2, vB_); PG8_STAGE(PG8_SB(0, 1), rl ? rT + 5 * RSB : b2 + hstep, vB_); PG8_STAGE(PG8_SA(0, 0), rl ? rT : a2, vA_);
            PG8_WAIT_V(8); PG8_WAIT_L(0); PG8_BAR; if (!halfu) { PG8_MMA(1, 0, At, B0); PG8_MMA(1, 1, At, B1); } PG8_BAR; PG8_SCHED;
#elif PG8_DMASPLIT == 1
            if (!halfu) PG8_LDA(At, 0, 1); PG8_STAGE(PG8_SB(0, 0), rl ? rT + 4 * RSB : b2, vB_); PG8_STAGE(PG8_SB(0, 1), rl ? rT + 5 * RSB : b2 + hstep, vB_);
            PG8_WAIT_V(6); PG8_WAIT_L(0); PG8_BAR; if (!halfu) PG8_MMA(1, 0, At, B0); PG8_SCHED; PG8_STAGE(PG8_SA(0, 0), rl ? rT : a2, vA_); PG8_SCHED; if (!halfu) PG8_MMA(1, 1, At, B1); PG8_BAR; PG8_SCHED;
#else
            if (!halfu) PG8_LDA(At, 0, 1); PG8_STAGE(PG8_SB(0, 0), rl ? rT + 4 * RSB : b2, vB_);
            PG8_WAIT_V(4); PG8_WAIT_L(0); PG8_BAR; if (!halfu) PG8_MMA(1, 0, At, B0); PG8_SCHED; PG8_STAGE(PG8_SB(0, 1), rl ? rT + 5 * RSB : b2 + hstep, vB_); PG8_STAGE(PG8_SA(0, 0), rl ? rT : a2, vA_); PG8_SCHED; if (!halfu) PG8_MMA(1, 1, At, B1); PG8_BAR; PG8_SCHED;
#endif
            if constexpr (Epi::RS_LDS) { if (last) { asm volatile("" : "+v"(rsE)); float s_ = rsE[0] + rsE[1]; s_ += __shfl_xor(s_, 1); RSL[tid >> 1] = __builtin_amdgcn_rsqf(s_ * (1.0f / 1024.0f) + 1e-6f); } }
            PG8_LDB(B0, 1, 0); PG8_LDB(B1, 1, 1); PG8_SCHED; PG8_LDA(At, 1, 0); PG8_STAGE(PG8_SA(0, 1), rl ? rT + RSB : a2 + (last ? hsN : hsC), vA_);
            PG8_WAIT_V(8); PG8_WAIT_L(0); PG8_BAR; PG8_MMA(0, 0, At, B0); PG8_MMA(0, 1, At, B1); PG8_BAR; PG8_SCHED;
#if PG8_DMASPLIT == 0
            if (!halfu) PG8_LDA(At, 1, 1); PG8_STAGE(PG8_SB(1, 0), rl ? rT + 6 * RSB : b3, vB_); PG8_STAGE(PG8_SB(1, 1), rl ? rT + 7 * RSB : b3 + hstep, vB_); PG8_STAGE(PG8_SA(1, 0), rl ? rT + 2 * RSB : a3, vA_);
            PG8_WAIT_V(8); PG8_WAIT_L(0);
            if constexpr (PG8_SPLITEPI && !Epi::AFTER_DRAIN) { if (last) { PG8_SCHED; E.template operator()<0, 1>(acc, cur, wr, wc, fr, fq, RSL); PG8_SCHED; } }
            PG8_BAR; if (!halfu) { PG8_MMA(1, 0, At, B0); PG8_MMA(1, 1, At, B1); } PG8_BAR; PG8_SCHED;
#elif PG8_DMASPLIT == 1
            if (!halfu) PG8_LDA(At, 1, 1); PG8_STAGE(PG8_SB(1, 0), rl ? rT + 6 * RSB : b3, vB_); PG8_STAGE(PG8_SB(1, 1), rl ? rT + 7 * RSB : b3 + hstep, vB_);
            PG8_WAIT_V(6); PG8_WAIT_L(0); PG8_BAR; if (!halfu) PG8_MMA(1, 0, At, B0); PG8_SCHED; PG8_STAGE(PG8_SA(1, 0), rl ? rT + 2 * RSB : a3, vA_); PG8_SCHED; if (!halfu) PG8_MMA(1, 1, At, B1); PG8_BAR; PG8_SCHED;
#else
            if (!halfu) PG8_LDA(At, 1, 1); PG8_STAGE(PG8_SB(1, 0), rl ? rT + 6 * RSB : b3, vB_);
            PG8_WAIT_V(4); PG8_WAIT_L(0); PG8_BAR; if (!halfu) PG8_MMA(1, 0, At, B0); PG8_SCHED; PG8_STAGE(PG8_SB(1, 1), rl ? rT + 7 * RSB : b3 + hstep, vB_); PG8_STAGE(PG8_SA(1, 0), rl ? rT + 2 * RSB : a3, vA_); PG8_SCHED; if (!halfu) PG8_MMA(1, 1, At, B1); PG8_BAR; PG8_SCHED;
#endif
            } else {
            PG8_LDB(B0, 0, 0); PG8_SCHED; PG8_LDA(At, 0, 0); PG8_STAGE(PG8_SA(1, 1), a1 + hstep, voffA);
            PG8_WAIT_L(8); PG8_BAR; PG8_WAIT_L(0); PG8_MMA(0, 0, At, B0); PG8_BAR; PG8_SCHED;
            PG8_LDB(B1, 0, 1); PG8_STAGE(PG8_SB(0, 0), b2, voffB);
            PG8_BAR; PG8_WAIT_L(0); PG8_MMA(0, 1, At, B1); PG8_BAR;
            PG8_LDA(At, 0, 1); PG8_STAGE(PG8_SA(0, 0), a2, voffA);
            PG8_BAR; PG8_WAIT_L(0); PG8_MMA(1, 0, At, B0); PG8_BAR; PG8_SCHED;
            PG8_STAGE(PG8_SB(0, 1), b2 + hstep, voffB);
            PG8_WAIT_V(6); PG8_BAR; PG8_MMA(1, 1, At, B1); PG8_BAR;
            PG8_LDB(B0, 1, 0); PG8_SCHED; PG8_LDA(At, 1, 0); PG8_STAGE(PG8_SA(0, 1), a2 + hstep, voffA);
            PG8_WAIT_L(8); PG8_BAR; PG8_WAIT_L(0); PG8_MMA(0, 0, At, B0); PG8_BAR; PG8_SCHED;
            PG8_LDB(B1, 1, 1); PG8_STAGE(PG8_SB(1, 0), b3, voffB);
            PG8_BAR; PG8_WAIT_L(0); PG8_MMA(0, 1, At, B1); PG8_BAR;
            PG8_LDA(At, 1, 1); PG8_STAGE(PG8_SA(1, 0), a3, voffA);
            PG8_BAR; PG8_WAIT_L(0); PG8_MMA(1, 0, At, B0); PG8_BAR; PG8_SCHED;
            PG8_STAGE(PG8_SB(1, 1), b3 + hstep, voffB);
            PG8_WAIT_V(6); PG8_BAR; PG8_MMA(1, 1, At, B1); PG8_BAR;
            }
        }
        if constexpr (ALIGN_EPI) { if (wr == 0) PG8_BAR; }
        if constexpr (!Epi::AFTER_DRAIN) { if constexpr (PG8_SPLITEPI) E.template operator()<1, 2>(acc, cur, wr, wc, fr, fq, RSL); else E(acc, cur, wr, wc, fr, fq, RSL);
#ifdef PROBE_EPI2
            asm volatile("" ::: "memory"); E(acc, cur, wr, wc, fr, fq, RSL);
#endif
            S.done(cur); }
        if (!has_next) break;
#pragma unroll
        for (int a = 0; a < 2; ++a)
#pragma unroll
            for (int b = 0; b < 2; ++b)
#pragma unroll
                for (int m = 0; m < 4; ++m)
#pragma unroll
                    for (int n = 0; n < 2; ++n) acc[a][b][m][n] = (f32x4){0.f, 0.f, 0.f, 0.f};
        cur = nxt; cA = nA; cB = nB; hsC = hsN; ++ui;
        if constexpr (ALIGN_EPI) { if (wr == 1) PG8_BAR; }
    }
    PG8_WAIT_V(0);
    if constexpr (!ALIGN_EPI) { if (wr == 0) PG8_BAR; }
    PG8_BAR;
    if constexpr (Epi::AFTER_DRAIN) { E.fused(acc, cur, wr, wc, fr, fq, lds, wid, lane); S.done(cur); }
#undef PG8_SA
#undef PG8_SB
#undef PG8_STAGE
#undef PG8_LDA
#undef PG8_LDB
#undef PG8_MMA
#undef PG8_WAIT_V
#undef PG8_WAIT_L
#undef PG8_BAR
#undef PG8_SCHED
}
}
namespace pg8 {
#ifndef PG8_RSLDS
#define PG8_RSLDS false
#endif
#ifndef PG8_RESIDLDS
#define PG8_RESIDLDS false
#endif
constexpr float NORM_EPS_F = 1e-6f;
__device__ __forceinline__ float row_rs(const float* ssq4, int row) {
    const f32x4 s = *(const __attribute__((address_space(1))) f32x4*)(ssq4 + (size_t)row * 4);
    return __builtin_amdgcn_rsqf(((s[0] + s[1]) + (s[2] + s[3])) * (1.0f / 1024.0f) + NORM_EPS_F);
}
__device__ __forceinline__ float silu_mul(float a, float b) { return a * __builtin_amdgcn_rcpf(1.0f + __expf(-a)) * b; }
struct TailHalfOrder : StaticOrder {
    __host__ __device__ bool next(int i, Unit& u) const {
        const int rem = nwg % G, nfull = nwg / G;
        if (rem == 0 || 2 * rem != G || (G % 16) != 0 || (nwg % NXCD) != 0) return StaticOrder::next(i, u);
        if (i < nfull) return StaticOrder::next(i, u);
        if (i > nfull) return false;
        const int x = c % NXCD, q = c / NXCD;
        if (!map((long)nfull * G + x + NXCD * (q >> 1), u)) return false;
        u.hm = 1 + (q & 1); return true;
    }
};
struct EpiSwiGLU {
    static constexpr bool PERM = true, AFTER_DRAIN = false, RS_LDS = PG8_RSLDS, RESID_LDS = false;
    bf16_t* H; int ldh; const float* ssq;
    static __device__ __forceinline__ f32x4 swiglu4(f32x4 a, f32x4 b, float rs) {
        const f32x4 t = a * rs, u = t * (-1.4426950408889634f);
        f32x4 e; e[0] = __builtin_amdgcn_exp2f(u[0]); e[1] = __builtin_amdgcn_exp2f(u[1]); e[2] = __builtin_amdgcn_exp2f(u[2]); e[3] = __builtin_amdgcn_exp2f(u[3]);
        const f32x4 d = e + 1.0f;
        f32x4 s; s[0] = __builtin_amdgcn_rcpf(d[0]); s[1] = __builtin_amdgcn_rcpf(d[1]); s[2] = __builtin_amdgcn_rcpf(d[2]); s[3] = __builtin_amdgcn_rcpf(d[3]);
        return (t * s) * (b * rs);
    }
    template <int AI_LO = 0, int AI_HI = 2>
    __device__ __forceinline__ void operator()(const f32x4 (&acc)[2][2][4][2], const Unit& u, int wr, int wc, int fr, int fq, const PG8_LAS float* rsl) const {
        const int row0 = u.pm * BM + wr * 64 + fr + (u.hm == 2 ? HALF : 0), col0 = u.pn * HALF + wc * 32 + 8 * fq;
        float rsv[2][4];
#pragma unroll
        for (int ai = AI_LO; ai < AI_HI; ++ai)
#pragma unroll
            for (int m = 0; m < 4; ++m) rsv[ai][m] = RS_LDS ? rsl[wr * 64 + fr + ai * HALF + m * 16] : row_rs(ssq, row0 + ai * HALF + m * 16);
#pragma unroll
        for (int ai = AI_LO; ai < AI_HI; ++ai) if (ai == 0 || u.hm == 0)
#pragma unroll
            for (int m = 0; m < 4; ++m) { const int row = row0 + ai * HALF + m * 16; const float rs = rsv[ai][m];
                const f32x4 h0 = swiglu4(acc[ai][0][m][0], acc[ai][1][m][0], rs), h1 = swiglu4(acc[ai][0][m][1], acc[ai][1][m][1], rs);
                u32x4 w; w.x = cvt_pk_bf16(h0[0], h0[1]); w.y = cvt_pk_bf16(h0[2], h0[3]); w.z = cvt_pk_bf16(h1[0], h1[1]); w.w = cvt_pk_bf16(h1[2], h1[3]);
                wt_st16(H + (size_t)row * ldh + col0, w); }
    }
};
__device__ __forceinline__ float bflo_(unsigned w) { return __uint_as_float(w << 16); }
__device__ __forceinline__ float bfhi_(unsigned w) { return __uint_as_float(w & 0xffff0000u); }
struct EpiResid {
    static constexpr bool PERM = true, AFTER_DRAIN = true, RS_LDS = false, RESID_LDS = PG8_RESIDLDS;
    const bf16_t* base; bf16_t* ob; float* outf; float* ssq_out; float alpha;
    __device__ __forceinline__ void fused(f32x4 (&acc)[2][2][4][2], const Unit& u, int wr, int wc, int fr, int fq, PG8_LAS unsigned char* lds, int wid, int lane) const {
        PG8_LAS float* P = (PG8_LAS float*)(lds + (RESID_LDS ? STAGE_BYTES + 4096 : 0));
        const int col0 = u.pn * BM + wc * 32 + 8 * fq;
        u32x4 bw[2][4][2];
        if constexpr (RESID_LDS) {
            if (wr == 1) {
#pragma unroll
                for (int m = 2; m < 4; ++m) { const size_t off = (size_t)(u.pm * BM + wr * 64 + m * 16 + fr) * 1024 + col0;
#pragma unroll
                    for (int bj = 0; bj < 2; ++bj) bw[0][m][bj] = *(const __attribute__((address_space(1))) u32x4*)(base + off + bj * HALF); } }
#pragma unroll
            for (int ai = 0; ai < 2; ++ai)
#pragma unroll
                for (int m = 0; m < 4; ++m) { const int s = ai * 4 + wr * 2 + (m >> 1);
                    if (!(ai == 0 && m >= 2 && wr == 1)) {
#pragma unroll
                        for (int bj = 0; bj < 2; ++bj) bw[ai][m][bj] = *(const PG8_LAS u32x4*)(lds + s * 16384 + (m & 1) * 8192 + (bj * 4 + wc) * 1024 + lane * 16); } }
        } else {
#pragma unroll
        for (int ai = 0; ai < 2; ++ai)
#pragma unroll
            for (int m = 0; m < 4; ++m) { const size_t off = (size_t)(u.pm * BM + ai * HALF + wr * 64 + m * 16 + fr) * 1024 + col0;
#pragma unroll
                for (int bj = 0; bj < 2; ++bj) bw[ai][m][bj] = *(const __attribute__((address_space(1))) u32x4*)(base + off + bj * HALF); }
        }
#pragma unroll
        for (int ai = 0; ai < 2; ++ai)
#pragma unroll
            for (int m = 0; m < 4; ++m) { const int r = ai * HALF + wr * 64 + m * 16 + fr; const size_t off = (size_t)(u.pm * BM + r) * 1024 + col0; float q = 0.f;
#pragma unroll
                for (int bj = 0; bj < 2; ++bj) { const u32x4 w = bw[ai][m][bj];
                    const f32x4 b0 = (f32x4){bflo_(w.x), bfhi_(w.x), bflo_(w.y), bfhi_(w.y)}, b1 = (f32x4){bflo_(w.z), bfhi_(w.z), bflo_(w.w), bfhi_(w.w)};
                    const f32x4 o0 = b0 + acc[ai][bj][m][0] * alpha, o1 = b1 + acc[ai][bj][m][1] * alpha;
                    q += ((o0[0] * o0[0] + o0[1] * o0[1]) + (o0[2] * o0[2] + o0[3] * o0[3])) + ((o1[0] * o1[0] + o1[1] * o1[1]) + (o1[2] * o1[2] + o1[3] * o1[3]));
                    if (ob) { u32x4 v; v.x = cvt_pk_bf16(o0[0], o0[1]); v.y = cvt_pk_bf16(o0[2], o0[3]); v.z = cvt_pk_bf16(o1[0], o1[1]); v.w = cvt_pk_bf16(o1[2], o1[3]); wt_st16(ob + off + bj * HALF, v); }
                    if (outf) { *(__attribute__((address_space(1))) f32x4*)(outf + off + bj * HALF) = o0; *(__attribute__((address_space(1))) f32x4*)(outf + off + bj * HALF + 4) = o1; } }
                q += __shfl_xor(q, 16); q += __shfl_xor(q, 32);
                if (fq == 0) P[r * 4 + wc] = q; }
        asm volatile("s_waitcnt lgkmcnt(0)" ::: "memory"); __builtin_amdgcn_s_barrier(); asm volatile("" ::: "memory");
        if (ssq_out) { const int t = wid * 64 + lane; if (t < 256) { const PG8_LAS f32x4* P4 = (const PG8_LAS f32x4*)P; const f32x4 p = P4[t]; wt_st4f(ssq_out + (size_t)(u.pm * BM + t) * 4 + u.pn, (p[0] + p[1]) + (p[2] + p[3])); } }
    }
};
struct EpiWin {
    static constexpr bool PERM = true, AFTER_DRAIN = false, RS_LDS = PG8_RSLDS, RESID_LDS = false;
    bf16_t* U; const float* ssq; const float* gains;
    template <int AI_LO = 0, int AI_HI = 2>
    __device__ __forceinline__ void operator()(const f32x4 (&acc)[2][2][4][2], const Unit& u, int wr, int wc, int fr, int fq, const PG8_LAS float* rsl) const {
        const int row0 = u.pm * BM + wr * 64 + fr, colL = u.pn * BM + wc * 64 + 8 * fq;
        const bool nrm = (u.pn == 4) || (u.pn == 5) || (u.pn == 7);
        const float* g = gains + ((u.pn == 4) ? 0 : (u.pn == 5) ? 64 : 128);
        f32x4 gv[2][2];
#pragma unroll
        for (int bj = 0; bj < 2; ++bj)
#pragma unroll
            for (int n = 0; n < 2; ++n) gv[bj][n] = nrm ? *(const __attribute__((address_space(1))) f32x4*)(g + 32 * bj + 8 * fq + 4 * n) : (f32x4){1.f, 1.f, 1.f, 1.f};
        float rsv[2][4];
#pragma unroll
        for (int ai = AI_LO; ai < AI_HI; ++ai)
#pragma unroll
            for (int m = 0; m < 4; ++m) rsv[ai][m] = RS_LDS ? rsl[wr * 64 + fr + ai * HALF + m * 16] : row_rs(ssq, row0 + ai * HALF + m * 16);
#pragma unroll
        for (int ai = AI_LO; ai < AI_HI; ++ai)
#pragma unroll
            for (int m = 0; m < 4; ++m) { const int row = row0 + ai * HALF + m * 16; const float rs = rsv[ai][m];
                f32x4 v[2][2]; float ss = 0.f;
#pragma unroll
                for (int bj = 0; bj < 2; ++bj)
#pragma unroll
                    for (int n = 0; n < 2; ++n) { v[bj][n] = acc[ai][bj][m][n] * rs; ss += (v[bj][n][0] * v[bj][n][0] + v[bj][n][1] * v[bj][n][1]) + (v[bj][n][2] * v[bj][n][2] + v[bj][n][3] * v[bj][n][3]); }
                ss += __shfl_xor(ss, 16); ss += __shfl_xor(ss, 32);
                const float rn = nrm ? __builtin_amdgcn_rsqf(ss * (1.0f / 64.0f) + NORM_EPS_F) * ((u.pn == 5) ? 1.0f : 0.18033688011112042f) : 1.0f;
#pragma unroll
                for (int bj = 0; bj < 2; ++bj) { const f32x4 x0 = v[bj][0] * rn * gv[bj][0], x1 = v[bj][1] * rn * gv[bj][1];
                    u32x4 w; w.x = cvt_pk_bf16(x0[0], x0[1]); w.y = cvt_pk_bf16(x0[2], x0[3]); w.z = cvt_pk_bf16(x1[0], x1[1]); w.w = cvt_pk_bf16(x1[2], x1[3]);
                    wt_st16(U + (size_t)row * 2048 + colL + 32 * bj, w); } }
    }
};
}
#ifndef PG8_SP2
#define PG8_SP2 true
#endif
#ifndef PG8_ALIGN
#define PG8_ALIGN true
#endif
#ifndef MK_N_LAUNCHES
#define MK_N_LAUNCHES 1
#endif
constexpr int NWAVES = 8;
constexpr int NPHASE = 9;
constexpr int N_LAUNCHES = MK_N_LAUNCHES;

constexpr int BATCH = 2, SEQ = 8192, D = 1024, FF = 2816, M = BATCH * SEQ;
constexpr int MEMLEN = 256, HD = 64, LRUW = 512, INW = 2048, NBLK = SEQ / 256;
constexpr float EPS = 1e-6f;

constexpr size_t MiB = 1u << 20;
constexpr size_t WS_CTL = 0, CTL_ZERO_BYTES = 64 * 1024;
constexpr size_t WS_SSQ0 = 1 * MiB, WS_SSQ1 = WS_SSQ0 + 256 * 1024, WS_SSQ2 = WS_SSQ1 + 256 * 1024;
constexpr size_t WS_KMEAN = 2 * MiB;
constexpr size_t WS_AGGA = WS_KMEAN + 64 * 1024;
constexpr size_t WS_AGGH = WS_AGGA + 128 * 1024;
constexpr size_t WS_GAINS = WS_AGGH + 128 * 1024;
constexpr size_t WS_PTAB = WS_GAINS + 4096;
constexpr size_t WS_MEMB = 3 * MiB;
constexpr size_t WS_MEMKF = 4 * MiB, WS_MEMVF = WS_MEMKF + 256 * 1024;
constexpr size_t WS_GR = 5 * MiB;
constexpr size_t WS_W1I = 8 * MiB, WS_W1O = 19 * MiB, WS_WIN = 25 * MiB, WS_WOUT = 29 * MiB, WS_WMKV = 31 * MiB, WS_W2I = 32 * MiB, WS_W2O = 43 * MiB;
constexpr size_t WS_WG = 49 * MiB;
constexpr size_t WS_XB = 50 * MiB;
constexpr size_t WS_MIX = 82 * MiB;
constexpr size_t WS_H = 114 * MiB;
constexpr size_t WS_U = WS_H;
constexpr size_t WS_KF = 202 * MiB, WS_VF = 210 * MiB;
constexpr size_t WS_PART2 = 218 * MiB;
constexpr size_t WS_END = 256 * MiB;
static_assert(WS_H + (size_t)M * FF * 2 <= WS_END, "d_ws map");
constexpr int CW_BAR = 1024;

constexpr int RING_OFF = 0, RING_BYTES = 131072;
constexpr int LDSCTL_OFF = RING_BYTES, MISC_OFF = LDSCTL_OFF + 320;
constexpr int LDS_BYTES = 163840;

#define GAS __attribute__((address_space(1)))
#define LAS __attribute__((address_space(3)))
typedef unsigned short bf16;
typedef unsigned v4u __attribute__((ext_vector_type(4)));
typedef float f32x4 __attribute__((ext_vector_type(4)));
typedef short bf16x8 __attribute__((ext_vector_type(8)));
typedef GAS unsigned gu32;
typedef GAS unsigned long long gu64;
#define RLX_AGENT __ATOMIC_RELAXED, __HIP_MEMORY_SCOPE_AGENT
#define LDS_WAIT() asm volatile("s_waitcnt lgkmcnt(0)" ::: "memory")
#define VM_WAIT() asm volatile("s_waitcnt vmcnt(0)" ::: "memory")
__device__ __forceinline__ unsigned long long rt() { return __builtin_amdgcn_s_memrealtime(); }
__device__ __forceinline__ unsigned f2bf(float f) { unsigned u = __builtin_bit_cast(unsigned, f); return (u + 0x7fffu + ((u >> 16) & 1u)) >> 16; }
__device__ __forceinline__ unsigned pk2(float lo, float hi) { return f2bf(lo) | (f2bf(hi) << 16); }

#define XB_TMO      128
#define XB_XCNT(j)  (256  + 64 * (j))
#define XB_XSUB(j)  (1280 + 64 * (j))
#define XB_XGEN(j)  (2304 + 64 * (j))
#define XB_TOP      3328
#define XB_TOPGEN   3392
#define XCD_BAR_WORDS 3456
#define XB_SPIN_CAP (1u << 18)

__device__ __forceinline__ unsigned xb_ld(unsigned* p)              { return __hip_atomic_load(p, __ATOMIC_RELAXED, __HIP_MEMORY_SCOPE_AGENT); }
__device__ __forceinline__ unsigned xb_add(unsigned* p, unsigned v) { return __hip_atomic_fetch_add(p, v, __ATOMIC_RELAXED, __HIP_MEMORY_SCOPE_AGENT); }
__device__ __forceinline__ unsigned xb_xcc_id() { return (unsigned)__builtin_amdgcn_s_getreg((3 << 11) | 20) & 0xFu; }
#define XB_SPIN(cond, bar) do { unsigned _sp = 0; while (cond) { __builtin_amdgcn_s_sleep(1); \
    if ((++_sp & 255u) == 0u) { if (xb_ld(&(bar)[XB_TMO])) break; if (_sp > XB_SPIN_CAP) { atomicAdd(&(bar)[XB_TMO], 1u); break; } } } } while (0)

struct XcdBarrier {
    unsigned* bar; unsigned x;
    volatile LAS unsigned* st;
    int wave;
};
__device__ __forceinline__ bool xb_thread0(int wave) { int ln; asm volatile("v_mbcnt_lo_u32_b32 %0, -1, 0\n\tv_mbcnt_hi_u32_b32 %0, -1, %0" : "=v"(ln)); return wave == 0 && ln == 0; }

__device__ __forceinline__ XcdBarrier xcd_barrier_post(unsigned* bar, volatile LAS unsigned* st, int wave) {
    XcdBarrier b; b.bar = bar; b.x = xb_xcc_id(); b.st = st; b.wave = wave;
    if (xb_thread0(wave)) (void)xb_add(&bar[XB_XCNT(b.x)], 1u);
    return b;
}
__device__ __forceinline__ void xcd_barrier_complete(unsigned* bar, unsigned x, unsigned& nloc, unsigned& nx) {
    const unsigned G = gridDim.x * gridDim.y * gridDim.z;
    unsigned sum, cnt, mine, sp = 0u;
    for (;;) {
        sum = 0u; cnt = 0u; mine = 0u;
#pragma unroll
        for (unsigned j = 0; j < 16; ++j) { const unsigned c = xb_ld(&bar[XB_XCNT(j)]); sum += c; cnt += (c > 0u) ? 1u : 0u; mine = (j == x) ? c : mine; }
        if (sum == G) break;
        __builtin_amdgcn_s_sleep(1);
        if ((++sp & 255u) == 0u) { if (xb_ld(&bar[XB_TMO])) break; if (sp > XB_SPIN_CAP) { atomicAdd(&bar[XB_TMO], 1u); break; } }
    }
    nloc = mine > 0u ? mine : 1u; nx = cnt > 0u ? cnt : 1u;
}

__device__ __forceinline__ void xcd_barrier(const XcdBarrier& b, const bool writeback = true) {
    asm volatile("s_waitcnt vmcnt(0)" ::: "memory");
    __syncthreads();
    if (xb_thread0(b.wave)) {
        unsigned* bar = b.bar;
        __builtin_amdgcn_s_waitcnt(0);
        unsigned nloc = b.st[0], nx = b.st[1];
        if (nloc == 0u) { xcd_barrier_complete(bar, b.x, nloc, nx); b.st[0] = nloc; b.st[1] = nx; }
        const unsigned old = xb_add(&bar[XB_XSUB(b.x)], 1u);
        const unsigned gen = old / nloc;
        if (old + 1u == (gen + 1u) * nloc) {
            if (writeback) __builtin_amdgcn_fence(__ATOMIC_RELEASE, "agent");
            asm volatile("s_waitcnt vmcnt(0)" ::: "memory");
            const unsigned og = xb_add(&bar[XB_TOP], 1u);
            const unsigned tg = og / nx;
#ifdef XB_EARLY_INV
            __builtin_amdgcn_fence(__ATOMIC_ACQUIRE, "agent");
            if (og + 1u == (tg + 1u) * nx) xb_add(&bar[XB_TOPGEN], 1u);
            else XB_SPIN(xb_ld(&bar[XB_TOPGEN]) == tg, bar);
#else
            if (og + 1u == (tg + 1u) * nx) xb_add(&bar[XB_TOPGEN], 1u);
            else XB_SPIN(xb_ld(&bar[XB_TOPGEN]) == tg, bar);
            __builtin_amdgcn_fence(__ATOMIC_ACQUIRE, "agent");
#endif
#ifndef XB_DIRECT
            xb_add(&bar[XB_XGEN(b.x)], 1u);
#endif
            asm volatile("s_waitcnt vmcnt(0)" ::: "memory");
        } else {
#ifdef XB_EARLY_INV
            __builtin_amdgcn_fence(__ATOMIC_ACQUIRE, "agent");
#ifdef XB_DIRECT
            XB_SPIN(xb_ld(&bar[XB_TOPGEN]) == gen, bar);
#else
            XB_SPIN(xb_ld(&bar[XB_XGEN(b.x)]) == gen, bar);
#endif
#elif defined(XB_DIRECT)
            XB_SPIN(xb_ld(&bar[XB_TOPGEN]) == gen, bar);
            __builtin_amdgcn_fence(__ATOMIC_ACQUIRE, "agent");
#else
            XB_SPIN(xb_ld(&bar[XB_XGEN(b.x)]) == gen, bar);
            __builtin_amdgcn_fence(__ATOMIC_ACQUIRE, "agent");
#endif
            asm volatile("s_waitcnt vmcnt(0)" ::: "memory");
        }
    }
    __syncthreads();
}

#define LB_CNT(l)  (8192 + 64 * (l))
#define LB_EV(e)   (8192 + 64 * (8 + (e)))
__device__ __forceinline__ void label_barrier(unsigned* ctl, unsigned* bar, int label, unsigned members, int wave, bool ev_sig, unsigned* ev, unsigned ev_need) {
    asm volatile("s_waitcnt vmcnt(0)" ::: "memory");
    __syncthreads();
    if (xb_thread0(wave)) {
        __builtin_amdgcn_s_waitcnt(0);
        unsigned* cnt = ctl + LB_CNT(label);
#ifndef WT_ALL
        __builtin_amdgcn_fence(__ATOMIC_RELEASE, "agent");
        asm volatile("s_waitcnt vmcnt(0)" ::: "memory");
#endif
        if (ev_sig) (void)xb_add(ev, 1u);
        const unsigned old = xb_add(cnt, 1u);
        const unsigned target = (old / members + 1u) * members;
#ifdef XB_EARLY_INV
        __builtin_amdgcn_fence(__ATOMIC_ACQUIRE, "agent");
#endif
        XB_SPIN(xb_ld(cnt) < target, bar);
        if (ev_need) XB_SPIN(xb_ld(ev) < ev_need, bar);
#ifndef XB_EARLY_INV
        __builtin_amdgcn_fence(__ATOMIC_ACQUIRE, "agent");
#endif
        asm volatile("s_waitcnt vmcnt(0)" ::: "memory");
    }
    __syncthreads();
}
__device__ __forceinline__ float bf2f(unsigned short h) { return __uint_as_float((unsigned)h << 16); }
__device__ __forceinline__ float bflo(unsigned w) { return __uint_as_float(w << 16); }
__device__ __forceinline__ float bfhi(unsigned w) { return __uint_as_float(w & 0xffff0000u); }
__device__ __forceinline__ float wave_sum(float v) {
#pragma unroll
    for (int o = 1; o < 64; o <<= 1) v += __shfl_xor(v, o);
    return v;
}
__device__ __forceinline__ float wave_max(float v) {
#pragma unroll
    for (int o = 1; o < 64; o <<= 1) v = fmaxf(v, __shfl_xor(v, o));
    return v;
}
__device__ __forceinline__ float sigmoidf_(float x) { return 1.0f / (1.0f + __expf(-x)); }
__device__ __forceinline__ float gelu_tanh(float x) { const float u = x * __builtin_fmaf(x * x, 0.10294324f, 2.3022082f); return x * __builtin_amdgcn_rcpf(1.0f + __builtin_amdgcn_exp2f(-u)); }
template <int CTRL, int ROWMASK> __device__ __forceinline__ float dppf(float old, float src) { return __builtin_bit_cast(float, __builtin_amdgcn_update_dpp(__builtin_bit_cast(int, old), __builtin_bit_cast(int, src), CTRL, ROWMASK, 0xF, false)); }

__device__ __forceinline__ int kperm16(int o) { return 8 * ((o >> 2) & 1) + 4 * (o >> 3) + (o & 3); }
__device__ __forceinline__ void p0_transpose_item(const float* W, int K, int N, const float* gain, bf16* WT, int dest_row0, LAS float* scr, int k0, int n0, int lane) {
#pragma unroll
    for (int i = 0; i < 32; ++i) { const int kk = 2 * i + (lane >> 5); const float g = gain ? gain[k0 + kk] : 1.0f; scr[kk * 33 + (lane & 31)] = W[(size_t)(k0 + kk) * N + n0 + (lane & 31)] * g; }
    LDS_WAIT(); asm volatile("" ::: "memory");
    const int c = lane & 7;
#pragma unroll
    for (int j = 0; j < 4; ++j) { const int n = (lane >> 3) + 8 * j; const LAS float* s = scr + (8 * c) * 33 + n;
        v4u o; o.x = pk2(s[0 * 33], s[1 * 33]); o.y = pk2(s[2 * 33], s[3 * 33]); o.z = pk2(s[4 * 33], s[5 * 33]); o.w = pk2(s[6 * 33], s[7 * 33]);
        *(GAS v4u*)(WT + (size_t)(dest_row0 + n) * K + k0 + 8 * c) = o; }
    LDS_WAIT(); asm volatile("" ::: "memory");
}
__device__ __forceinline__ int map_swiglu(int n0) { return n0 < FF ? 256 * (n0 / 128) + (n0 % 128) : 256 * ((n0 - FF) / 128) + 128 + ((n0 - FF) % 128); }
__device__ __forceinline__ int map_heads(int n0) { const int rem = n0 % 256; return 256 * (n0 / 256) + 128 * ((rem / 32) & 1) + 32 * (rem / 64); }
__device__ __forceinline__ void row_to_bf16(const float* xrow, bf16* orow, float* ssq4, bool scale, int lane) {
    const GAS f32x4* xr = (const GAS f32x4*)xrow + lane;
    f32x4 v[4]; float s = 0.f;
#pragma unroll
    for (int j = 0; j < 4; ++j) { v[j] = xr[64 * j]; s += (v[j].x * v[j].x + v[j].y * v[j].y) + (v[j].z * v[j].z + v[j].w * v[j].w); }
    s = wave_sum(s);
    const float rs = scale ? __builtin_amdgcn_rsqf(s * (1.0f / 1024.0f) + EPS) : 1.0f;
    GAS unsigned long long* o8 = (GAS unsigned long long*)orow + lane;
#pragma unroll
    for (int j = 0; j < 4; ++j) wt_st8((void*)(o8 + 64 * j), (unsigned long long)pk2(v[j].x * rs, v[j].y * rs) | ((unsigned long long)pk2(v[j].z * rs, v[j].w * rs) << 32));
    if (ssq4 && lane == 0) { wt_st16f(ssq4, (f32x4){s, 0.f, 0.f, 0.f}); }
}
struct P0Item { const float* src; const float* gain; bf16* dst; int K, N; float useg; int grp; };
template <int SET>
__device__ __forceinline__ bool p0_decode(const float* const* in, unsigned char* ws, int it, P0Item& d) {
    constexpr int I_FI = (D / 64) * (2 * FF / 32), I_FO = (FF / 64) * (D / 32), I_WI = (D / 64) * (INW / 32), I_WO = (D / 64) * (D / 32), I_MK = (D / 64) * (512 / 32);
    constexpr int NITEMS = SET == 0 ? 2 * I_FI + I_MK : SET == 1 ? I_FO + I_WO + I_WI : I_FO;
    if (it >= NITEMS) return false;
    int r = it; const float* W; const float* gain; bf16* WT; int K, N, map;
    if (SET == 0) {
        if (r < I_FI) { W = in[3]; K = D; N = 2 * FF; gain = in[2]; WT = (bf16*)(ws + WS_W1I); map = 1; }
        else if ((r -= I_FI) < I_MK) { W = in[17]; K = D; N = 512; gain = in[6]; WT = (bf16*)(ws + WS_WMKV); map = 0; }
        else { r -= I_MK; W = in[22]; K = D; N = 2 * FF; gain = in[21]; WT = (bf16*)(ws + WS_W2I); map = 1; }
    } else if (SET == 1) {
        if (r < I_FO) { W = in[4]; K = FF; N = D; gain = nullptr; WT = (bf16*)(ws + WS_W1O); map = 0; }
        else if ((r -= I_FO) < I_WI) { W = in[7]; K = D; N = INW; gain = in[5]; WT = (bf16*)(ws + WS_WIN); map = 2; }
        else { r -= I_WI; W = in[20]; K = D; N = D; gain = nullptr; WT = (bf16*)(ws + WS_WOUT); map = 0; }
    } else { W = in[23]; K = FF; N = D; gain = nullptr; WT = (bf16*)(ws + WS_W2O); map = 0; }
    const int nblk = N / 32, kb = r / nblk, nb = r % nblk, k0 = 64 * kb, n0 = 32 * nb;
    const int dr = map == 1 ? map_swiglu(n0) : map == 2 ? map_heads(n0) : n0;
    d.src = W + (size_t)k0 * N + n0; d.gain = gain ? gain + k0 : W; d.useg = gain ? 1.0f : 0.0f; d.K = K; d.N = N;
#if PG8_BTILED
    if (WT != (bf16*)(ws + WS_WMKV)) { d.dst = WT + ((size_t)(dr >> 7) * (K >> 6) + (k0 >> 6)) * 8192; d.grp = dr & 96; return true; }
#endif
    d.dst = WT + (size_t)dr * K + k0; d.grp = -1; return true;
}
__device__ __forceinline__ void p0_item_load(const P0Item& d, f32x4 (&v)[8], float (&gv)[8], int lane) {
#pragma unroll
    for (int i = 0; i < 8; ++i) { v[i] = *(const GAS f32x4*)(d.src + (size_t)((lane >> 3) + 8 * i) * d.N + 4 * (lane & 7)); gv[i] = *(const GAS float*)(d.gain + (lane >> 3) + 8 * i); }
}
__device__ __forceinline__ void p0_item_finish(const P0Item& d, const f32x4 (&v)[8], const float (&gv)[8], LAS float* scr, int lane) {
#pragma unroll
    for (int i = 0; i < 8; ++i) { const int kk = (lane >> 3) + 8 * i; const float g = d.useg != 0.0f ? gv[i] : 1.0f; LAS float* s = scr + kk * 33 + 4 * (lane & 7);
        s[0] = v[i].x * g; s[1] = v[i].y * g; s[2] = v[i].z * g; s[3] = v[i].w * g; }
    LDS_WAIT(); asm volatile("" ::: "memory");
    const int c = lane & 7;
#pragma unroll
    for (int j = 0; j < 4; ++j) { const int n = (lane >> 3) + 8 * j; const LAS float* s = scr + (8 * c) * 33 + n;
        v4u o; o.x = pk2(s[0 * 33], s[1 * 33]); o.y = pk2(s[2 * 33], s[3 * 33]); o.z = pk2(s[4 * 33], s[5 * 33]); o.w = pk2(s[6 * 33], s[7 * 33]);
        const size_t eo = d.grp >= 0 ? (size_t)(pg8::lds_byte(d.grp + 16 * ((n >> 2) & 1) + 4 * (n >> 3) + (n & 3), 8 * c) >> 1) : (size_t)n * d.K + 8 * c;
        wt_st16(d.dst + eo, o); }
    LDS_WAIT(); asm volatile("" ::: "memory");
}
template <int SET>
__device__ __forceinline__ void p0_weights(const float* const* in, unsigned char* ws, LAS unsigned char* lds, int widx, int nw, int wave, int lane) {
    LAS float* scr = (LAS float*)(lds + RING_OFF + wave * 16384);
    P0Item d0, d1; f32x4 v0[8], v1[8]; float g0[8], g1[8];
    int it = widx; bool have = p0_decode<SET>(in, ws, it, d0);
    if (have) p0_item_load(d0, v0, g0, lane);
    while (have) {
        const bool have1 = p0_decode<SET>(in, ws, it + nw, d1);
        if (!have1) d1 = d0;
        p0_item_load(d1, v1, g1, lane);
        p0_item_finish(d0, v0, g0, scr, lane);
        it += nw; have = have1; d0 = d1;
#pragma unroll
        for (int i = 0; i < 8; ++i) { v0[i] = v1[i]; g0[i] = g1[i]; }
    }
}
struct P0Mat { const float* W; int K, N; const float* gain; bf16* WT; int map; };
__device__ __forceinline__ void p0_prologue(const float* const* in, unsigned char* ws, LAS unsigned char* lds, int vcu, int G, int wave, int lane) {
    LAS float* scr = (LAS float*)(lds + RING_OFF + wave * 16384);
    const int gw = vcu * NWAVES + wave, NGW = G * NWAVES;
    for (int m = gw; m < M; m += 4 * NGW) {
        f32x4 v[4][4];
#pragma unroll
        for (int r = 0; r < 4; ++r) { const GAS f32x4* xr = (const GAS f32x4*)(in[0] + (size_t)(m + r * NGW) * D) + 2 * lane;
            v[r][0] = xr[0]; v[r][1] = xr[1]; v[r][2] = xr[128]; v[r][3] = xr[129]; }
#pragma unroll
        for (int r = 0; r < 4; ++r) { float sa = 0.f;
#pragma unroll
            for (int j = 0; j < 4; ++j) sa += (v[r][j].x * v[r][j].x + v[r][j].y * v[r][j].y) + (v[r][j].z * v[r][j].z + v[r][j].w * v[r][j].w);
            sa = wave_sum(sa);
            GAS v4u* o16 = (GAS v4u*)((bf16*)(ws + WS_XB) + (size_t)(m + r * NGW) * D) + lane;
            wt_st16((void*)(o16), (v4u){pk2(v[r][0].x, v[r][0].y), pk2(v[r][0].z, v[r][0].w), pk2(v[r][1].x, v[r][1].y), pk2(v[r][1].z, v[r][1].w)});
            wt_st16((void*)(o16 + 64), (v4u){pk2(v[r][2].x, v[r][2].y), pk2(v[r][2].z, v[r][2].w), pk2(v[r][3].x, v[r][3].y), pk2(v[r][3].z, v[r][3].w)});
            if (lane == 0) wt_st16f((float*)(ws + WS_SSQ0) + (size_t)(m + r * NGW) * 4, (f32x4){sa, 0.f, 0.f, 0.f}); }
    }
    for (int m = gw; m < BATCH * MEMLEN; m += NGW) row_to_bf16(in[1] + (size_t)m * D, (bf16*)(ws + WS_MEMB) + (size_t)m * D, nullptr, true, lane);
    for (int f = gw * 64 + lane; f < 8 * 2 * 2 * 4 * 64; f += NGW * 64) {
        const int ln = f & 63, ks = (f >> 6) & 3, blk = (f >> 8) & 1, gate = (f >> 9) & 1, n = f >> 10, r = ln & 31, h = ln >> 5;
        const float* Wg = (gate ? in[12] : in[10]) + (size_t)n * 4096 + 32 * blk + r; float v[8];
#pragma unroll
        for (int j = 0; j < 8; ++j) v[j] = 1.4426950408889634f * Wg[(8 * (2 * ks + (j >> 2)) + 4 * h + (j & 3)) * 64];
        v4u o; o.x = pk2(v[0], v[1]); o.y = pk2(v[2], v[3]); o.z = pk2(v[4], v[5]); o.w = pk2(v[6], v[7]);
        wt_st16((bf16*)(ws + WS_WG) + (size_t)f * 8, o); }
    p0_weights<0>(in, ws, lds, gw, NGW, wave, lane);
    for (int i = gw * 64 + lane; i < BATCH * NBLK * LRUW * 2; i += NGW * 64) wt_st8((unsigned long long*)(ws + WS_GR) + i, 0ull);
}
__device__ __forceinline__ unsigned pkbf(float lo, float hi) { typedef float f2 __attribute__((ext_vector_type(2))); typedef __bf16 b2 __attribute__((ext_vector_type(2))); f2 v = {lo, hi}; b2 r = __builtin_convertvector(v, b2); return __builtin_bit_cast(unsigned, r); }
typedef float f32x16_ __attribute__((ext_vector_type(16)));
constexpr int LRU_ROWB = 136, LRU_XT = 40 * LRU_ROWB, LRU_TILE = LRU_XT + 32 * LRU_ROWB;
__device__ __forceinline__ void lru_load(const bf16* U, int n, int b, int ck, int wave, int lane, v4u (&xv)[5], v4u (&gv)[4]) {
    const int t0 = ck * 256 + wave * 32;
    const int rr = lane >> 3, c16 = lane & 7; const bf16* src = U + ((size_t)b * SEQ + t0 - 3 + rr) * INW + n * 64 + c16 * 8;
#pragma unroll
    for (int i = 0; i < 5; ++i) { const int row = rr + 8 * i; const bool ok = (row < 35) && (t0 - 3 + row >= 0); const int rowc = ok ? row : 3;
        const v4u ld = *(const GAS v4u*)(src + (size_t)(rowc - rr) * INW); xv[i] = ok ? ld : (v4u){0u, 0u, 0u, 0u}; }
#pragma unroll
    for (int i = 0; i < 4; ++i) gv[i] = *(const GAS v4u*)(src + (size_t)(3 + 8 * i) * INW + LRUW);
}
__device__ __forceinline__ void lru_stage(LAS unsigned char* tile, int lane, const v4u (&xv)[5], const v4u (&gv)[4]) {
    typedef unsigned u2v __attribute__((ext_vector_type(2)));
    const int rr = lane >> 3, c16 = lane & 7;
#pragma unroll
    for (int i = 0; i < 5; ++i) { LAS unsigned char* d = tile + (rr + 8 * i) * LRU_ROWB + c16 * 16; *(LAS u2v*)d = (u2v){xv[i].x, xv[i].y}; *(LAS u2v*)(d + 8) = (u2v){xv[i].z, xv[i].w}; }
#pragma unroll
    for (int i = 0; i < 4; ++i) { LAS unsigned char* d = tile + LRU_XT + (rr + 8 * i) * LRU_ROWB + c16 * 16; *(LAS u2v*)d = (u2v){gv[i].x, gv[i].y}; *(LAS u2v*)(d + 8) = (u2v){gv[i].z, gv[i].w}; }
}
__device__ __forceinline__ void lru_local(const bf16* WG, const LAS float* PT, LAS unsigned char* tile, int n, int b, int ck, int wave, int lane, float (&av)[32], float (&bv)[32]) {
    typedef unsigned u2v __attribute__((ext_vector_type(2)));
    const int r32 = lane & 31, hi = lane >> 5;
    const int t0 = ck * 256 + wave * 32, t = t0 + r32;
    const LAS unsigned char* xrow = tile + r32 * LRU_ROWB + 8 * hi;
    unsigned xpk[16];
#pragma unroll
    for (int g = 0; g < 8; ++g) {
        f32x4 acc = *(const LAS f32x4*)(PT + 4 * 64 + 8 * g + 4 * hi);
#pragma unroll
        for (int jj = 0; jj < 4; ++jj) { const u2v w = *(const LAS u2v*)(xrow + jj * LRU_ROWB + 16 * g);
            const f32x4 cw = *(const LAS f32x4*)(PT + jj * 64 + 8 * g + 4 * hi);
            acc[0] += cw[0] * bflo(w.x); acc[1] += cw[1] * bfhi(w.x); acc[2] += cw[2] * bflo(w.y); acc[3] += cw[3] * bfhi(w.y); }
        xpk[2 * g] = pkbf(acc[0], acc[1]); xpk[2 * g + 1] = pkbf(acc[2], acc[3]);
    }
    bf16x8 xf[4];
#pragma unroll
    for (int ks = 0; ks < 4; ++ks) { v4u w; w.x = xpk[4 * ks]; w.y = xpk[4 * ks + 1]; w.z = xpk[4 * ks + 2]; w.w = xpk[4 * ks + 3]; xf[ks] = __builtin_bit_cast(bf16x8, w); }
    f32x16_ aR[2], aI[2];
#pragma unroll
    for (int blk = 0; blk < 2; ++blk)
#pragma unroll
        for (int q4 = 0; q4 < 4; ++q4) { const f32x4 ba = *(const LAS f32x4*)(PT + 6 * 64 + 32 * blk + 8 * q4 + 4 * hi), bx = *(const LAS f32x4*)(PT + 7 * 64 + 32 * blk + 8 * q4 + 4 * hi);
#pragma unroll
            for (int i = 0; i < 4; ++i) { aR[blk][4 * q4 + i] = ba[i]; aI[blk][4 * q4 + i] = bx[i]; } }
#pragma unroll
    for (int blk = 0; blk < 2; ++blk)
#pragma unroll
        for (int ks = 0; ks < 4; ++ks) {
            const bf16x8 wa = *(const GAS bf16x8*)(WG + ((size_t)(((n * 2 + 0) * 2 + blk) * 4 + ks) * 64 + lane) * 8);
            const bf16x8 wx = *(const GAS bf16x8*)(WG + ((size_t)(((n * 2 + 1) * 2 + blk) * 4 + ks) * 64 + lane) * 8);
            aR[blk] = __builtin_amdgcn_mfma_f32_32x32x16_bf16(wa, xf[ks], aR[blk], 0, 0, 0);
            aI[blk] = __builtin_amdgcn_mfma_f32_32x32x16_bf16(wx, xf[ks], aI[blk], 0, 0, 0); }
#pragma unroll
    for (int blk = 0; blk < 2; ++blk)
#pragma unroll
        for (int q4 = 0; q4 < 4; ++q4) { const f32x4 sp4 = *(const LAS f32x4*)(PT + 5 * 64 + 32 * blk + 8 * q4 + 4 * hi);
#pragma unroll
            for (int i = 0; i < 4; ++i) { const int idx = 16 * blk + 4 * q4 + i;
                const float r = __builtin_amdgcn_rcpf(1.0f + __builtin_amdgcn_exp2f(-aR[blk][4 * q4 + i])), ii = __builtin_amdgcn_rcpf(1.0f + __builtin_amdgcn_exp2f(-aI[blk][4 * q4 + i]));
                const float a = __builtin_amdgcn_exp2f(r * sp4[i]);
                float mult = __builtin_amdgcn_sqrtf(__builtin_fmaf(-a, a, 1.0f)); if (t == 0) mult = 1.0f;
                const unsigned xw_ = xpk[idx >> 1]; av[idx] = a; bv[idx] = mult * ii * ((idx & 1) ? bfhi(xw_) : bflo(xw_)); } }
#define LRU_E(i, C) "v_fmac_f32_dpp %" #i ", %" #i ", %" #C " " CTRL "\n\tv_mul_f32_dpp %" #C ", %" #C ", %" #C " " CTRL "\n\t"
#define LRU_STEP4(g) asm volatile("s_nop 1\n\t" LRU_E(0, 4) LRU_E(1, 5) LRU_E(2, 6) LRU_E(3, 7) : "+v"(bv[g]), "+v"(bv[g + 1]), "+v"(bv[g + 2]), "+v"(bv[g + 3]), "+v"(av[g]), "+v"(av[g + 1]), "+v"(av[g + 2]), "+v"(av[g + 3]))
#define LRU_STEP() do { LRU_STEP4(0); LRU_STEP4(4); LRU_STEP4(8); LRU_STEP4(12); LRU_STEP4(16); LRU_STEP4(20); LRU_STEP4(24); LRU_STEP4(28); } while (0)
#define CTRL "row_shr:1 row_mask:0xf bank_mask:0xf"
    LRU_STEP();
#undef CTRL
#define CTRL "row_shr:2 row_mask:0xf bank_mask:0xf"
    LRU_STEP();
#undef CTRL
#define CTRL "row_shr:4 row_mask:0xf bank_mask:0xf"
    LRU_STEP();
#undef CTRL
#define CTRL "row_shr:8 row_mask:0xf bank_mask:0xf"
    LRU_STEP();
#undef CTRL
#define CTRL "row_bcast:15 row_mask:0xa bank_mask:0xf"
    LRU_STEP();
#undef CTRL
#undef LRU_E
#undef LRU_STEP4
#undef LRU_STEP
}
__device__ __forceinline__ void lru_put_agg(LAS float* Aw, LAS float* Hw, int wave, int lane, const float (&av)[32], const float (&bv)[32]) {
    const int r32 = lane & 31, hi = lane >> 5;
    if (r32 == 31) {
#pragma unroll
        for (int k = 0; k < 8; ++k) { const int d = 8 * k + 4 * hi; const int idx = 4 * k;
            *(LAS f32x4*)(Aw + wave * 64 + d) = (f32x4){av[idx], av[idx + 1], av[idx + 2], av[idx + 3]}; *(LAS f32x4*)(Hw + wave * 64 + d) = (f32x4){bv[idx], bv[idx + 1], bv[idx + 2], bv[idx + 3]}; } }
}
__device__ __forceinline__ void lru_publish(gu64* GR, const LAS float* Aw, const LAS float* Hw, int b, int ck, int n, int lane) {
    float cA = 1.f, cH = 0.f; const int gc = n * 64 + lane;
#pragma unroll
    for (int v = 0; v < 8; ++v) { const float a1 = Aw[v * 64 + lane], h1 = Hw[v * 64 + lane]; cH = a1 * cH + h1; cA *= a1; }
    gu64* g = GR + ((size_t)(b * NBLK + ck) * LRUW + gc) * 2;
    __hip_atomic_store(g, (1ull << 32) | (unsigned long long)__float_as_uint(cA), __ATOMIC_RELAXED, __HIP_MEMORY_SCOPE_AGENT);
    __hip_atomic_store(g + 1, (1ull << 32) | (unsigned long long)__float_as_uint(cH), __ATOMIC_RELAXED, __HIP_MEMORY_SCOPE_AGENT);
}
__device__ __forceinline__ float lru_lookback(const gu64* GR, int b, int ck, int n, int lane) {
    const int gc = n * 64 + lane; float h = 0.f;
    if (ck > 0) {
        const gu64* g0 = GR + ((size_t)(b * NBLK) * LRUW + gc) * 2;
#pragma unroll
        for (int half = 0; half < 2; ++half) {
            if (half * 16 < ck) {
                float ca[16], ch[16];
                for (unsigned spins = 0;; ++spins) { bool ok = true;
#pragma unroll
                    for (int cc = 0; cc < 16; ++cc) { const int c1 = half * 16 + cc, c2 = c1 < ck ? c1 : 0;
                        const unsigned long long x = __hip_atomic_load(g0 + (size_t)c2 * LRUW * 2, __ATOMIC_RELAXED, __HIP_MEMORY_SCOPE_AGENT), y = __hip_atomic_load(g0 + (size_t)c2 * LRUW * 2 + 1, __ATOMIC_RELAXED, __HIP_MEMORY_SCOPE_AGENT);
                        ok = ok && ((x >> 32) == 1ull) && ((y >> 32) == 1ull); ca[cc] = __uint_as_float((unsigned)x); ch[cc] = __uint_as_float((unsigned)y); }
                    if (__all(ok) || spins > (1u << 14)) break;
                    __builtin_amdgcn_s_sleep(2); }
#pragma unroll
                for (int cc = 0; cc < 16; ++cc) h = (half * 16 + cc) < ck ? ca[cc] * h + ch[cc] : h;
            }
        }
    }
    return h;
}
__device__ __forceinline__ void lru_finish(bf16* MIX, const LAS float* Aw, const LAS float* Hw, const LAS float* CAR, LAS unsigned char* tile, int n, int b, int ck, int wave, int lane, const float (&av)[32], const float (&bv)[32]) {
    typedef unsigned u2v __attribute__((ext_vector_type(2)));
    const int r32 = lane & 31, hi = lane >> 5;
    LAS unsigned char* grow = tile + LRU_XT + r32 * LRU_ROWB + 8 * hi;
    f32x4 c[8];
#pragma unroll
    for (int k = 0; k < 8; ++k) c[k] = *(const LAS f32x4*)(CAR + 8 * k + 4 * hi);
    for (int v = 0; v < wave; ++v) { const LAS float* ap = Aw + v * 64 + 4 * hi; const LAS float* hp = Hw + v * 64 + 4 * hi;
#pragma unroll
        for (int k = 0; k < 8; ++k) { const f32x4 a1 = *(const LAS f32x4*)(ap + 8 * k), h1 = *(const LAS f32x4*)(hp + 8 * k); c[k] = a1 * c[k] + h1; } }
#pragma unroll
    for (int k = 0; k < 8; ++k) { const int idx = 4 * k;
        const u2v gw = *(const LAS u2v*)(grow + 16 * k);
        const float h0 = bv[idx] + av[idx] * c[k][0], h1_ = bv[idx + 1] + av[idx + 1] * c[k][1], h2 = bv[idx + 2] + av[idx + 2] * c[k][2], h3 = bv[idx + 3] + av[idx + 3] * c[k][3];
        u2v o; o.x = pkbf(h0 * gelu_tanh(bflo(gw.x)), h1_ * gelu_tanh(bfhi(gw.x))); o.y = pkbf(h2 * gelu_tanh(bflo(gw.y)), h3 * gelu_tanh(bfhi(gw.y)));
        *(LAS u2v*)(grow + 16 * k) = o; }
    { const int rr = lane >> 3, c16 = lane & 7; bf16* dst = MIX + ((size_t)b * SEQ + ck * 256 + wave * 32 + rr) * D + n * 64 + c16 * 8;
#pragma unroll
      for (int i = 0; i < 4; ++i) { const LAS unsigned char* s = tile + LRU_XT + (rr + 8 * i) * LRU_ROWB + c16 * 16; const u2v lo = *(const LAS u2v*)s, hi2 = *(const LAS u2v*)(s + 8);
          *(GAS v4u*)(dst + (size_t)(8 * i) * D) = (v4u){lo.x, lo.y, hi2.x, hi2.y}; } }
}
template <bool FINAL>
__device__ __forceinline__ void lru_items(unsigned char* ws, LAS unsigned char* lds, int G, int wave, int tid) {
    const bf16* U = (const bf16*)(ws + WS_U); bf16* MIX = (bf16*)(ws + WS_MIX); const bf16* WG = (const bf16*)(ws + WS_WG);
    gu64* GR = (gu64*)(ws + WS_GR);
    LAS float* PT = (LAS float*)(lds + RING_OFF);
    LAS float* Aw = PT + 512; LAS float* Hw = Aw + 512; LAS float* CAR = Hw + 512;
    LAS unsigned char* tile = lds + RING_OFF + 8192 + wave * 10240;
    static_assert(LRU_TILE <= 10240 && 8192 + 8 * 10240 <= RING_BYTES, "LRU LDS map");
    const int n = blockIdx.x & 7;
    __syncthreads();
    { const int row = tid >> 6, c = tid & 63; PT[row * 64 + c] = ((const float*)(ws + WS_PTAB))[row * 512 + n * 64 + c]; }
    v4u xv[5], gv[4];
    if ((int)blockIdx.x < BATCH * NBLK * 8) { int lane0; asm volatile("v_mbcnt_lo_u32_b32 %0, -1, 0\n\tv_mbcnt_hi_u32_b32 %0, -1, %0" : "=v"(lane0)); lru_load(U, n, (int)blockIdx.x >> 8, ((int)blockIdx.x >> 3) & 31, wave, lane0, xv, gv); }
    for (int id = blockIdx.x; id < BATCH * NBLK * 8; id += G) {
        const int ck = (id >> 3) & 31, b = id >> 8;
        int lane; asm volatile("v_mbcnt_lo_u32_b32 %0, -1, 0\n\tv_mbcnt_hi_u32_b32 %0, -1, %0" : "=v"(lane));
        __syncthreads();
        float av[32], bv[32];
        lru_stage(tile, lane, xv, gv);
        { const int nid = (id + G < BATCH * NBLK * 8) ? id + G : id; lru_load(U, n, nid >> 8, (nid >> 3) & 31, wave, lane, xv, gv); }
        lru_local(WG, PT, tile, n, b, ck, wave, lane, av, bv);
        lru_put_agg(Aw, Hw, wave, lane, av, bv);
        __syncthreads();
        if (wave == 0) lru_publish(GR, Aw, Hw, b, ck, n, lane);
        if (wave == 7) CAR[lane] = lru_lookback(GR, b, ck, n, lane);
        __syncthreads();
        lru_finish(MIX, Aw, Hw, CAR, tile, n, b, ck, wave, lane, av, bv);
    }
    __syncthreads();
}
__device__ __forceinline__ void kvprep_items(unsigned char* ws, LAS unsigned char* lds, int G, int wave, int lane, int tid) {
    const bf16* U = (const bf16*)(ws + WS_U); bf16* KF = (bf16*)(ws + WS_KF); bf16* VF = (bf16*)(ws + WS_VF); float* KM = (float*)(ws + WS_KMEAN);
    LAS unsigned char* KT = lds + RING_OFF;
    LAS unsigned short* VTl = (LAS unsigned short*)(lds + RING_OFF + 36864);
    LAS float* part = (LAS float*)(lds + RING_OFF + 36864 + 33792);
    for (int id = blockIdx.x; id < BATCH * NBLK * 4; id += G) {
        const int h = id & 3, j = (id >> 2) & 31, b = id >> 7, bh = b * 4 + h;
        __syncthreads();
        { const int key = tid >> 1, half = tid & 1; const bf16* rowp = U + ((size_t)b * SEQ + j * 256 + key) * INW + h * 64 + half * 32;
          const uint4* ks = (const uint4*)(rowp + 1280); const uint4* vs = (const uint4*)(rowp + 1536);
          v4u kw[4], vw[4];
#pragma unroll
          for (int c = 0; c < 4; ++c) { kw[c] = *(const GAS v4u*)(ks + c); vw[c] = *(const GAS v4u*)(vs + c); }
#pragma unroll
          for (int c = 0; c < 4; ++c) { *(LAS v4u*)(KT + key * 144 + half * 64 + c * 16) = kw[c];
              LAS unsigned* dst = (LAS unsigned*)(VTl + key * 66 + half * 32 + c * 8); dst[0] = vw[c].x; dst[1] = vw[c].y; dst[2] = vw[c].z; dst[3] = vw[c].w; } }
        __syncthreads();
        { const int d = tid & 63, pt = tid >> 6; float s = 0.f;
#pragma unroll 8
          for (int r = 0; r < 32; ++r) s += bf2f(*(const LAS unsigned short*)(KT + (pt * 32 + r) * 144 + d * 2));
          part[pt * 64 + d] = s; }
        { const int r32 = lane & 31, hi = lane >> 5;
#pragma unroll
          for (int ks = 0; ks < 4; ++ks) { const v4u w = *(const LAS v4u*)(KT + (wave * 32 + r32) * 144 + ks * 32 + hi * 16);
              *(GAS v4u*)(KF + (((size_t)(bh * 256 + j * 8 + wave) * 4 + ks) * 64 + lane) * 8) = w; }
#pragma unroll
          for (int db = 0; db < 2; ++db)
#pragma unroll
              for (int s = 0; s < 2; ++s) { unsigned short v[8];
#pragma unroll
                  for (int jj = 0; jj < 8; ++jj) v[jj] = VTl[(wave * 32 + 16 * s + 8 * (jj >> 2) + 4 * hi + (jj & 3)) * 66 + 32 * db + r32];
                  uint4 w; w.x = v[0] | ((unsigned)v[1] << 16); w.y = v[2] | ((unsigned)v[3] << 16); w.z = v[4] | ((unsigned)v[5] << 16); w.w = v[6] | ((unsigned)v[7] << 16);
                  *(GAS v4u*)(VF + ((((size_t)(bh * 256 + j * 8 + wave) * 2 + db) * 2 + s) * 64 + lane) * 8) = (v4u){w.x, w.y, w.z, w.w}; } }
        __syncthreads();
        if (tid < 64) { float s = 0.f;
#pragma unroll
            for (int v = 0; v < 8; ++v) s += part[v * 64 + tid];
            KM[((size_t)bh * NBLK + j) * 64 + tid] = s * (1.0f / 256.0f); }
    }
    __syncthreads();
}
__device__ __forceinline__ void memkv_items(unsigned char* ws, LAS unsigned char* lds, int vcu, int G, int wave, int lane) {
    const bf16* A = (const bf16*)(ws + WS_MEMB); const bf16* Bt = (const bf16*)(ws + WS_WMKV);
    bf16* MK = (bf16*)(ws + WS_MEMKF); bf16* MV = (bf16*)(ws + WS_MEMVF); const float* gk = (const float*)(ws + WS_GAINS) + 256;
    LAS float* red = (LAS float*)(lds + RING_OFF);
    for (int id = vcu; id < 32 * 8; id += G) {
        const int rt = id >> 3, ct = id & 7, fr = lane & 15, fq = lane >> 4;
        f32x4 acc[4];
#pragma unroll
        for (int nb = 0; nb < 4; ++nb) acc[nb] = (f32x4){0.f, 0.f, 0.f, 0.f};
        const bf16* ap = A + (size_t)(rt * 16 + fr) * D + fq * 8 + wave * 128;
        const bf16* bp = Bt + (size_t)(ct * 64 + fr) * D + fq * 8 + wave * 128;
        bf16x8 af[4], bfr[4][4];
#pragma unroll
        for (int ks = 0; ks < 4; ++ks) { af[ks] = *(const GAS bf16x8*)(ap + ks * 32);
#pragma unroll
            for (int nb = 0; nb < 4; ++nb) bfr[ks][nb] = *(const GAS bf16x8*)(bp + (size_t)nb * 16 * D + ks * 32); }
#pragma unroll
        for (int ks = 0; ks < 4; ++ks)
#pragma unroll
            for (int nb = 0; nb < 4; ++nb) acc[nb] = __builtin_amdgcn_mfma_f32_16x16x32_bf16(af[ks], bfr[ks][nb], acc[nb], 0, 0, 0);
        __syncthreads();
#pragma unroll
        for (int nb = 0; nb < 4; ++nb) *(LAS f32x4*)(red + ((wave * 4 + nb) * 64 + lane) * 4) = acc[nb];
        __syncthreads();
        if (wave == 0) {
            float gkv[4];
#pragma unroll
            for (int nb = 0; nb < 4; ++nb) gkv[nb] = *(const GAS float*)(gk + nb * 16 + fr);
#pragma unroll
            for (int nb = 0; nb < 4; ++nb) { f32x4 s = *(const LAS f32x4*)(red + (nb * 64 + lane) * 4);
#pragma unroll
                for (int w = 1; w < 8; ++w) s += *(const LAS f32x4*)(red + ((w * 4 + nb) * 64 + lane) * 4);
                acc[nb] = s; }
#pragma unroll
            for (int reg = 0; reg < 4; ++reg) { const int row = rt * 16 + 4 * fq + reg, bb = row >> 8, m = row & 255, kb = m >> 5, mm = m & 31;
                if (ct < 4) { float ss = 0.f;
#pragma unroll
                    for (int nb = 0; nb < 4; ++nb) ss += acc[nb][reg] * acc[nb][reg];
                    ss += __shfl_xor(ss, 1); ss += __shfl_xor(ss, 2); ss += __shfl_xor(ss, 4); ss += __shfl_xor(ss, 8);
                    const float rn = __builtin_amdgcn_rsqf(ss * (1.0f / 64.0f) + EPS);
#pragma unroll
                    for (int nb = 0; nb < 4; ++nb) { const int d = nb * 16 + fr;
                        MK[((((size_t)((bb * 4 + ct) * 8 + kb) * 4 + (d >> 4)) * 64) + ((d >> 3) & 1) * 32 + mm) * 8 + (d & 7)] = (bf16)f2bf(acc[nb][reg] * rn * gkv[nb]); }
                } else { const int s = mm >> 4, o = mm & 15, hi2 = (o >> 2) & 1, jj = 4 * (o >> 3) + (o & 3);
#pragma unroll
                    for (int nb = 0; nb < 4; ++nb) { const int d = nb * 16 + fr;
                        MV[(((((size_t)((bb * 4 + (ct - 4)) * 8 + kb) * 2 + (d >> 5)) * 2 + s) * 64) + hi2 * 32 + (d & 31)) * 8 + jj] = (bf16)f2bf(acc[nb][reg]); } } }
        }
    }
    __syncthreads();
}
typedef float f32x16 __attribute__((ext_vector_type(16)));
__device__ __forceinline__ int crow(int r, int hi) { return (r & 3) + 8 * (r >> 2) + 4 * hi; }
__device__ __forceinline__ unsigned cvtpk(float lo, float hi) { typedef float f2 __attribute__((ext_vector_type(2))); typedef __bf16 b2 __attribute__((ext_vector_type(2))); f2 v = {lo, hi}; b2 r = __builtin_convertvector(v, b2); return __builtin_bit_cast(unsigned, r); }
__device__ __forceinline__ void attn_task(f32x16& o0, f32x16& o1, float& lsum, const bf16* qrow, const bf16* KFb, const bf16* VFb, int nkb, float cq, float slopeL, int dist0, int lane) {
    const int r32 = lane & 31, hi = lane >> 5; (void)r32;
    bf16x8 qf[4];
#pragma unroll
    for (int ks = 0; ks < 4; ++ks) qf[ks] = *(const bf16x8*)(qrow + 16 * ks + 8 * hi);
    float base[16];
#pragma unroll
    for (int r = 0; r < 16; ++r) base[r] = slopeL * (float)crow(r, hi) + cq;
#pragma unroll
    for (int r = 0; r < 16; ++r) { o0[r] = 0.f; o1[r] = 0.f; }
    lsum = 0.f;
    const bf16* kp = KFb + lane * 8;
    const bf16* vp = VFb + lane * 8;
    bf16x8 kA[4], vA[4];
#define AT_LOADK(k_, kb_) do { _Pragma("unroll") for (int ks = 0; ks < 4; ++ks) k_[ks] = *(const bf16x8*)(kp + ((kb_) * 4 + ks) * 512); } while (0)
#define AT_LOADV(v_, kb_) do { _Pragma("unroll") for (int f = 0; f < 4; ++f) v_[f] = *(const bf16x8*)(vp + ((kb_) * 4 + f) * 512); } while (0)
    AT_LOADK(kA, 0); AT_LOADV(vA, 0);
#pragma unroll 1
    for (int kb = 0; kb < nkb; ++kb) {
        const float c0 = slopeL * (float)(32 * kb); f32x16 sc;
#pragma unroll
        for (int r = 0; r < 16; ++r) sc[r] = base[r] + c0;
#pragma unroll
        for (int ks = 0; ks < 4; ++ks) sc = __builtin_amdgcn_mfma_f32_32x32x16_bf16(kA[ks], qf[ks], sc, 0, 0, 0);
        if (kb + 1 < nkb) AT_LOADK(kA, kb + 1);
#pragma unroll
        for (int r = 0; r < 16; ++r) { float pr = __builtin_amdgcn_exp2f(sc[r]); if (32 * kb + crow(r, hi) > dist0) pr = 0.f; sc[r] = pr; lsum += pr; }
        v4u w0, w1; w0.x = cvtpk(sc[0], sc[1]); w0.y = cvtpk(sc[2], sc[3]); w0.z = cvtpk(sc[4], sc[5]); w0.w = cvtpk(sc[6], sc[7]); w1.x = cvtpk(sc[8], sc[9]); w1.y = cvtpk(sc[10], sc[11]); w1.z = cvtpk(sc[12], sc[13]); w1.w = cvtpk(sc[14], sc[15]);
        const bf16x8 p0 = __builtin_bit_cast(bf16x8, w0), p1 = __builtin_bit_cast(bf16x8, w1);
        o0 = __builtin_amdgcn_mfma_f32_32x32x16_bf16(vA[0], p0, o0, 0, 0, 0); o0 = __builtin_amdgcn_mfma_f32_32x32x16_bf16(vA[1], p1, o0, 0, 0, 0);
        o1 = __builtin_amdgcn_mfma_f32_32x32x16_bf16(vA[2], p0, o1, 0, 0, 0); o1 = __builtin_amdgcn_mfma_f32_32x32x16_bf16(vA[3], p1, o1, 0, 0, 0);
        if (kb + 1 < nkb) AT_LOADV(vA, kb + 1);
    }
#undef AT_LOADK
#undef AT_LOADV
}
constexpr int AU_KMT = 0;
constexpr int AU_SLOT = 0;
constexpr int AU_CNT = LDSCTL_OFF + 512, AU_TC = AU_CNT + 128, AU_TASKS = AU_TC + 16, AU_LIST = AU_TASKS + 240, AU_LACC = AU_LIST + 32 * 256 * 2, AU_END = AU_LACC + 4 * 256 * 4;
static_assert(AU_END <= LDS_BYTES, "MoBA unit LDS map");
__device__ __forceinline__ void moba_unit(unsigned char* ws, LAS unsigned char* lds, int bh, int qb, int wave, int lane, int tid) {
    const bf16* U = (const bf16*)(ws + WS_U); bf16* MIX = (bf16*)(ws + WS_MIX); const float* KM = (const float*)(ws + WS_KMEAN);
    const float* GT = (const float*)(ws + WS_GAINS);
    LAS unsigned* CNT = (LAS unsigned*)(lds + AU_CNT); LAS unsigned* TC = (LAS unsigned*)(lds + AU_TC);
    LAS unsigned short* TASKS = (LAS unsigned short*)(lds + AU_TASKS); LAS unsigned short* LIST = (LAS unsigned short*)(lds + AU_LIST);
    LAS float* KMT = (LAS float*)(lds + AU_KMT); LAS float* LACC = (LAS float*)(lds + AU_LACC);
    LAS unsigned char* SLOT = lds + AU_SLOT;
    const int b = bh >> 2, h = bh & 3, r32 = lane & 31, hi = lane >> 5;
    const size_t rb = (size_t)b * SEQ;
    const float slopeL = exp2f(-2.0f * (float)(h + 1)) * 1.4426950408889634f;
    const float MB2 = GT[192];
    const bf16* Qh = U + (rb + (size_t)qb * 256) * INW + 1024 + h * 64;
    const bf16* KFh = (const bf16*)(ws + WS_KF) + (size_t)bh * 256 * 2048;
    const bf16* VFh = (const bf16*)(ws + WS_VF) + (size_t)bh * 256 * 2048;
#ifndef REP_MB_SETUP
#define REP_MB_SETUP 1
#endif
    for (int rsu_ = 0; rsu_ < REP_MB_SETUP; ++rsu_) {
    __syncthreads();
    if (tid < 36) CNT[tid] = 0u;
    const int ql = wave * 32 + r32;
    unsigned qw[32];
    { const GAS v4u* p = (const GAS v4u*)(Qh + (size_t)ql * INW);
#pragma unroll
      for (int c = 0; c < 8; ++c) { const v4u w = p[c]; qw[4 * c] = w.x; qw[4 * c + 1] = w.y; qw[4 * c + 2] = w.z; qw[4 * c + 3] = w.w; } }
    for (int i = tid; i < qb * 64; i += 512) KMT[(i >> 6) * 65 + (i & 63)] = *(const GAS float*)(KM + (size_t)bh * NBLK * 64 + i);
    __syncthreads();
    if (qb > 0) {
        f32x16 g;
#pragma unroll
        for (int r = 0; r < 16; ++r) g[r] = 0.f;
#pragma unroll
        for (int ks = 0; ks < 32; ++ks) { const float a = KMT[r32 * 65 + 2 * ks + hi]; const float bq = hi ? bfhi(qw[ks]) : bflo(qw[ks]); g = __builtin_amdgcn_mfma_f32_32x32x2f32(a, bq, g, 0, 0, 0); }
        float g1 = -INFINITY, g2 = -INFINITY, g3 = -INFINITY; int i1 = 0, i2 = 0, i3 = 0;
#pragma unroll
        for (int r = 0; r < 16; ++r) { const int j = crow(r, hi); const float gv = (j < qb) ? g[r] : -INFINITY;
            const bool c1 = gv > g1, c2 = gv > g2, c3 = gv > g3;
            g3 = c2 ? g2 : (c3 ? gv : g3); i3 = c2 ? i2 : (c3 ? j : i3);
            g2 = c1 ? g1 : (c2 ? gv : g2); i2 = c1 ? i1 : (c2 ? j : i2);
            g1 = c1 ? gv : g1; i1 = c1 ? j : i1; }
        float pg[3]; int pi[3];
        pg[0] = __shfl_xor(g1, 32); pg[1] = __shfl_xor(g2, 32); pg[2] = __shfl_xor(g3, 32); pi[0] = __shfl_xor(i1, 32); pi[1] = __shfl_xor(i2, 32); pi[2] = __shfl_xor(i3, 32);
#pragma unroll
        for (int k = 0; k < 3; ++k) { const float gv = pg[k]; const int j = pi[k];
            const bool c1 = gv > g1 || (gv == g1 && j < i1), c2 = gv > g2 || (gv == g2 && j < i2), c3 = gv > g3 || (gv == g3 && j < i3);
            g3 = c2 ? g2 : (c3 ? gv : g3); i3 = c2 ? i2 : (c3 ? j : i3);
            g2 = c1 ? g1 : (c2 ? gv : g2); i2 = c1 ? i1 : (c2 ? j : i2);
            g1 = c1 ? gv : g1; i1 = c1 ? j : i1; }
        if (hi == 0) { const int nok = qb < 3 ? qb : 3;
            if (nok > 0) { const unsigned pos = atomicAdd((unsigned*)&CNT[i1], 1u); LIST[i1 * 256 + pos] = (unsigned short)ql; }
            if (nok > 1) { const unsigned pos = atomicAdd((unsigned*)&CNT[i2], 1u); LIST[i2 * 256 + pos] = (unsigned short)(ql | 0x100); }
            if (nok > 2) { const unsigned pos = atomicAdd((unsigned*)&CNT[i3], 1u); LIST[i3 * 256 + pos] = (unsigned short)(ql | 0x200); } }
    }
    __syncthreads();
    if (wave == 0) {
        const unsigned c = (lane < qb && lane < 32) ? CNT[lane] : 0u; const int ng = (int)((c + 31u) >> 5);
        int incl = ng;
#pragma unroll
        for (int o = 1; o < 64; o <<= 1) { const int t = __shfl_up(incl, o); if (lane >= o) incl += t; }
        const int off = incl - ng, total = __shfl(incl, 63);
#ifdef MB_SHARED_FIRST
        for (int g = 0; g < ng; ++g) TASKS[16 + off + g] = (unsigned short)((lane << 8) | g);
        if (lane < 8) { TASKS[lane] = (unsigned short)(0x4000 | lane); TASKS[8 + lane] = (unsigned short)(0x8000 | lane); }
#else
        for (int g = 0; g < ng; ++g) TASKS[off + g] = (unsigned short)((lane << 8) | g);
        if (lane < 8) { TASKS[total + lane] = (unsigned short)(0x8000 | (7 - lane)); TASKS[total + 8 + lane] = (unsigned short)(0x4000 | lane); }
#endif
        if (lane == 0) TC[0] = (unsigned)(total + 16);
    }
    __syncthreads();
    }
    const int ntasks = (int)TC[0];
#ifndef REP_MB_STREAM
#define REP_MB_STREAM 1
#endif
#ifdef MB_ROT4
    for (int rst_ = 0; rst_ < REP_MB_STREAM; ++rst_)
    if (wave < ntasks) {
        int lane; asm volatile("v_mbcnt_lo_u32_b32 %0, -1, 0\n\tv_mbcnt_hi_u32_b32 %0, -1, %0" : "=v"(lane));
        const int r32 = lane & 31, hi = lane >> 5; unsigned loffB = (unsigned)lane * 16u;
        int t = wave;
        int c_j, c_nkb, c_slot, c_ql, c_dist0; bool c_valid, c_own, c_mem;
#define MB_DECODE(T, J, NKB, SLOT, QL, DIST0, VALID, OWN, MEM) do { const unsigned tk_ = (unsigned)__builtin_amdgcn_readfirstlane((int)TASKS[T]); MEM = (tk_ & 0x4000u) != 0u; OWN = (tk_ & 0x8000u) != 0u; \
        if (MEM) { QL = (int)(tk_ & 7u) * 32 + r32; SLOT = 4; J = 0; NKB = 8; DIST0 = 1 << 20; VALID = true; } \
        else if (OWN) { const int w_ = (int)(tk_ & 7u); QL = w_ * 32 + r32; SLOT = 3; J = qb; NKB = (w_ + 2) & ~1; DIST0 = QL; VALID = true; } \
        else { J = (int)(tk_ >> 8); const int g_ = (int)(tk_ & 0xffu); const int cnt_ = (int)CNT[J]; const int idx_ = 32 * g_ + r32; VALID = idx_ < cnt_; const unsigned e_ = LIST[J * 256 + (VALID ? idx_ : 32 * g_)]; \
               QL = (int)(e_ & 0xffu); SLOT = (int)(e_ >> 8); NKB = 8; DIST0 = 1 << 20; } } while (0)
        MB_DECODE(t, c_j, c_nkb, c_slot, c_ql, c_dist0, c_valid, c_own, c_mem);
        bf16x8 qf[4], qfn[4], kA[4], vA[4], kB[4], vB[4];
        const bf16* MKFh = (const bf16*)(ws + WS_MEMKF) + (size_t)bh * 8 * 2048; const bf16* MVFh = (const bf16*)(ws + WS_MEMVF) + (size_t)bh * 8 * 2048; const float MBM = GT[193];
        { const bf16* qrow = Qh + (size_t)c_ql * INW + 8 * hi + (c_mem ? 768 : 0);
#pragma unroll
          for (int ks = 0; ks < 4; ++ks) qf[ks] = *(const GAS bf16x8*)(qrow + 16 * ks); }
        const bf16* kp = c_mem ? MKFh : KFh + (size_t)c_j * 16384; const bf16* vp = c_mem ? MVFh : VFh + (size_t)c_j * 16384;
#define MB_LOADF(F_, P, KB) do { const GAS char* b_ = (const GAS char*)((P) + (KB) * 2048); _Pragma("unroll") for (int f = 0; f < 4; ++f) F_[f] = *(const GAS bf16x8*)(b_ + f * 1024 + loffB); } while (0)
#define MB_QK(K_, KB) const float c0_ = __builtin_fmaf(c_slope, (float)(32 * (KB)), cqh); f32x16 sc; _Pragma("unroll") for (int r = 0; r < 16; ++r) sc[r] = __builtin_fmaf(c_slope, (float)((r & 3) + 8 * (r >> 2)), c0_); \
        _Pragma("unroll") for (int ks = 0; ks < 4; ++ks) sc = __builtin_amdgcn_mfma_f32_32x32x16_bf16(K_[ks], qf[ks], sc, 0, 0, 0);
#define MB_PV(V_, KB) \
        if (c_own) { _Pragma("unroll") for (int r = 0; r < 16; ++r) { float pr = __builtin_amdgcn_exp2f(sc[r]); if (32 * (KB) + crow(r, hi) > c_dist0) pr = 0.f; sc[r] = pr; ls += pr; } } \
        else { _Pragma("unroll") for (int r = 0; r < 16; ++r) { const float pr = __builtin_amdgcn_exp2f(sc[r]); sc[r] = pr; ls += pr; } } \
        v4u w0_, w1_; w0_.x = cvtpk(sc[0], sc[1]); w0_.y = cvtpk(sc[2], sc[3]); w0_.z = cvtpk(sc[4], sc[5]); w0_.w = cvtpk(sc[6], sc[7]); w1_.x = cvtpk(sc[8], sc[9]); w1_.y = cvtpk(sc[10], sc[11]); w1_.z = cvtpk(sc[12], sc[13]); w1_.w = cvtpk(sc[14], sc[15]); \
        const bf16x8 p0_ = __builtin_bit_cast(bf16x8, w0_), p1_ = __builtin_bit_cast(bf16x8, w1_); \
        o0 = __builtin_amdgcn_mfma_f32_32x32x16_bf16(V_[0], p0_, o0, 0, 0, 0); o0 = __builtin_amdgcn_mfma_f32_32x32x16_bf16(V_[1], p1_, o0, 0, 0, 0); \
        o1 = __builtin_amdgcn_mfma_f32_32x32x16_bf16(V_[2], p0_, o1, 0, 0, 0); o1 = __builtin_amdgcn_mfma_f32_32x32x16_bf16(V_[3], p1_, o1, 0, 0, 0);
#define MB_SB __builtin_amdgcn_sched_barrier(0)
#define MB_PINK asm volatile("" :: "v"(sc) : "memory")
#define MB_PINV asm volatile("" :: "v"(o0), "v"(o1) : "memory")
        MB_LOADF(kA, kp, 0); MB_LOADF(vA, vp, 0); MB_LOADF(kB, kp, 1); MB_LOADF(vB, vp, 1);
#pragma unroll 1
        for (;;) {
            const int tn = t + 8; const bool has_next = tn < ntasks;
            int n_j = 0, n_nkb = 0, n_slot = 0, n_ql = 0, n_dist0 = 0; bool n_valid = false, n_own = false, n_mem = false;
            const bf16* kpn = kp; const bf16* vpn = vp;
            if (has_next) { MB_DECODE(tn, n_j, n_nkb, n_slot, n_ql, n_dist0, n_valid, n_own, n_mem);
                const bf16* qrow = Qh + (size_t)n_ql * INW + 8 * hi + (n_mem ? 768 : 0);
#pragma unroll
                for (int ks = 0; ks < 4; ++ks) qfn[ks] = *(const GAS bf16x8*)(qrow + 16 * ks);
                kpn = n_mem ? MKFh : KFh + (size_t)n_j * 16384; vpn = n_mem ? MVFh : VFh + (size_t)n_j * 16384; }
            const float c_slope = c_mem ? 0.f : slopeL;
            const float cq = c_mem ? -MBM : -MB2 - slopeL * (float)((qb - c_j) * 256 + c_ql);
            const float cqh = __builtin_fmaf(c_slope, (float)(4 * hi), cq);
            f32x16 o0, o1; float ls = 0.f;
#pragma unroll
            for (int r = 0; r < 16; ++r) { o0[r] = 0.f; o1[r] = 0.f; }
#pragma unroll 1
            for (int kb = 0; kb < c_nkb; kb += 2) {
                const bool more = kb + 2 < c_nkb; const bf16* kq = more ? kp : kpn; const bf16* vq = more ? vp : vpn; const int kbq = more ? kb + 2 : 0;
                { MB_QK(kA, kb) MB_PINK; MB_LOADF(kA, kq, kbq); MB_SB; MB_PV(vA, kb) MB_PINV; MB_LOADF(vA, vq, kbq); MB_SB; }
                { MB_QK(kB, kb + 1) MB_PINK; MB_LOADF(kB, kq, kbq + 1); MB_SB; MB_PV(vB, kb + 1) MB_PINV; MB_LOADF(vB, vq, kbq + 1); MB_SB; }
            }
            ls += __shfl_xor(ls, 32);
            if (c_mem) { const float il = 1.0f / ls; bf16* dst = MIX + (rb + (size_t)qb * 256 + c_ql) * D + 768 + h * 64;
#pragma unroll
                for (int q4 = 0; q4 < 4; ++q4) { uint2 w;
                    w.x = cvtpk(o0[4 * q4] * il, o0[4 * q4 + 1] * il); w.y = cvtpk(o0[4 * q4 + 2] * il, o0[4 * q4 + 3] * il); *(uint2*)(dst + 8 * q4 + 4 * hi) = w;
                    w.x = cvtpk(o1[4 * q4] * il, o1[4 * q4 + 1] * il); w.y = cvtpk(o1[4 * q4 + 2] * il, o1[4 * q4 + 3] * il); *(uint2*)(dst + 32 + 8 * q4 + 4 * hi) = w; } }
            else if (c_valid) { LAS unsigned char* rowp = SLOT + (c_slot * 256 + c_ql) * 128; const int sw = c_ql & 15;
                typedef unsigned u2v __attribute__((ext_vector_type(2)));
#pragma unroll
                for (int q4 = 0; q4 < 4; ++q4) { *(LAS u2v*)(rowp + (((2 * q4 + hi) ^ sw) << 3)) = (u2v){cvtpk(o0[4 * q4], o0[4 * q4 + 1]), cvtpk(o0[4 * q4 + 2], o0[4 * q4 + 3])};
                    *(LAS u2v*)(rowp + (((8 + 2 * q4 + hi) ^ sw) << 3)) = (u2v){cvtpk(o1[4 * q4], o1[4 * q4 + 1]), cvtpk(o1[4 * q4 + 2], o1[4 * q4 + 3])}; }
                if (hi == 0) LACC[c_slot * 256 + c_ql] = ls; }
            if (!has_next) break;
            t = tn; c_j = n_j; c_nkb = n_nkb; c_slot = n_slot; c_ql = n_ql; c_dist0 = n_dist0; c_valid = n_valid; c_own = n_own; c_mem = n_mem; kp = kpn; vp = vpn;
#pragma unroll
            for (int ks = 0; ks < 4; ++ks) qf[ks] = qfn[ks];
        }
#undef MB_DECODE
#undef MB_LOADF
#undef MB_QK
#undef MB_PV
#undef MB_SB
#undef MB_PINK
#undef MB_PINV
    }
#else
    for (int rst_ = 0; rst_ < REP_MB_STREAM; ++rst_)
    if (wave < ntasks) {
        int lane; asm volatile("v_mbcnt_lo_u32_b32 %0, -1, 0\n\tv_mbcnt_hi_u32_b32 %0, -1, %0" : "=v"(lane));
        const int r32 = lane & 31, hi = lane >> 5;
        int t = wave;
        int c_j, c_nkb, c_slot, c_ql, c_dist0; bool c_valid, c_own;
#define MB_DECODE(T, J, NKB, SLOT, QL, DIST0, VALID, OWN) do { const unsigned tk_ = TASKS[T]; \
        if (tk_ & 0x4000u) { QL = (int)(tk_ & 7u) * 32 + r32; SLOT = 4; J = 0; NKB = 8; DIST0 = 1 << 20; VALID = true; OWN = false; } \
        else if (tk_ & 0x8000u) { const int w_ = (int)(tk_ & 7u); QL = w_ * 32 + r32; SLOT = 3; J = qb; NKB = (w_ + 2) & ~1; DIST0 = QL; VALID = true; OWN = true; } \
        else { J = (int)(tk_ >> 8); const int g_ = (int)(tk_ & 0xffu); const int cnt_ = (int)CNT[J]; const int idx_ = 32 * g_ + r32; VALID = idx_ < cnt_; const unsigned e_ = LIST[J * 256 + (VALID ? idx_ : 32 * g_)]; \
               QL = (int)(e_ & 0xffu); SLOT = (int)(e_ >> 8); NKB = 8; DIST0 = 1 << 20; OWN = false; } } while (0)
        MB_DECODE(t, c_j, c_nkb, c_slot, c_ql, c_dist0, c_valid, c_own);
        bf16x8 qf[4], qfn[4], kA[4], vA[4], kB[4], vB[4];
        const bf16* MKFh = (const bf16*)(ws + WS_MEMKF) + (size_t)bh * 8 * 2048; const bf16* MVFh = (const bf16*)(ws + WS_MEMVF) + (size_t)bh * 8 * 2048; const float MBM = GT[193];
        { const bf16* qrow = Qh + (size_t)c_ql * INW + 8 * hi + (c_slot == 4 ? 768 : 0);
#pragma unroll
          for (int ks = 0; ks < 4; ++ks) qf[ks] = *(const GAS bf16x8*)(qrow + 16 * ks); }
        const bf16* kp = (c_slot == 4 ? MKFh : KFh + (size_t)c_j * 16384) + lane * 8; const bf16* vp = (c_slot == 4 ? MVFh : VFh + (size_t)c_j * 16384) + lane * 8;
#ifdef MB_PROBE_VAR
        const int pvar_ = (REP_MB_STREAM == 2 && rst_ == 0) ? MB_PROBE_VAR : 0;
#define MB_KBE(KB) (pvar_ == 1 ? 0 : (KB))
#define MB_NOEXP (pvar_ == 2)
#define MB_NOMMA (pvar_ == 3)
#define MB_NKB(n) (pvar_ == 4 ? 0 : (n))
#else
#define MB_NKB(n) (n)
#define MB_KBE(KB) (KB)
#define MB_NOEXP false
#define MB_NOMMA false
#endif
#define MB_LOADK(K_, KP, KB) do { _Pragma("unroll") for (int f = 0; f < 4; ++f) K_[f] = *(const GAS bf16x8*)((KP) + (MB_KBE(KB) * 4 + f) * 512); } while (0)
#define MB_LOADV(V_, VP, KB) do { _Pragma("unroll") for (int f = 0; f < 4; ++f) V_[f] = *(const GAS bf16x8*)((VP) + (MB_KBE(KB) * 4 + f) * 512); } while (0)
#define MB_LOAD(K_, V_, KP, VP, KB) do { MB_LOADK(K_, KP, KB); MB_LOADV(V_, VP, KB); } while (0)
#define MB_QK(K_, KB) const float c0_ = __builtin_fmaf(c_slope, (float)(32 * (KB)), cqh); f32x16 sc; _Pragma("unroll") for (int r = 0; r < 16; ++r) sc[r] = __builtin_fmaf(c_slope, (float)((r & 3) + 8 * (r >> 2)), c0_); \
        if (!MB_NOMMA) { _Pragma("unroll") for (int ks = 0; ks < 4; ++ks) sc = __builtin_amdgcn_mfma_f32_32x32x16_bf16(K_[ks], qf[ks], sc, 0, 0, 0); }
#define MB_PV(V_, KB) \
        if (MB_NOEXP) { _Pragma("unroll") for (int r = 0; r < 16; ++r) ls += sc[r]; } else \
        if (c_own) { _Pragma("unroll") for (int r = 0; r < 16; ++r) { float pr = __builtin_amdgcn_exp2f(sc[r]); if (32 * (KB) + crow(r, hi) > c_dist0) pr = 0.f; sc[r] = pr; ls += pr; } } \
        else { _Pragma("unroll") for (int r = 0; r < 16; ++r) { const float pr = __builtin_amdgcn_exp2f(sc[r]); sc[r] = pr; ls += pr; } } \
        v4u w0_, w1_; w0_.x = cvtpk(sc[0], sc[1]); w0_.y = cvtpk(sc[2], sc[3]); w0_.z = cvtpk(sc[4], sc[5]); w0_.w = cvtpk(sc[6], sc[7]); w1_.x = cvtpk(sc[8], sc[9]); w1_.y = cvtpk(sc[10], sc[11]); w1_.z = cvtpk(sc[12], sc[13]); w1_.w = cvtpk(sc[14], sc[15]); \
        const bf16x8 p0_ = __builtin_bit_cast(bf16x8, w0_), p1_ = __builtin_bit_cast(bf16x8, w1_); \
        if (!MB_NOMMA) { o0 = __builtin_amdgcn_mfma_f32_32x32x16_bf16(V_[0], p0_, o0, 0, 0, 0); o0 = __builtin_amdgcn_mfma_f32_32x32x16_bf16(V_[1], p1_, o0, 0, 0, 0); \
        o1 = __builtin_amdgcn_mfma_f32_32x32x16_bf16(V_[2], p0_, o1, 0, 0, 0); o1 = __builtin_amdgcn_mfma_f32_32x32x16_bf16(V_[3], p1_, o1, 0, 0, 0); } \
        else { _Pragma("unroll") for (int f = 0; f < 4; ++f) asm volatile("" :: "v"(V_[f])); asm volatile("" :: "v"(p0_), "v"(p1_)); }
#define MB_COMP(K_, V_, KB) do { MB_QK(K_, KB) MB_PV(V_, KB) } while (0)
        MB_LOAD(kA, vA, kp, vp, 0);
#pragma unroll 1
        for (;;) {
            const int tn = t + 8; const bool has_next = tn < ntasks;
            int n_j = 0, n_nkb = 0, n_slot = 0, n_ql = 0, n_dist0 = 0; bool n_valid = false, n_own = false;
            const bf16* kpn = kp; const bf16* vpn = vp;
            if (has_next) { MB_DECODE(tn, n_j, n_nkb, n_slot, n_ql, n_dist0, n_valid, n_own);
                const bf16* qrow = Qh + (size_t)n_ql * INW + 8 * hi + (n_slot == 4 ? 768 : 0);
#pragma unroll
                for (int ks = 0; ks < 4; ++ks) qfn[ks] = *(const GAS bf16x8*)(qrow + 16 * ks);
                kpn = (n_slot == 4 ? MKFh : KFh + (size_t)n_j * 16384) + lane * 8; vpn = (n_slot == 4 ? MVFh : VFh + (size_t)n_j * 16384) + lane * 8; }
            const float c_slope = c_slot == 4 ? 0.f : slopeL;
            const float cq = c_slot == 4 ? -MBM : -MB2 - slopeL * (float)((qb - c_j) * 256 + c_ql);
            const float cqh = __builtin_fmaf(c_slope, (float)(4 * hi), cq);
            f32x16 o0, o1; float ls = 0.f;
#pragma unroll
            for (int r = 0; r < 16; ++r) { o0[r] = 0.f; o1[r] = 0.f; }
#pragma unroll 1
            for (int kb = 0; kb < MB_NKB(c_nkb); kb += 2) {
                MB_LOAD(kB, vB, kp, vp, kb + 1);
                MB_COMP(kA, vA, kb);
                { const bool more = kb + 2 < c_nkb; const bf16* kq = more ? kp : kpn; const bf16* vq = more ? vp : vpn; const int kbq = more ? kb + 2 : 0;
                  MB_LOAD(kA, vA, kq, vq, kbq); }
                MB_COMP(kB, vB, kb + 1);
            }
            ls += __shfl_xor(ls, 32);
            if (c_slot == 4) { const float il = 1.0f / ls; bf16* dst = MIX + (rb + (size_t)qb * 256 + c_ql) * D + 768 + h * 64;
#pragma unroll
                for (int q4 = 0; q4 < 4; ++q4) { uint2 w;
                    w.x = cvtpk(o0[4 * q4] * il, o0[4 * q4 + 1] * il); w.y = cvtpk(o0[4 * q4 + 2] * il, o0[4 * q4 + 3] * il); *(uint2*)(dst + 8 * q4 + 4 * hi) = w;
                    w.x = cvtpk(o1[4 * q4] * il, o1[4 * q4 + 1] * il); w.y = cvtpk(o1[4 * q4 + 2] * il, o1[4 * q4 + 3] * il); *(uint2*)(dst + 32 + 8 * q4 + 4 * hi) = w; } }
            else if (c_valid) { LAS unsigned char* rowp = SLOT + (c_slot * 256 + c_ql) * 128; const int sw = c_ql & 15;
                typedef unsigned u2v __attribute__((ext_vector_type(2)));
#pragma unroll
                for (int q4 = 0; q4 < 4; ++q4) { *(LAS u2v*)(rowp + (((2 * q4 + hi) ^ sw) << 3)) = (u2v){cvtpk(o0[4 * q4], o0[4 * q4 + 1]), cvtpk(o0[4 * q4 + 2], o0[4 * q4 + 3])};
                    *(LAS u2v*)(rowp + (((8 + 2 * q4 + hi) ^ sw) << 3)) = (u2v){cvtpk(o1[4 * q4], o1[4 * q4 + 1]), cvtpk(o1[4 * q4 + 2], o1[4 * q4 + 3])}; }
                if (hi == 0) LACC[c_slot * 256 + c_ql] = ls; }
            if (!has_next) break;
            t = tn; c_j = n_j; c_nkb = n_nkb; c_slot = n_slot; c_ql = n_ql; c_dist0 = n_dist0; c_valid = n_valid; c_own = n_own; kp = kpn; vp = vpn;
#pragma unroll
            for (int ks = 0; ks < 4; ++ks) qf[ks] = qfn[ks];
        }
#undef MB_DECODE
#undef MB_LOAD
#undef MB_COMP
#undef MB_QK
#undef MB_PV
#undef MB_LOADK
#undef MB_LOADV
    }
#endif
    __syncthreads();
    { int lane; asm volatile("v_mbcnt_lo_u32_b32 %0, -1, 0\n\tv_mbcnt_hi_u32_b32 %0, -1, %0" : "=v"(lane)); const int tid = wave * 64 + lane;
      const int row = tid >> 1, half = tid & 1; const int nok = qb < 3 ? qb : 3; const int sw = row & 15;
      typedef unsigned u2v __attribute__((ext_vector_type(2)));
      float acc[32]; float l = LACC[3 * 256 + row];
      { const LAS unsigned char* rowp = SLOT + (3 * 256 + row) * 128;
#pragma unroll
        for (int c = 0; c < 8; ++c) { const u2v w = *(const LAS u2v*)(rowp + (((8 * half + c) ^ sw) << 3)); acc[4 * c] = bflo(w.x); acc[4 * c + 1] = bfhi(w.x); acc[4 * c + 2] = bflo(w.y); acc[4 * c + 3] = bfhi(w.y); } }
#pragma unroll
      for (int s = 0; s < 3; ++s) if (s < nok) { const LAS unsigned char* rowp = SLOT + (s * 256 + row) * 128; l += LACC[s * 256 + row];
#pragma unroll
        for (int c = 0; c < 8; ++c) { const u2v w = *(const LAS u2v*)(rowp + (((8 * half + c) ^ sw) << 3)); acc[4 * c] += bflo(w.x); acc[4 * c + 1] += bfhi(w.x); acc[4 * c + 2] += bflo(w.y); acc[4 * c + 3] += bfhi(w.y); } }
      const float il = 1.0f / l;
      uint4* dst = (uint4*)(MIX + (rb + (size_t)qb * 256 + row) * D + 512 + h * 64 + half * 32);
#pragma unroll
      for (int c = 0; c < 4; ++c) { uint4 w; w.x = cvtpk(acc[8 * c] * il, acc[8 * c + 1] * il); w.y = cvtpk(acc[8 * c + 2] * il, acc[8 * c + 3] * il); w.z = cvtpk(acc[8 * c + 4] * il, acc[8 * c + 5] * il); w.w = cvtpk(acc[8 * c + 6] * il, acc[8 * c + 7] * il); dst[c] = w; } }
    __syncthreads();
}
__device__ __forceinline__ void memattn_unit(unsigned char* ws, int bh, int qb, int wave, int lane) {
    const bf16* U = (const bf16*)(ws + WS_U); bf16* MIX = (bf16*)(ws + WS_MIX); const float* GT = (const float*)(ws + WS_GAINS);
    const int b = bh >> 2, h = bh & 3, r32 = lane & 31, hi = lane >> 5;
    const size_t row = (size_t)b * SEQ + qb * 256 + wave * 32 + r32;
    const bf16* KFh = (const bf16*)(ws + WS_MEMKF) + (size_t)bh * 8 * 2048;
    const bf16* VFh = (const bf16*)(ws + WS_MEMVF) + (size_t)bh * 8 * 2048;
    f32x16 o0, o1; float ls;
    attn_task(o0, o1, ls, U + row * INW + 1792 + h * 64, KFh, VFh, 8, -GT[193], 0.f, 1 << 20, lane);
    ls += __shfl_xor(ls, 32);
    const float il = 1.0f / ls;
    bf16* dst = MIX + row * D + 768 + h * 64;
#pragma unroll
    for (int q4 = 0; q4 < 4; ++q4) { uint2 w;
        w.x = cvtpk(o0[4 * q4] * il, o0[4 * q4 + 1] * il); w.y = cvtpk(o0[4 * q4 + 2] * il, o0[4 * q4 + 3] * il); *(uint2*)(dst + 8 * q4 + 4 * hi) = w;
        w.x = cvtpk(o1[4 * q4] * il, o1[4 * q4 + 1] * il); w.y = cvtpk(o1[4 * q4 + 2] * il, o1[4 * q4 + 3] * il); *(uint2*)(dst + 32 + 8 * q4 + 4 * hi) = w; }
}
struct Args { const float* in[24]; float* out; unsigned char* ws; int ph_lo, ph_hi; };
__global__ void __launch_bounds__(NWAVES * 64, 2) hymba_fwd(Args args) {
    extern __shared__ __attribute__((aligned(16))) unsigned char lds[];
    LAS unsigned char* L = (LAS unsigned char*)lds;
    volatile LAS unsigned* MISC = (volatile LAS unsigned*)(L + MISC_OFF);
    const int wave = __builtin_amdgcn_readfirstlane(threadIdx.x >> 6);
#define LANE_TID() int lane; asm volatile("v_mbcnt_lo_u32_b32 %0, -1, 0\n\tv_mbcnt_hi_u32_b32 %0, -1, %0" : "=v"(lane)); const int tid = wave * 64 + lane; (void)tid
    const int G = gridDim.x; const int bx = blockIdx.x; const int vcu = (G % 8 == 0) ? (bx % 8) * (G / 8) + bx / 8 : bx;
    unsigned char* const ws0 = args.ws; const float* const* in = args.in; float* out = args.out;
    gu32* ctl = (gu32*)(ws0 + WS_CTL);
    { LANE_TID(); for (int u = tid; u < (LDS_BYTES - LDSCTL_OFF) / 4; u += NWAVES * 64) ((LAS unsigned*)(L + LDSCTL_OFF))[u] = 0u; }
    __syncthreads();
    XcdBarrier bar; bar.bar = (unsigned*)(ctl + CW_BAR); bar.x = 0; bar.st = nullptr; bar.wave = wave;
    if (N_LAUNCHES == 1) bar = xcd_barrier_post((unsigned*)(ctl + CW_BAR), MISC + 8, wave);
#define GRID_BAR() do { if (N_LAUNCHES == 1) xcd_barrier(bar); } while (0)
#ifdef WT_ALL
#define GRID_BAR_NW() do { if (N_LAUNCHES == 1) xcd_barrier(bar, false); } while (0)
#else
#define GRID_BAR_NW() GRID_BAR()
#endif
#ifdef LABEL_BARS
#define LABEL_BAR(sig, e, need) do { if (N_LAUNCHES == 1) { if (G % 8 == 0) label_barrier((unsigned*)ctl, (unsigned*)(ctl + CW_BAR), bx & 7, (unsigned)(G / 8), wave, (sig), (unsigned*)(ctl + LB_EV(e)), (unsigned)(need)); else xcd_barrier(bar); } } while (0)
#else
#define LABEL_BAR(sig, e, need) GRID_BAR_NW()
#endif
    const int lo = args.ph_lo, hi = args.ph_hi;
#ifndef PH_MASK
#define PH_MASK 0x1ff
#endif
#define IN(k) (((PH_MASK >> (k)) & 1) && lo <= (k) && (k) < hi)
#define BOTH(k) (IN(k) && IN((k) + 1))
#ifndef REP_MASK
#define REP_MASK 0
#endif
#define REPS(k) (((REP_MASK >> (k)) & 1) ? 2 : 1)
#ifndef REP_SUB
#define REP_SUB 0
#endif
#define RSUB(k) for (int rs_ = 0; rs_ < (((REP_SUB >> (k)) & 1) ? 2 : 1); ++rs_)
#define WSP() unsigned char* ws = ws0; asm volatile("" : "+s"(ws)); (void)ws
#define XB ((bf16*)(ws + WS_XB))
#define HB ((bf16*)(ws + WS_H))
#define UB ((bf16*)(ws + WS_U))
#define MIX ((bf16*)(ws + WS_MIX))
#define SSQ0 ((float*)(ws + WS_SSQ0))
#define SSQ1 ((float*)(ws + WS_SSQ1))
#define SSQ2 ((float*)(ws + WS_SSQ2))

    for (int rep = 0; rep < REPS(0); ++rep) if (IN(0)) { WSP(); LANE_TID(); p0_prologue(in, ws, L, vcu, G, wave, lane);
        if (bx == 0 && tid < 192) wt_st4f((float*)(ws + WS_GAINS) + tid, (tid < 64 ? in[15][tid] : tid < 128 ? in[16][tid - 64] : in[18][tid - 128]));
        if (bx == 0 && tid < 64) wt_st4f((float*)(ws + WS_GAINS) + 256 + tid, in[19][tid]);
        if (bx == 1) { float* PTB = (float*)(ws + WS_PTAB);
            for (int i = tid; i < 8 * 512; i += 512) { const int row = i >> 9, gc = i & 511; float v;
                if (row < 4) v = in[8][row * 512 + gc]; else if (row == 4) v = in[9][gc]; else if (row == 5) v = -8.0f * 1.4426950408889634f * log1pf(__expf(-in[14][gc])); else if (row == 6) v = 1.4426950408889634f * in[11][gc]; else v = 1.4426950408889634f * in[13][gc];
                wt_st4f(PTB + i, v); } }
        if (bx == 0 && wave == 3) {
            const float mq = wave_max(fabsf(in[15][lane])), mk = wave_max(fabsf(in[16][lane])), cq = wave_max(fabsf(in[18][lane])), ck = wave_max(fabsf(in[19][lane]));
            if (lane == 0) { wt_st4f((float*)(ws + WS_GAINS) + 192, 8.0f * mq * mk * 1.4426950408889634f); wt_st4f((float*)(ws + WS_GAINS) + 193, 8.0f * cq * ck * 1.4426950408889634f); } } if (BOTH(0)) GRID_BAR_NW(); }
    for (int rep = 0; rep < REPS(1); ++rep) if (IN(1)) { WSP();
        pg8::Gemm g{XB, (const bf16*)(ws + WS_W1I), M, 2 * FF, D}; pg8::StaticOrder S; S.init(M, 2 * FF, G, bx);
#ifdef PROBE_NOMMA
        g.nomma = (REPS(1) == 2 && rep == 0) ? 1 : 0;
#endif
        pg8::EpiSwiGLU E{HB, FF, SSQ0};
        pg8::gemm_phase<pg8::EpiSwiGLU, pg8::StaticOrder, PG8_ALIGN, PG8_SP2>(L + RING_OFF, g, S, E, wave);
        bool tail1 = false; int ntail1 = 0;
        { pg8::Unit u6; const int nwg = (M / 256) * (2 * FF / 256), nshort = (nwg % G) ? G - nwg % G : 0;
          if (nshort > 0 && !S.next(nwg / G, u6)) { __syncthreads(); LANE_TID(); memkv_items(ws, L, bx - (G - nshort), nshort, wave, lane);
              p0_weights<1>(in, ws, L, (bx - (G - nshort)) * NWAVES + wave, nshort * NWAVES, wave, lane); tail1 = true; }
          else if (nshort == 0) { __syncthreads(); LANE_TID(); p0_weights<1>(in, ws, L, vcu * NWAVES + wave, G * NWAVES, wave, lane); tail1 = true; }
          ntail1 = nshort > 0 ? nshort : G; }
        if (BOTH(1)) LABEL_BAR(tail1, 0, ntail1);
    }
    for (int rep = 0; rep < REPS(2); ++rep) if (IN(2)) { WSP();
        pg8::Gemm g{HB, (const bf16*)(ws + WS_W1O), M, D, FF}; pg8::StaticOrder S; S.init(M, D, G, bx);
        pg8::EpiResid E{XB, XB, nullptr, SSQ1, 0.5f};
        pg8::gemm_phase<pg8::EpiResid, pg8::StaticOrder, false, PG8_SP2>(L + RING_OFF, g, S, E, wave);
        if (BOTH(2)) LABEL_BAR(false, 0, 0);
    }
    for (int rep = 0; rep < REPS(3); ++rep) if (IN(3)) { WSP();
        pg8::Gemm g{XB, (const bf16*)(ws + WS_WIN), M, INW, D}; pg8::StaticOrder S; S.init(M, INW, G, bx);
        pg8::EpiWin E{UB, SSQ1, (const float*)(ws + WS_GAINS)};
        pg8::gemm_phase<pg8::EpiWin, pg8::StaticOrder, PG8_ALIGN, PG8_SP2>(L + RING_OFF, g, S, E, wave);
        if (BOTH(3)) GRID_BAR_NW();
    }
#ifdef EXTRA_BARS
    for (int eb = 0; eb < EXTRA_BARS; ++eb) GRID_BAR();
#endif
    for (int rep = 0; rep < REPS(4); ++rep) if (IN(4)) {
        RSUB(0) { WSP(); LANE_TID(); lru_items<true>(ws, L, G, wave, tid); }
        RSUB(1) { WSP(); LANE_TID(); kvprep_items(ws, L, G, wave, lane, tid); }
        if ((((M / 256) * (2 * FF / 256)) % G) == 0) RSUB(2) { WSP(); LANE_TID(); memkv_items(ws, L, vcu, G, wave, lane); }
        if (BOTH(4)) GRID_BAR();
    }
    for (int rep = 0; rep < REPS(5); ++rep) if (IN(5)) {
#ifndef NO_MOBA
        RSUB(4) { WSP(); LANE_TID(); for (int id = vcu; id < BATCH * 4 * NBLK; id += G) moba_unit(ws, L, id >> 5, id & 31, wave, lane, tid); }
#endif
        if (BOTH(5)) GRID_BAR();
    }
    if (IN(6)) { WSP();
        pg8::Gemm g{MIX, (const bf16*)(ws + WS_WOUT), M, D, D}; pg8::StaticOrder S; S.init(M, D, G, bx);
        pg8::EpiResid E{XB, XB, nullptr, SSQ2, 1.0f};
        pg8::gemm_phase<pg8::EpiResid, pg8::StaticOrder, false, PG8_SP2>(L + RING_OFF, g, S, E, wave);
        if (BOTH(6)) LABEL_BAR(false, 0, 0);
    }
    for (int rep = 0; rep < REPS(7); ++rep) if (IN(7)) { WSP();
        pg8::Gemm g{XB, (const bf16*)(ws + WS_W2I), M, 2 * FF, D}; pg8::StaticOrder S; S.init(M, 2 * FF, G, bx);
#ifdef PROBE_NOMMA
        g.nomma = (REPS(7) == 2 && rep == 0) ? 1 : 0;
#endif
        pg8::EpiSwiGLU E{HB, FF, SSQ2};
        pg8::gemm_phase<pg8::EpiSwiGLU, pg8::StaticOrder, PG8_ALIGN, PG8_SP2>(L + RING_OFF, g, S, E, wave);
        bool tail7 = false; int ntail7 = 0;
        { pg8::Unit u6; const int nwg = (M / 256) * (2 * FF / 256), nshort = (nwg % G) ? G - nwg % G : 0;
          if (rep == 0) { if (nshort > 0 && !S.next(nwg / G, u6)) { __syncthreads(); LANE_TID(); p0_weights<2>(in, ws, L, (bx - (G - nshort)) * NWAVES + wave, nshort * NWAVES, wave, lane); tail7 = true; }
                          else if (nshort == 0) { __syncthreads(); LANE_TID(); p0_weights<2>(in, ws, L, vcu * NWAVES + wave, G * NWAVES, wave, lane); tail7 = true; } }
          ntail7 = nshort > 0 ? nshort : G; }
        if (BOTH(7)) LABEL_BAR(tail7, 1, ntail7);
    }
    for (int rep = 0; rep < REPS(8); ++rep) if (IN(8)) { WSP();
        pg8::Gemm g{HB, (const bf16*)(ws + WS_W2O), M, D, FF}; pg8::StaticOrder S; S.init(M, D, G, bx);
        pg8::EpiResid E{XB, nullptr, out, nullptr, 0.5f};
        pg8::gemm_phase<pg8::EpiResid, pg8::StaticOrder, false, PG8_SP2>(L + RING_OFF, g, S, E, wave);
        if (rep + 1 < REPS(8)) GRID_BAR();
    }
#undef IN
#undef BOTH
}

extern "C" void kernel_launch(void* const* d_in, const int* in_sizes, int n_in, void* d_out, int out_size, void* d_ws, size_t ws_size, hipStream_t stream) {
    static int grid = 0;
    if (grid == 0) {
        if (n_in != 24 || in_sizes[0] != M * D || out_size != M * D || ws_size < WS_END) { fprintf(stderr, "kernel_launch: unexpected shapes (n_in %d, in0 %d, out %d, ws %zu); nothing launched\n", n_in, n_in > 0 ? in_sizes[0] : -1, out_size, ws_size); grid = -1; return; }
        int dev = 0, cus = 0, per_cu = 0;
        if (hipGetDevice(&dev) != hipSuccess || hipDeviceGetAttribute(&cus, hipDeviceAttributeMultiprocessorCount, dev) != hipSuccess) { fprintf(stderr, "kernel_launch: device query failed\n"); grid = -1; return; }
        if (hipFuncSetAttribute((const void*)hymba_fwd, hipFuncAttributeMaxDynamicSharedMemorySize, LDS_BYTES) != hipSuccess) { fprintf(stderr, "kernel_launch: hipFuncSetAttribute failed\n"); grid = -1; return; }
        if (hipOccupancyMaxActiveBlocksPerMultiprocessor(&per_cu, (const void*)hymba_fwd, NWAVES * 64, LDS_BYTES) != hipSuccess) per_cu = 0;
        (void)hipGetLastError();
        if (per_cu < 1 || cus * per_cu < 256) { fprintf(stderr, "kernel_launch: the persistent grid of 256 workgroups is not resident (cus %d, per_cu %d); nothing launched\n", cus, per_cu); grid = -1; return; }
        grid = 256;
    }
    if (grid < 0) return;
    if (hipMemsetAsync((char*)d_ws + WS_CTL, 0, CTL_ZERO_BYTES, stream) != hipSuccess) { fprintf(stderr, "kernel_launch: hipMemsetAsync failed\n"); return; }
    Args a{};
    for (int i = 0; i < 24; ++i) a.in[i] = (const float*)d_in[i];
    a.out = (float*)d_out; a.ws = (unsigned char*)d_ws;
    if (N_LAUNCHES == 1) { a.ph_lo = 0; a.ph_hi = NPHASE; hipLaunchKernelGGL(hymba_fwd, dim3(grid), dim3(NWAVES * 64), LDS_BYTES, stream, a); }
    else for (int p = 0; p < NPHASE; ++p) { a.ph_lo = p; a.ph_hi = p + 1; hipLaunchKernelGGL(hymba_fwd, dim3(grid), dim3(NWAVES * 64), LDS_BYTES, stream, a); }
    const hipError_t le = hipPeekAtLastError();
    if (le != hipSuccess) fprintf(stderr, "kernel_launch: launch failed: %s\n", hipGetErrorName(le));
}
```
